# Optimizing an MI355X kernel written in HIP

```python
import math
import jax, jax.numpy as jnp
from jax import lax
import numpy as np

D_MODEL = 1024
BATCH = 4
SEQ = 4096
DEPTH = 4

N_A = DEPTH // 2
N_B = DEPTH - N_A
CONV_WIDTH = 31
CONV_CH = D_MODEL
N_HEADS = 8
QK_NOPE_DIM = 128
QK_ROPE_DIM = 64
V_HEAD_DIM = 128
Q_LORA_RANK = 384
KV_LORA_RANK = 256
ROPE_THETA = 10000.0
Q_BLOCK = 128
ATTN_SCALE = 1.0 / math.sqrt(QK_NOPE_DIM + QK_ROPE_DIM)
N_EXPERTS = 16
N_GROUPS = 4
EXPERTS_PER_GROUP = N_EXPERTS // N_GROUPS
TOP_K = 2
D_EXPERT = 512
ROW_BLOCK = 128
EPS = 1e-6
NEG_INF = -1e30

kernel_name = "yoco_conformer_mla_grouped_moe_adaln"


def rms_norm(x, g):
    xf = x.astype(jnp.float32)
    y = xf * lax.rsqrt(jnp.mean(xf * xf, axis=-1, keepdims=True) + EPS)
    return (y * g.astype(jnp.float32)).astype(x.dtype)


def layer_norm(x, g, b):
    xf = x.astype(jnp.float32)
    mu = jnp.mean(xf, axis=-1, keepdims=True)
    var = jnp.mean(jnp.square(xf - mu), axis=-1, keepdims=True)
    y = (xf - mu) * lax.rsqrt(var + EPS)
    return (y * g.astype(jnp.float32) + b.astype(jnp.float32)).astype(x.dtype)


def modulate(x, g, shift, scale):
    return rms_norm(x, g) * (1 + scale[:, None, :]) + shift[:, None, :]


def rope_tables(positions, dtype):
    inv_freq = ROPE_THETA ** (-jnp.arange(0, QK_ROPE_DIM, 2, dtype=jnp.float32) / QK_ROPE_DIM)
    ang = positions.astype(jnp.float32)[..., None] * inv_freq
    return jnp.cos(ang).astype(dtype), jnp.sin(ang).astype(dtype)


def apply_rope(x, cos, sin):
    x1, x2 = jnp.split(x, 2, axis=-1)
    return jnp.concatenate([x1 * cos - x2 * sin, x1 * sin + x2 * cos], axis=-1)


def conformer_conv(h, w_in, b_in, w_dw, b_dw, ln_g, ln_b, w_out):
    u = h @ w_in + b_in
    a, gate = jnp.split(u, 2, axis=-1)
    u = a * jax.nn.sigmoid(gate)
    u = lax.conv_general_dilated(
        u, w_dw[:, None, :], window_strides=(1,), padding=[(CONV_WIDTH - 1, 0)],
        dimension_numbers=("NWC", "WIO", "NWC"), feature_group_count=CONV_CH) + b_dw
    u = jax.nn.silu(layer_norm(u, ln_g, ln_b))
    return u @ w_out


def shared_kv(x, kv_in_g, w_dkv, kv_norm_g, w_ukv, cos, sin):
    Bsz, S, _ = x.shape
    ckv = rms_norm(x, kv_in_g) @ w_dkv
    latent = rms_norm(ckv[..., :KV_LORA_RANK], kv_norm_g)
    k_rope = apply_rope(ckv[..., KV_LORA_RANK:], cos, sin)
    kv = (latent @ w_ukv).reshape(Bsz, S, N_HEADS, QK_NOPE_DIM + V_HEAD_DIM)
    return kv[..., :QK_NOPE_DIM], k_rope, kv[..., QK_NOPE_DIM:]


def mla_attention(q_nope, q_rope, k_nope, k_rope, v):
    Bsz, S, H, _ = q_nope.shape
    nb = S // Q_BLOCK
    qn = q_nope.reshape(Bsz, nb, Q_BLOCK, H, QK_NOPE_DIM).transpose(1, 0, 2, 3, 4)
    qr = q_rope.reshape(Bsz, nb, Q_BLOCK, H, QK_ROPE_DIM).transpose(1, 0, 2, 3, 4)
    q_pos = jnp.arange(S, dtype=jnp.int32).reshape(nb, Q_BLOCK)
    k_pos = jnp.arange(S, dtype=jnp.int32)

    def one_block(args):
        qn_b, qr_b, qp = args
        s = (jnp.einsum("bqhd,bkhd->bhqk", qn_b, k_nope)
             + jnp.einsum("bqhr,bkr->bhqk", qr_b, k_rope)).astype(jnp.float32) * ATTN_SCALE
        s = jnp.where(k_pos[None, :] <= qp[:, None], s, NEG_INF)
        p = jax.nn.softmax(s, axis=-1).astype(v.dtype)
        return jnp.einsum("bhqk,bkhd->bqhd", p, v)

    o = lax.map(one_block, (qn, qr, q_pos))
    return o.transpose(1, 0, 2, 3, 4).reshape(Bsz, S, H * V_HEAD_DIM)


def route(h2, router_w, router_b):
    T = h2.shape[0]
    s = jax.nn.sigmoid(h2.astype(jnp.float32) @ router_w.astype(jnp.float32))
    sb = (s + router_b.astype(jnp.float32)).reshape(T, N_GROUPS, EXPERTS_PER_GROUP)
    grp_score = lax.top_k(sb, 2)[0].sum(-1)
    g = jnp.argmax(grp_score, axis=-1).astype(jnp.int32)
    within = jnp.take_along_axis(sb, g[:, None, None], axis=1)[:, 0]
    _, loc = lax.top_k(within, TOP_K)
    idx = g[:, None] * EXPERTS_PER_GROUP + loc.astype(jnp.int32)
    w = jnp.take_along_axis(s, idx, axis=1)
    return idx, w / jnp.sum(w, axis=-1, keepdims=True)


def moe_ffn(h, router_w, router_b, w_gate, w_up, w_down):
    Bsz, S, D = h.shape
    T = Bsz * S
    h2 = h.reshape(T, D)
    idx, w = route(h2, router_w, router_b)
    flat_e = idx.reshape(-1)
    flat_w = w.reshape(-1).astype(h.dtype)
    flat_tok = jnp.repeat(jnp.arange(T, dtype=jnp.int32), TOP_K)
    order = jnp.argsort(flat_e)
    sorted_e = flat_e[order]
    counts = jnp.bincount(flat_e, length=N_EXPERTS)
    padded = ((counts + ROW_BLOCK - 1) // ROW_BLOCK) * ROW_BLOCK
    pad_end = jnp.cumsum(padded)
    pad_start = pad_end - padded
    start = jnp.cumsum(counts) - counts
    rank = jnp.arange(T * TOP_K, dtype=jnp.int32) - start[sorted_e]
    dest = pad_start[sorted_e] + rank
    n_rows = T * TOP_K + N_EXPERTS * ROW_BLOCK
    n_blk = n_rows // ROW_BLOCK
    buf_tok = jnp.full((n_rows,), T, jnp.int32).at[dest].set(flat_tok[order])
    buf_w = jnp.zeros((n_rows,), h.dtype).at[dest].set(flat_w[order])
    blk_start = jnp.arange(n_blk, dtype=pad_end.dtype) * ROW_BLOCK
    blk_e = jnp.minimum(jnp.searchsorted(pad_end, blk_start, side="right"), N_EXPERTS - 1)
    h_pad = jnp.concatenate([h2, jnp.zeros((1, D), h.dtype)], axis=0)
    xb = h_pad[buf_tok].reshape(n_blk, ROW_BLOCK, D)

    def expert_block(args):
        xr, e = args
        return (jax.nn.silu(xr @ w_gate[e]) * (xr @ w_up[e])) @ w_down[e]

    yb = lax.map(expert_block, (xb, blk_e)).reshape(n_rows, D)
    y = jnp.zeros((T + 1, D), h.dtype).at[buf_tok].add(yb * buf_w[:, None])[:T]
    return y.reshape(Bsz, S, D)


def setup_inputs(seed: int = 0) -> dict:
    key = jax.random.key(seed)
    ks = iter(jax.random.split(key, 40))
    D = D_MODEL
    f32 = jnp.float32

    def nrm(shape, scale):
        return jax.random.normal(next(ks), shape, f32) * scale

    def gain(shape):
        return 1.0 + 0.05 * jax.random.normal(next(ks), shape, f32)

    x = jax.random.normal(next(ks), (BATCH, SEQ, D), f32)
    c = jax.random.normal(next(ks), (BATCH, D), f32)
    offs = jax.random.randint(next(ks), (BATCH, 1), 0, 1024, dtype=jnp.int32)
    positions = offs + jnp.arange(SEQ, dtype=jnp.int32)[None, :]
    return {
        "x": x, "c": c, "positions": positions,
        "ada_w": nrm((DEPTH, D, 6 * D), 0.5 * D ** -0.5),
        "ada_b": nrm((DEPTH, 6 * D), 0.02),
        "norm1_g": gain((DEPTH, D)),
        "norm2_g": gain((DEPTH, D)),
        "conv_w_in": nrm((N_A, D, 2 * CONV_CH), D ** -0.5),
        "conv_b_in": nrm((N_A, 2 * CONV_CH), 0.02),
        "conv_w_dw": nrm((N_A, CONV_WIDTH, CONV_CH), CONV_WIDTH ** -0.5),
        "conv_b_dw": nrm((N_A, CONV_CH), 0.02),
        "conv_ln_g": gain((N_A, CONV_CH)),
        "conv_ln_b": nrm((N_A, CONV_CH), 0.02),
        "conv_w_out": nrm((N_A, CONV_CH, D), CONV_CH ** -0.5),
        "kv_in_g": gain((D,)),
        "w_dkv": nrm((D, KV_LORA_RANK + QK_ROPE_DIM), D ** -0.5),
        "kv_norm_g": gain((KV_LORA_RANK,)),
        "w_ukv": nrm((KV_LORA_RANK, N_HEADS * (QK_NOPE_DIM + V_HEAD_DIM)), KV_LORA_RANK ** -0.5),
        "w_dq": nrm((N_B, D, Q_LORA_RANK), D ** -0.5),
        "q_norm_g": gain((N_B, Q_LORA_RANK)),
        "w_uq": nrm((N_B, Q_LORA_RANK, N_HEADS * (QK_NOPE_DIM + QK_ROPE_DIM)), Q_LORA_RANK ** -0.5),
        "w_o": nrm((N_B, N_HEADS * V_HEAD_DIM, D), (N_HEADS * V_HEAD_DIM) ** -0.5),
        "router_w": nrm((D, N_EXPERTS), D ** -0.5),
        "router_b": nrm((N_EXPERTS,), 0.01),
        "exp_w_gate": nrm((DEPTH, N_EXPERTS, D, D_EXPERT), D ** -0.5),
        "exp_w_up": nrm((DEPTH, N_EXPERTS, D, D_EXPERT), D ** -0.5),
        "exp_w_down": nrm((DEPTH, N_EXPERTS, D_EXPERT, D), D_EXPERT ** -0.5),
        "final_g": gain((D,)),
    }


def reference(x, c, positions, ada_w, ada_b, norm1_g, norm2_g,
              conv_w_in, conv_b_in, conv_w_dw, conv_b_dw, conv_ln_g, conv_ln_b, conv_w_out,
              kv_in_g, w_dkv, kv_norm_g, w_ukv,
              w_dq, q_norm_g, w_uq, w_o,
              router_w, router_b, exp_w_gate, exp_w_up, exp_w_down, final_g):
    Bsz, S, _ = x.shape
    cos, sin = rope_tables(positions, x.dtype)
    c_act = jax.nn.silu(c)
    k_nope = k_rope = v = None
    for l in range(DEPTH):
        mod = c_act @ ada_w[l] + ada_b[l]
        sh1, sc1, g1, sh2, sc2, g2 = jnp.split(mod, 6, axis=-1)
        h = modulate(x, norm1_g[l], sh1, sc1)
        if l < N_A:
            mix = conformer_conv(h, conv_w_in[l], conv_b_in[l], conv_w_dw[l], conv_b_dw[l],
                                 conv_ln_g[l], conv_ln_b[l], conv_w_out[l])
        else:
            j = l - N_A
            if j == 0:
                k_nope, k_rope, v = shared_kv(x, kv_in_g, w_dkv, kv_norm_g, w_ukv, cos, sin)
            cq = rms_norm(h @ w_dq[j], q_norm_g[j])
            q = (cq @ w_uq[j]).reshape(Bsz, S, N_HEADS, QK_NOPE_DIM + QK_ROPE_DIM)
            q_nope = q[..., :QK_NOPE_DIM]
            q_rope = apply_rope(q[..., QK_NOPE_DIM:], cos[:, :, None, :], sin[:, :, None, :])
            mix = mla_attention(q_nope, q_rope, k_nope, k_rope, v) @ w_o[j]
        x = x + g1[:, None, :] * mix
        h = modulate(x, norm2_g[l], sh2, sc2)
        x = x + g2[:, None, :] * moe_ffn(h, router_w, router_b,
                                         exp_w_gate[l], exp_w_up[l], exp_w_down[l])
    return rms_norm(x, final_g)
```

```cpp
#include <hip/hip_runtime.h>
#include <cstdio>
#include <cstdint>

#define LAS __attribute__((address_space(3)))
typedef unsigned short bf16_t;
typedef short bf16x8 __attribute__((ext_vector_type(8)));
typedef float f32x4 __attribute__((ext_vector_type(4)));
typedef float f32x2 __attribute__((ext_vector_type(2)));
typedef unsigned u32x4 __attribute__((ext_vector_type(4)));
typedef unsigned u32x2 __attribute__((ext_vector_type(2)));

#ifndef MK_ONE_LAUNCH
#define MK_ONE_LAUNCH 0
#endif

constexpr int NB = 4, SEQ = 4096, T = NB * SEQ, D = 1024, DEPTH = 4;
constexpr int CWID = 31, NH = 8, DQK = 192, QR = 384, KVR = 256;
constexpr int NE = 16, DE = 512;
constexpr float EPS = 1e-6f;
constexpr float ATTN_SCALE = 0.07216878364870322f;

constexpr size_t MiB = 1u << 20;
constexpr size_t WS_CTL = 0, CTL_BYTES = 1 * MiB;
constexpr size_t WS_MOD = 1 * MiB;
constexpr size_t WS_ROPE = 2 * MiB;
constexpr size_t WS_TOKINFO = 6 * MiB;
constexpr size_t WS_LIST = 7 * MiB;
constexpr size_t WS_WIN = 8 * MiB;
constexpr size_t WS_WOUT = 16 * MiB;
constexpr size_t WS_WDKV = 20 * MiB;
constexpr size_t WS_WUKV = 21 * MiB;
constexpr size_t WS_WDQ = 22 * MiB;
constexpr size_t WS_WUQ = 24 * MiB;
constexpr size_t WS_WO = 27 * MiB;
constexpr size_t WS_WGU = 32 * MiB;
constexpr size_t WS_WDN = 160 * MiB;
constexpr size_t WS_HA = 224 * MiB;
constexpr size_t WS_XKV = 256 * MiB;
constexpr size_t WS_U = 288 * MiB;
constexpr size_t WS_H2 = WS_U;
constexpr size_t WS_V2 = 320 * MiB;
constexpr size_t WS_AO = WS_V2;
constexpr size_t WS_YB = 352 * MiB;
constexpr size_t WS_CQRAW = 352 * MiB;
constexpr size_t WS_CKVRAW = 376 * MiB;
constexpr size_t WS_CQ = 396 * MiB;
constexpr size_t WS_LAT = 408 * MiB;
constexpr size_t WS_KROPE = 422 * MiB;
constexpr size_t WS_Q = 424 * MiB;
constexpr size_t WS_ACT = WS_Q;
constexpr size_t WS_KV = 472 * MiB;
constexpr size_t WS_END = 536 * MiB;
constexpr int NSLOT_MAX = 2 * T + NE * 128;

constexpr int CW_BAR = 4096;
constexpr int CW_CNT = 16384;

constexpr int LDS_BYTES = 147456;
constexpr int NTHREADS = 512;

#define XB_TMO      128
#define XB_XCNT(j)  (256  + 64 * (j))
#define XB_XSUB(j)  (1280 + 64 * (j))
#define XB_XGEN(j)  (2304 + 64 * (j))
#define XB_TOP      3328
#define XB_TOPGEN   3392
#define XCD_BAR_WORDS 3456
#define XB_SPIN_CAP (1u << 18)

__device__ __forceinline__ unsigned xb_ld(unsigned* p)              { return __hip_atomic_load(p, __ATOMIC_RELAXED, __HIP_MEMORY_SCOPE_AGENT); }
__device__ __forceinline__ unsigned xb_add(unsigned* p, unsigned v) { return __hip_atomic_fetch_add(p, v, __ATOMIC_RELAXED, __HIP_MEMORY_SCOPE_AGENT); }
__device__ __forceinline__ unsigned xb_xcc_id() { return (unsigned)__builtin_amdgcn_s_getreg((3 << 11) | 20) & 0xFu; }
#define XB_SPIN(cond, bar) do { unsigned _sp = 0; while (cond) { __builtin_amdgcn_s_sleep(1); \
    if ((++_sp & 255u) == 0u) { if (xb_ld(&(bar)[XB_TMO])) break; if (_sp > XB_SPIN_CAP) { atomicAdd(&(bar)[XB_TMO], 1u); break; } } } } while (0)

struct XcdBarrier { unsigned* bar; unsigned x; volatile LAS unsigned* st; };

__device__ __forceinline__ XcdBarrier xcd_barrier_post(unsigned* bar, volatile LAS unsigned* st) {
    XcdBarrier b; b.bar = bar; b.x = xb_xcc_id(); b.st = st;
    if (threadIdx.x == 0) (void)xb_add(&bar[XB_XCNT(b.x)], 1u);
    return b;
}
__device__ __forceinline__ void xcd_barrier_complete(unsigned* bar, unsigned x, unsigned& nloc, unsigned& nx) {
    const unsigned G = gridDim.x * gridDim.y * gridDim.z;
    unsigned sum, cnt, mine, sp = 0u;
    for (;;) {
        sum = 0u; cnt = 0u; mine = 0u;
#pragma unroll
        for (unsigned j = 0; j < 16; ++j) { const unsigned c = xb_ld(&bar[XB_XCNT(j)]); sum += c; cnt += (c > 0u) ? 1u : 0u; mine = (j == x) ? c : mine; }
        if (sum == G) break;
        __builtin_amdgcn_s_sleep(1);
        if ((++sp & 255u) == 0u) { if (xb_ld(&bar[XB_TMO])) break; if (sp > XB_SPIN_CAP) { atomicAdd(&bar[XB_TMO], 1u); break; } }
    }
    nloc = mine > 0u ? mine : 1u; nx = cnt > 0u ? cnt : 1u;
}
__device__ __forceinline__ void xcd_barrier(const XcdBarrier& b) {
    asm volatile("s_waitcnt vmcnt(0)" ::: "memory");
    __syncthreads();
    if (threadIdx.x == 0) {
        unsigned* bar = b.bar;
        __builtin_amdgcn_s_waitcnt(0);
        unsigned nloc = b.st[0], nx = b.st[1];
        if (nloc == 0u) { xcd_barrier_complete(bar, b.x, nloc, nx); b.st[0] = nloc; b.st[1] = nx; }
        const unsigned old = xb_add(&bar[XB_XSUB(b.x)], 1u);
        const unsigned gen = old / nloc;
        if (old + 1u == (gen + 1u) * nloc) {
            __builtin_amdgcn_fence(__ATOMIC_RELEASE, "agent");
            asm volatile("s_waitcnt vmcnt(0)" ::: "memory");
            const unsigned og = xb_add(&bar[XB_TOP], 1u);
            const unsigned tg = og / nx;
            if (og + 1u == (tg + 1u) * nx) xb_add(&bar[XB_TOPGEN], 1u);
            else XB_SPIN(xb_ld(&bar[XB_TOPGEN]) == tg, bar);
            __builtin_amdgcn_fence(__ATOMIC_ACQUIRE, "agent");
            xb_add(&bar[XB_XGEN(b.x)], 1u);
            asm volatile("s_waitcnt vmcnt(0)" ::: "memory");
        } else {
            XB_SPIN(xb_ld(&bar[XB_XGEN(b.x)]) == gen, bar);
            __builtin_amdgcn_fence(__ATOMIC_ACQUIRE, "agent");
            asm volatile("s_waitcnt vmcnt(0)" ::: "memory");
        }
    }
    __syncthreads();
}

__device__ __forceinline__ unsigned f2bf(float f) { unsigned u = __builtin_bit_cast(unsigned, f); return (u + 0x7fffu + ((u >> 16) & 1u)) >> 16; }
__device__ __forceinline__ unsigned pk2(float lo, float hi) { return f2bf(lo) | (f2bf(hi) << 16); }
__device__ __forceinline__ float bf2f(unsigned short b) { return __builtin_bit_cast(float, (unsigned)b << 16); }
__device__ __forceinline__ float bflo(unsigned w) { return __builtin_bit_cast(float, w << 16); }
__device__ __forceinline__ float bfhi(unsigned w) { return __builtin_bit_cast(float, w & 0xffff0000u); }
__device__ __forceinline__ float wave_sum(float v) {
#pragma unroll
    for (int o = 1; o < 64; o <<= 1) v += __shfl_xor(v, o);
    return v;
}
__device__ __forceinline__ float sigmoidf_(float x) { return 1.0f / (1.0f + __expf(-x)); }
__device__ __forceinline__ float siluf_(float x) { return x / (1.0f + __expf(-x)); }

struct Args { const void* in[28]; float* out; unsigned char* ws; int ph_lo, ph_hi; };
__device__ __forceinline__ int otid() { int t = threadIdx.x; asm volatile("" : "+v"(t)); return t; }
template <class P> __device__ __forceinline__ P* opq(P* p) { asm volatile("" : "+s"(p)); return p; }

constexpr int LDT = 72;
template <class Epi>
__device__ __forceinline__ void gemm_tile(LAS unsigned char* lds, const bf16_t* a0, const bf16_t* a1, const bf16_t* b0, const bf16_t* b1, int K, const Epi& epi) {
    const int tid = otid(), lane = tid & 63, wid = tid >> 6, wm = wid >> 2, wn = wid & 3, fr = lane & 15, fq = lane >> 4;
    const int srow = tid >> 3, skc = tid & 7;
    LAS bf16_t* As = (LAS bf16_t*)lds; LAS bf16_t* Bs = As + 128 * LDT;
    u32x4 ra0 = *(const u32x4*)a0, ra1 = *(const u32x4*)a1, rb0 = *(const u32x4*)b0, rb1 = *(const u32x4*)b1;
    f32x4 acc[4][2];
#pragma unroll
    for (int i = 0; i < 4; ++i)
#pragma unroll
        for (int j = 0; j < 2; ++j) acc[i][j] = (f32x4){0.f, 0.f, 0.f, 0.f};
    const int nk = K >> 6;
    for (int kt = 0; kt < nk; ++kt) {
        __syncthreads();
        *(LAS u32x4*)(As + srow * LDT + skc * 8) = ra0; *(LAS u32x4*)(As + (srow + 64) * LDT + skc * 8) = ra1;
        *(LAS u32x4*)(Bs + srow * LDT + skc * 8) = rb0; *(LAS u32x4*)(Bs + (srow + 64) * LDT + skc * 8) = rb1;
        __syncthreads();
        if (kt + 1 < nk) { const int o = (kt + 1) * 64; ra0 = *(const u32x4*)(a0 + o); ra1 = *(const u32x4*)(a1 + o); rb0 = *(const u32x4*)(b0 + o); rb1 = *(const u32x4*)(b1 + o); }
#pragma unroll
        for (int ks = 0; ks < 2; ++ks) {
            bf16x8 af[4], bfr[2];
#pragma unroll
            for (int mi = 0; mi < 4; ++mi) af[mi] = *(const LAS bf16x8*)(As + (wm * 64 + mi * 16 + fr) * LDT + ks * 32 + fq * 8);
#pragma unroll
            for (int ni = 0; ni < 2; ++ni) bfr[ni] = *(const LAS bf16x8*)(Bs + (wn * 32 + ni * 16 + fr) * LDT + ks * 32 + fq * 8);
#pragma unroll
            for (int mi = 0; mi < 4; ++mi)
#pragma unroll
                for (int ni = 0; ni < 2; ++ni) acc[mi][ni] = __builtin_amdgcn_mfma_f32_16x16x32_bf16(bfr[ni], af[mi], acc[mi][ni], 0, 0, 0);
        }
    }
    epi(wm * 64 + fr, wn, fq, acc);
}

__device__ __forceinline__ int pair_row(int ch, int half) { return (ch >> 6) * 128 + ((ch >> 4) & 3) * 32 + half * 16 + (ch & 15); }

template <int MODE>
__device__ __forceinline__ void cvt_item(const float* W, int K, int N, int ld, bf16_t* WT, int row_off_or_half, LAS float* scr, int item, int lane) {
    const int nblk = N / 32, kb = item / nblk, nb = item % nblk, k0 = 64 * kb, n0 = 32 * nb;
#pragma unroll 8
    for (int i = 0; i < 32; ++i) { const int kk = 2 * i + (lane >> 5); scr[kk * 33 + (lane & 31)] = W[(size_t)(k0 + kk) * ld + n0 + (lane & 31)]; }
    asm volatile("s_waitcnt lgkmcnt(0)" ::: "memory");
    const int c = lane & 7;
#pragma unroll
    for (int j = 0; j < 4; ++j) { const int n = (lane >> 3) + 8 * j; const LAS float* s = scr + (8 * c) * 33 + n;
        u32x4 o; o.x = pk2(s[0 * 33], s[1 * 33]); o.y = pk2(s[2 * 33], s[3 * 33]); o.z = pk2(s[4 * 33], s[5 * 33]); o.w = pk2(s[6 * 33], s[7 * 33]);
        const int drow = (MODE == 0) ? (row_off_or_half + n0 + n) : pair_row(n0 + n, row_off_or_half);
        *(u32x4*)(WT + (size_t)drow * K + k0 + 8 * c) = o; }
    asm volatile("s_waitcnt lgkmcnt(0)" ::: "memory");
}

__device__ __forceinline__ void phase_prologue(const Args& a, LAS unsigned char* lds) {
    const int tid = otid(), lane = tid & 63, wave = tid >> 6, G = gridDim.x;
    unsigned char* ws = opq(a.ws);
    {
        const float* c = (const float*)a.in[1]; const float* ada_w = (const float*)a.in[3]; const float* ada_b = (const float*)a.in[4];
        float* mod = (float*)(ws + WS_MOD);
        LAS float* cs = (LAS float*)lds;
        LAS float* red = cs + 4096;
        bool have = false;
        for (int it = blockIdx.x; it < 4 * 48; it += G) {
            if (!have) { for (int i = tid; i < 4096; i += NTHREADS) cs[i] = siluf_(c[i]); have = true; }
            __syncthreads();
            const int l = it / 48, n0 = (it % 48) * 128;
            const float* wp = ada_w + (size_t)l * D * 6144 + n0 + 2 * lane;
            float acc[4][2] = {{0.f, 0.f}, {0.f, 0.f}, {0.f, 0.f}, {0.f, 0.f}};
            const int kb = wave * 128;
#pragma unroll 4
            for (int k = 0; k < 128; ++k) {
                const f32x2 w = *(const f32x2*)(wp + (size_t)(kb + k) * 6144);
#pragma unroll
                for (int b = 0; b < 4; ++b) { const float cv = cs[b * 1024 + kb + k]; acc[b][0] += cv * w.x; acc[b][1] += cv * w.y; }
            }
#pragma unroll
            for (int b = 0; b < 4; ++b) { red[(wave * 4 + b) * 128 + 2 * lane] = acc[b][0]; red[(wave * 4 + b) * 128 + 2 * lane + 1] = acc[b][1]; }
            __syncthreads();
            { const int b = tid >> 7, col = tid & 127; float s = 0.f;
#pragma unroll
              for (int w = 0; w < 8; ++w) s += red[(w * 4 + b) * 128 + col];
              mod[((size_t)l * 4 + b) * 6144 + n0 + col] = s + ada_b[l * 6144 + n0 + col]; }
        }
        __syncthreads();
    }
    {
        const int* pos = (const int*)a.in[2]; f32x2* rt = (f32x2*)(ws + WS_ROPE);
        for (int idx = blockIdx.x * NTHREADS + tid; idx < T * 32; idx += G * NTHREADS) {
            const int t = idx >> 5, i = idx & 31;
            const float inv = exp2f(-(float)i * (13.287712379549449f / 32.0f));
            const float ang = (float)pos[t] * inv;
            const float kf = rintf(ang * 0.15915494309189535f);
            float r = fmaf(-kf, 6.28125f, ang); r = fmaf(-kf, 1.9353071795864769e-3f, r);
            rt[idx] = (f32x2){__cosf(r), __sinf(r)};
        }
    }
    {
        LAS float* scr = (LAS float*)(lds + wave * 16384);
        const int gw = blockIdx.x * 8 + wave, NGW = G * 8;
        const float* w_in = (const float*)a.in[7]; const float* w_out = (const float*)a.in[13]; const float* w_dkv = (const float*)a.in[15]; const float* w_ukv = (const float*)a.in[17];
        const float* w_dq = (const float*)a.in[18]; const float* w_uq = (const float*)a.in[20]; const float* w_o = (const float*)a.in[21];
        const float* wg = (const float*)a.in[24]; const float* wu = (const float*)a.in[25]; const float* wd = (const float*)a.in[26];
        constexpr int I_IN = 16 * 64, I_OUT = 16 * 32, I_DKV = 16 * 10, I_UKV = 4 * 64, I_DQ = 16 * 12, I_UQ = 6 * 48, I_O = 16 * 32;
        constexpr int I_G = 16 * 16, I_D = 8 * 32;
        constexpr int NSMALL = 2 * I_IN + 2 * I_OUT + I_DKV + I_UKV + 2 * I_DQ + 2 * I_UQ + 2 * I_O;
        constexpr int NEXP = 4 * 16 * (2 * I_G + I_D);
        for (int it = gw; it < NSMALL + NEXP; it += NGW) {
            int r = it;
            if (r < 2 * I_IN) { const int l = r / I_IN; r %= I_IN; const int half = r / 512;
                cvt_item<1>(w_in + (size_t)l * D * 2048 + half * 1024, D, 1024, 2048, (bf16_t*)(ws + WS_WIN) + (size_t)l * 2048 * 1024, half, scr, r % 512, lane); continue; }
            r -= 2 * I_IN;
            if (r < 2 * I_OUT) { const int l = r / I_OUT; cvt_item<0>(w_out + (size_t)l * D * D, D, D, D, (bf16_t*)(ws + WS_WOUT) + (size_t)l * D * D, 0, scr, r % I_OUT, lane); continue; }
            r -= 2 * I_OUT;
            if (r < I_DKV) { cvt_item<0>(w_dkv, D, 320, 320, (bf16_t*)(ws + WS_WDKV), 0, scr, r, lane); continue; }
            r -= I_DKV;
            if (r < I_UKV) { cvt_item<0>(w_ukv, KVR, 2048, 2048, (bf16_t*)(ws + WS_WUKV), 0, scr, r, lane); continue; }
            r -= I_UKV;
            if (r < 2 * I_DQ) { const int j = r / I_DQ; cvt_item<0>(w_dq + (size_t)j * D * QR, D, QR, QR, (bf16_t*)(ws + WS_WDQ) + (size_t)j * QR * D, 0, scr, r % I_DQ, lane); continue; }
            r -= 2 * I_DQ;
            if (r < 2 * I_UQ) { const int j = r / I_UQ; cvt_item<0>(w_uq + (size_t)j * QR * 1536, QR, 1536, 1536, (bf16_t*)(ws + WS_WUQ) + (size_t)j * 1536 * QR, 0, scr, r % I_UQ, lane); continue; }
            r -= 2 * I_UQ;
            if (r < 2 * I_O) { const int j = r / I_O; cvt_item<0>(w_o + (size_t)j * D * D, D, D, D, (bf16_t*)(ws + WS_WO) + (size_t)j * D * D, 0, scr, r % I_O, lane); continue; }
            r -= 2 * I_O;
            { const int per = 2 * I_G + I_D; const int le = r / per; r %= per;
              bf16_t* gu = (bf16_t*)(ws + WS_WGU) + (size_t)le * 1024 * 1024; bf16_t* dn = (bf16_t*)(ws + WS_WDN) + (size_t)le * 1024 * 512;
              if (r < I_G) cvt_item<1>(wg + (size_t)le * D * DE, D, DE, DE, gu, 0, scr, r, lane);
              else if (r < 2 * I_G) cvt_item<1>(wu + (size_t)le * D * DE, D, DE, DE, gu, 1, scr, r - I_G, lane);
              else cvt_item<0>(wd + (size_t)le * DE * D, DE, D, D, dn, 0, scr, r - 2 * I_G, lane); }
        }
        { u32x4* z = (u32x4*)((bf16_t*)(ws + WS_WDKV) + 320 * 1024); const int n16 = 64 * 1024 * 2 / 16;
          for (int i = blockIdx.x * NTHREADS + tid; i < n16; i += G * NTHREADS) z[i] = (u32x4){0u, 0u, 0u, 0u}; }
    }
}

__device__ __forceinline__ void row_load(const float* p, int lane, f32x4 (&v)[4]) {
#pragma unroll
    for (int j = 0; j < 4; ++j) v[j] = *(const f32x4*)(p + 4 * lane + 256 * j);
}
__device__ __forceinline__ float row_rstd(const f32x4 (&v)[4]) {
    float s = 0.f;
#pragma unroll
    for (int j = 0; j < 4; ++j) s += (v[j].x * v[j].x + v[j].y * v[j].y) + (v[j].z * v[j].z + v[j].w * v[j].w);
    return 1.0f / sqrtf(wave_sum(s) * (1.0f / D) + EPS);
}
__device__ __forceinline__ void row_modulate_store(const f32x4 (&v)[4], float r, const float* g, const float* sc, const float* sh, bf16_t* orow, int lane, f32x4 (*hout)[4] = nullptr) {
#pragma unroll
    for (int j = 0; j < 4; ++j) {
        const int c = 4 * lane + 256 * j;
        const f32x4 gv = *(const f32x4*)(g + c);
        f32x4 h = v[j] * r * gv;
        if (sc) { const f32x4 s1 = *(const f32x4*)(sc + c), s0 = *(const f32x4*)(sh + c); h = h * (s1 + 1.0f) + s0; }
        if (hout) (*hout)[j] = h;
        u32x2 o; o.x = pk2(h.x, h.y); o.y = pk2(h.z, h.w);
        *(u32x2*)(orow + c) = o;
    }
}

__device__ __forceinline__ void phase_mod0(const Args& a) {
    const int tid_ = otid(); const int lane = tid_ & 63, gw = blockIdx.x * 8 + (tid_ >> 6), NGW = gridDim.x * 8;
    const float* x = (const float*)a.in[0]; const float* g = (const float*)a.in[5]; const float* mod = (const float*)(a.ws + WS_MOD);
    bf16_t* HA = (bf16_t*)(a.ws + WS_HA);
    for (int row = gw; row < T; row += NGW) {
        f32x4 v[4]; row_load(x + (size_t)row * D, lane, v);
#pragma unroll
        for (int j = 0; j < 4; ++j) *(f32x4*)(a.out + (size_t)row * D + 4 * lane + 256 * j) = v[j];
        const float r = row_rstd(v); const int b = row / SEQ;
        row_modulate_store(v, r, g, mod + (size_t)b * 6144 + 1024, mod + (size_t)b * 6144, HA + (size_t)row * D, lane);
    }
}

struct EpiGLU {
    bf16_t* U; const float* bias; int row0, tn;
    __device__ __forceinline__ void operator()(int r0, int wn, int fq, const f32x4 (&acc)[4][2]) const {
        const int ch = tn * 64 + wn * 16 + 4 * fq;
        const f32x4 ba = *(const f32x4*)(bias + ch), bg = *(const f32x4*)(bias + 1024 + ch);
#pragma unroll
        for (int mi = 0; mi < 4; ++mi) { const f32x4 av = acc[mi][0] + ba, gv = acc[mi][1] + bg;
            u32x2 o; o.x = pk2(av.x * sigmoidf_(gv.x), av.y * sigmoidf_(gv.y)); o.y = pk2(av.z * sigmoidf_(gv.z), av.w * sigmoidf_(gv.w));
            *(u32x2*)(U + (size_t)(row0 + r0 + 16 * mi) * D + ch) = o; }
    }
};
struct EpiSwiGLU {
    bf16_t* ACT; int row0, tn;
    __device__ __forceinline__ void operator()(int r0, int wn, int fq, const f32x4 (&acc)[4][2]) const {
        const int ch = tn * 64 + wn * 16 + 4 * fq;
#pragma unroll
        for (int mi = 0; mi < 4; ++mi) { const f32x4 gv = acc[mi][0], uv = acc[mi][1];
            u32x2 o; o.x = pk2(siluf_(gv.x) * uv.x, siluf_(gv.y) * uv.y); o.y = pk2(siluf_(gv.z) * uv.z, siluf_(gv.w) * uv.w);
            *(u32x2*)(ACT + (size_t)(row0 + r0 + 16 * mi) * DE + ch) = o; }
    }
};
struct EpiResid {
    float* X; const float* gate; int row0, col0;
    __device__ __forceinline__ void operator()(int r0, int wn, int fq, const f32x4 (&acc)[4][2]) const {
#pragma unroll
        for (int ni = 0; ni < 2; ++ni) { const int c = col0 + wn * 32 + ni * 16 + 4 * fq; const f32x4 gv = *(const f32x4*)(gate + c);
#pragma unroll
            for (int mi = 0; mi < 4; ++mi) { float* p = X + (size_t)(row0 + r0 + 16 * mi) * D + c; *(f32x4*)p = *(const f32x4*)p + gv * acc[mi][ni]; } }
    }
};
struct EpiBf16 {
    bf16_t* O; int ldc, row0, col0;
    __device__ __forceinline__ void operator()(int r0, int wn, int fq, const f32x4 (&acc)[4][2]) const {
#pragma unroll
        for (int ni = 0; ni < 2; ++ni) { const int c = col0 + wn * 32 + ni * 16 + 4 * fq;
#pragma unroll
            for (int mi = 0; mi < 4; ++mi) { u32x2 o; o.x = pk2(acc[mi][ni].x, acc[mi][ni].y); o.y = pk2(acc[mi][ni].z, acc[mi][ni].w);
                *(u32x2*)(O + (size_t)(row0 + r0 + 16 * mi) * ldc + c) = o; } }
    }
};
struct EpiF32 {
    float* O; int ldc, row0, col0, ncols;
    __device__ __forceinline__ void operator()(int r0, int wn, int fq, const f32x4 (&acc)[4][2]) const {
#pragma unroll
        for (int ni = 0; ni < 2; ++ni) { const int c = col0 + wn * 32 + ni * 16 + 4 * fq;
            if (c < ncols) {
#pragma unroll
                for (int mi = 0; mi < 4; ++mi) *(f32x4*)(O + (size_t)(row0 + r0 + 16 * mi) * ldc + c) = acc[mi][ni]; } }
    }
};

template <class F>
__device__ __forceinline__ void gemm_phase_plain(LAS unsigned char* lds, const bf16_t* A, int lda, const bf16_t* Bt, int K, int ntm, int ntn, F&& mk, int ubase, int utotal) {
    const int tid_ = otid(); const int srow = tid_ >> 3, skc = tid_ & 7;
    for (int u = blockIdx.x; u < utotal; u += gridDim.x) {
        const int v = u - ubase; if (v < 0 || v >= ntm * ntn) continue;
        const int tm = v / ntn, tn = v % ntn;
        const bf16_t* a0 = A + (size_t)(tm * 128 + srow) * lda + skc * 8; const bf16_t* b0 = Bt + (size_t)(tn * 128 + srow) * K + skc * 8;
        gemm_tile(lds, a0, a0 + (size_t)64 * lda, b0, b0 + (size_t)64 * K, K, mk(tm, tn));
    }
}

__device__ __forceinline__ void phase_conv(const Args& a, LAS unsigned char* lds, int l) {
    const int tid = otid(), lane = tid & 63, wave = tid >> 6;
    const bf16_t* U = (const bf16_t*)(a.ws + WS_U); bf16_t* V2 = (bf16_t*)(a.ws + WS_V2);
    const float* w_dw = (const float*)a.in[9] + (size_t)l * CWID * D; const float* b_dw = (const float*)a.in[10] + l * D;
    const float* ln_g = (const float*)a.in[11] + l * D; const float* ln_b = (const float*)a.in[12] + l * D;
    constexpr int RC = 16, NR = RC + CWID - 1;
    LAS unsigned* ub = (LAS unsigned*)lds;
    LAS float* red = (LAS float*)(lds + NR * 2048);
    const int c = 2 * tid;
    float w0[CWID], w1[CWID];
#pragma unroll
    for (int j = 0; j < CWID; ++j) { const f32x2 w = *(const f32x2*)(w_dw + (size_t)j * D + c); w0[j] = w.x; w1[j] = w.y; }
    const f32x2 bd = *(const f32x2*)(b_dw + c), lg = *(const f32x2*)(ln_g + c), lb = *(const f32x2*)(ln_b + c);
    for (int it = blockIdx.x; it < T / RC; it += gridDim.x) {
        const int b = it / (SEQ / RC), t0 = (it % (SEQ / RC)) * RC;
        __syncthreads();
        for (int i = tid; i < NR * 128; i += NTHREADS) { const int rr = i >> 7, ch = i & 127; const int t = t0 - (CWID - 1) + rr;
            u32x4 val = (u32x4){0u, 0u, 0u, 0u};
            if (t >= 0) val = *(const u32x4*)(U + ((size_t)b * SEQ + t) * D + ch * 8);
            *(LAS u32x4*)(ub + rr * 512 + ch * 4) = val; }
        __syncthreads();
        float o0[RC], o1[RC];
#pragma unroll
        for (int t = 0; t < RC; ++t) { float s0 = bd.x, s1 = bd.y;
#pragma unroll
            for (int j = 0; j < CWID; ++j) { const unsigned w = ub[(t + j) * 512 + tid]; s0 += bflo(w) * w0[j]; s1 += bfhi(w) * w1[j]; }
            o0[t] = s0; o1[t] = s1; }
#pragma unroll
        for (int t = 0; t < RC; ++t) { const float s = wave_sum(o0[t] + o1[t]); const float q = wave_sum(o0[t] * o0[t] + o1[t] * o1[t]);
            if (lane == 0) { red[(wave * RC + t) * 2] = s; red[(wave * RC + t) * 2 + 1] = q; } }
        __syncthreads();
#pragma unroll
        for (int t = 0; t < RC; ++t) { float s = 0.f, q = 0.f;
#pragma unroll
            for (int w = 0; w < 8; ++w) { s += red[(w * RC + t) * 2]; q += red[(w * RC + t) * 2 + 1]; }
            const float mean = s * (1.0f / D); const float var = fmaxf(q * (1.0f / D) - mean * mean, 0.f); const float rstd = 1.0f / sqrtf(var + EPS);
            const float y0 = (o0[t] - mean) * rstd * lg.x + lb.x, y1 = (o1[t] - mean) * rstd * lg.y + lb.y;
            *(unsigned*)(V2 + ((size_t)b * SEQ + t0 + t) * D + c) = pk2(siluf_(y0), siluf_(y1)); }
    }
}

__device__ __forceinline__ float top2sum4(float a, float b, float c, float d) {
    return fmaxf(fmaxf(fmaxf(a + b, a + c), fmaxf(a + d, b + c)), fmaxf(b + d, c + d));
}
__device__ __forceinline__ void phase_route(const Args& a, LAS unsigned char* lds, int l) {
    const int tid = otid(), lane = tid & 63, wave = tid >> 6, G = gridDim.x;
    const float* X = a.out; bf16_t* H2 = (bf16_t*)(a.ws + WS_H2);
    const float* g = (const float*)a.in[6] + l * D; const float* mod = (const float*)(a.ws + WS_MOD) + (size_t)l * 4 * 6144;
    const float* rw_g = (const float*)a.in[22]; const float* rb = (const float*)a.in[23];
    unsigned* cnt = (unsigned*)(a.ws + WS_CTL) + CW_CNT + 64 * l;
    int* list = (int*)(a.ws + WS_LIST); int* tokinfo = (int*)(a.ws + WS_TOKINFO);
    LAS float* rw = (LAS float*)lds;
    LAS int* lcnt = (LAS int*)(lds + 65536);
    LAS int* sel = (LAS int*)(lds + 65536 + 256);
    for (int i = tid; i < 1024 * 16 / 4; i += NTHREADS) *(LAS f32x4*)(rw + 4 * i) = *(const f32x4*)(rw_g + 4 * i);
    if (tid < 32) lcnt[tid] = 0;
    __syncthreads();
    float rbv[16];
#pragma unroll
    for (int e = 0; e < 16; ++e) rbv[e] = rb[e];
    int nloc = 0;
    for (int base = blockIdx.x * 8; base < T; base += G * 8, ++nloc) {
        const int row = base + wave; const int b = row / SEQ;
        f32x4 v[4]; row_load(X + (size_t)row * D, lane, v);
        const float r = row_rstd(v);
        f32x4 h[4];
        row_modulate_store(v, r, g, mod + (size_t)b * 6144 + 4 * 1024, mod + (size_t)b * 6144 + 3 * 1024, H2 + (size_t)row * D, lane, &h);
        float lg[16];
#pragma unroll
        for (int e = 0; e < 16; ++e) lg[e] = 0.f;
#pragma unroll
        for (int j = 0; j < 4; ++j)
#pragma unroll
            for (int i = 0; i < 4; ++i) { const int c = 4 * lane + 256 * j + i; const float hv = h[j][i];
#pragma unroll
                for (int q = 0; q < 4; ++q) { const f32x4 w = *(const LAS f32x4*)(rw + c * 16 + 4 * q);
                    lg[4 * q + 0] += hv * w.x; lg[4 * q + 1] += hv * w.y; lg[4 * q + 2] += hv * w.z; lg[4 * q + 3] += hv * w.w; } }
        float s[16], sb[16];
#pragma unroll
        for (int e = 0; e < 16; ++e) { s[e] = 1.0f / (1.0f + expf(-wave_sum(lg[e]))); sb[e] = s[e] + rbv[e]; }
        float best = -1e30f; int gi = 0; float wb0 = 0, wb1 = 0, wb2 = 0, wb3 = 0, ws0 = 0, ws1 = 0, ws2 = 0, ws3 = 0;
#pragma unroll
        for (int q = 0; q < 4; ++q) { const float gs = top2sum4(sb[4 * q], sb[4 * q + 1], sb[4 * q + 2], sb[4 * q + 3]);
            if (gs > best) { best = gs; gi = q; wb0 = sb[4 * q]; wb1 = sb[4 * q + 1]; wb2 = sb[4 * q + 2]; wb3 = sb[4 * q + 3]; ws0 = s[4 * q]; ws1 = s[4 * q + 1]; ws2 = s[4 * q + 2]; ws3 = s[4 * q + 3]; } }
        int i1 = 0; float m1 = wb0, sv1 = ws0;
        if (wb1 > m1) { m1 = wb1; i1 = 1; sv1 = ws1; } if (wb2 > m1) { m1 = wb2; i1 = 2; sv1 = ws2; } if (wb3 > m1) { m1 = wb3; i1 = 3; sv1 = ws3; }
        int i2 = -1; float m2 = -1e30f, sv2 = 0.f;
        if (i1 != 0 && wb0 > m2) { m2 = wb0; i2 = 0; sv2 = ws0; } if (i1 != 1 && wb1 > m2) { m2 = wb1; i2 = 1; sv2 = ws1; }
        if (i1 != 2 && wb2 > m2) { m2 = wb2; i2 = 2; sv2 = ws2; } if (i1 != 3 && wb3 > m2) { m2 = wb3; i2 = 3; sv2 = ws3; }
        const int e0 = 4 * gi + i1, e1 = 4 * gi + i2; const float wsum = sv1 + sv2; const float w0 = sv1 / wsum, w1 = sv2 / wsum;
        if (lane == 0) { const int lp0 = atomicAdd((int*)&lcnt[e0], 1), lp1 = atomicAdd((int*)&lcnt[e1], 1);
            LAS int* sp = sel + (nloc * 8 + wave) * 8; sp[0] = row; sp[1] = e0; sp[2] = e1; sp[3] = lp0; sp[4] = lp1; sp[5] = __builtin_bit_cast(int, w0); sp[6] = __builtin_bit_cast(int, w1); }
    }
    __syncthreads();
    if (tid < 16) lcnt[16 + tid] = (int)atomicAdd(&cnt[tid], (unsigned)lcnt[tid]);
    __syncthreads();
    for (int i = tid; i < nloc * 8; i += NTHREADS) { const LAS int* sp = sel + i * 8; const int row = sp[0], e0 = sp[1], e1 = sp[2];
        const int p0 = lcnt[16 + e0] + sp[3], p1 = lcnt[16 + e1] + sp[4];
        list[(size_t)e0 * T + p0] = row; list[(size_t)e1 * T + p1] = row;
        int* ti = tokinfo + (size_t)row * 8; ti[0] = e0; ti[1] = p0; ti[2] = sp[5]; ti[3] = e1; ti[4] = p1; ti[5] = sp[6]; }
    __syncthreads();
}

__device__ __forceinline__ void moe_tiles(const unsigned* cnt, LAS int* tb, LAS int* cn) {
    if (threadIdx.x == 0) { int s = 0; for (int e = 0; e < 16; ++e) { const int c = (int)cnt[e]; cn[e] = c; tb[e] = s; s += (c + 127) >> 7; } tb[16] = s; }
    __syncthreads();
}
__device__ __forceinline__ void phase_moe_up(const Args& a, LAS unsigned char* lds, int l) {
    LAS int* tb = (LAS int*)(lds + 40960); LAS int* cn = tb + 32;
    const unsigned* cnt = (const unsigned*)(a.ws + WS_CTL) + CW_CNT + 64 * l;
    moe_tiles(cnt, tb, cn);
    const int NT = tb[16]; const int tid_ = otid(); const int srow = tid_ >> 3, skc = tid_ & 7;
    const bf16_t* H2 = (const bf16_t*)(a.ws + WS_H2); const int* list = (const int*)(a.ws + WS_LIST);
    const bf16_t* WGU = (const bf16_t*)(a.ws + WS_WGU) + (size_t)l * 16 * 1024 * 1024;
    for (int u = blockIdx.x; u < NT * 8; u += gridDim.x) {
        const int rt = u >> 3, tn = u & 7; int e = 0;
#pragma unroll
        for (int q = 1; q < 16; ++q) e += (rt >= tb[q]) ? 1 : 0;
        const int p0 = (rt - tb[e]) * 128 + srow, p1 = p0 + 64, c = cn[e];
        const int tok0 = p0 < c ? list[(size_t)e * T + p0] : 0, tok1 = p1 < c ? list[(size_t)e * T + p1] : 0;
        const bf16_t* b0 = WGU + ((size_t)e * 1024 + tn * 128 + srow) * 1024 + skc * 8;
        gemm_tile(lds, H2 + (size_t)tok0 * D + skc * 8, H2 + (size_t)tok1 * D + skc * 8, b0, b0 + (size_t)64 * 1024, D, EpiSwiGLU{(bf16_t*)(a.ws + WS_ACT), rt * 128, tn});
    }
}
__device__ __forceinline__ void phase_moe_down(const Args& a, LAS unsigned char* lds, int l) {
    LAS int* tb = (LAS int*)(lds + 40960); LAS int* cn = tb + 32;
    const unsigned* cnt = (const unsigned*)(a.ws + WS_CTL) + CW_CNT + 64 * l;
    moe_tiles(cnt, tb, cn);
    const int NT = tb[16]; const int tid_ = otid(); const int srow = tid_ >> 3, skc = tid_ & 7;
    const bf16_t* ACT = (const bf16_t*)(a.ws + WS_ACT);
    const bf16_t* WDN = (const bf16_t*)(a.ws + WS_WDN) + (size_t)l * 16 * 1024 * 512;
    for (int u = blockIdx.x; u < NT * 8; u += gridDim.x) {
        const int rt = u >> 3, tn = u & 7; int e = 0;
#pragma unroll
        for (int q = 1; q < 16; ++q) e += (rt >= tb[q]) ? 1 : 0;
        const bf16_t* a0 = ACT + (size_t)(rt * 128 + srow) * DE + skc * 8;
        const bf16_t* b0 = WDN + ((size_t)e * 1024 + tn * 128 + srow) * DE + skc * 8;
        gemm_tile(lds, a0, a0 + (size_t)64 * DE, b0, b0 + (size_t)64 * DE, DE, EpiBf16{(bf16_t*)(a.ws + WS_YB), D, rt * 128, tn * 128});
    }
}
__device__ __forceinline__ void phase_combine(const Args& a, LAS unsigned char* lds, int l) {
    LAS int* tb = (LAS int*)(lds + 40960); LAS int* cn = tb + 32;
    const unsigned* cnt = (const unsigned*)(a.ws + WS_CTL) + CW_CNT + 64 * l;
    moe_tiles(cnt, tb, cn);
    const int tid_ = otid(); const int lane = tid_ & 63, gw = blockIdx.x * 8 + (tid_ >> 6), NGW = gridDim.x * 8;
    float* X = a.out; const bf16_t* YB = (const bf16_t*)(a.ws + WS_YB); const int* tokinfo = (const int*)(a.ws + WS_TOKINFO);
    const float* mod = (const float*)(a.ws + WS_MOD);
    for (int row = gw; row < T; row += NGW) {
        const int b = row / SEQ; const int* ti = tokinfo + (size_t)row * 8;
        const int e0 = ti[0], p0 = ti[1], e1 = ti[3], p1 = ti[4]; const float w0 = __builtin_bit_cast(float, ti[2]), w1 = __builtin_bit_cast(float, ti[5]);
        const bf16_t* y0 = YB + (size_t)(tb[e0] * 128 + p0) * D; const bf16_t* y1 = YB + (size_t)(tb[e1] * 128 + p1) * D;
        const float* g2 = mod + ((size_t)l * 4 + b) * 6144 + 5 * 1024;
        f32x4 v[4]; row_load(X + (size_t)row * D, lane, v);
#pragma unroll
        for (int j = 0; j < 4; ++j) { const int c = 4 * lane + 256 * j; const u32x2 a0 = *(const u32x2*)(y0 + c), a1 = *(const u32x2*)(y1 + c); const f32x4 gv = *(const f32x4*)(g2 + c);
            f32x4 y; y.x = w0 * bflo(a0.x) + w1 * bflo(a1.x); y.y = w0 * bfhi(a0.x) + w1 * bfhi(a1.x); y.z = w0 * bflo(a0.y) + w1 * bflo(a1.y); y.w = w0 * bfhi(a0.y) + w1 * bfhi(a1.y);
            v[j] = v[j] + gv * y; }
        const float r = row_rstd(v);
        if (l == DEPTH - 1) {
            const float* fg = (const float*)a.in[27];
#pragma unroll
            for (int j = 0; j < 4; ++j) { const int c = 4 * lane + 256 * j; *(f32x4*)(X + (size_t)row * D + c) = v[j] * r * *(const f32x4*)(fg + c); }
        } else {
#pragma unroll
            for (int j = 0; j < 4; ++j) *(f32x4*)(X + (size_t)row * D + 4 * lane + 256 * j) = v[j];
            const float* mn = mod + ((size_t)(l + 1) * 4 + b) * 6144;
            row_modulate_store(v, r, (const float*)a.in[5] + (l + 1) * D, mn + 1024, mn, (bf16_t*)(a.ws + WS_HA) + (size_t)row * D, lane);
            if (l == 1) row_modulate_store(v, r, (const float*)a.in[14], nullptr, nullptr, (bf16_t*)(a.ws + WS_XKV) + (size_t)row * D, lane);
        }
    }
}

__device__ __forceinline__ void phase_mla_norm(const Args& a, int j) {
    const int tid_ = otid(); const int lane = tid_ & 63, gw = blockIdx.x * 8 + (tid_ >> 6), NGW = gridDim.x * 8;
    const float* CQRAW = (const float*)(a.ws + WS_CQRAW); const float* CKVRAW = (const float*)(a.ws + WS_CKVRAW);
    bf16_t* CQ = (bf16_t*)(a.ws + WS_CQ); bf16_t* LAT = (bf16_t*)(a.ws + WS_LAT); bf16_t* KROPE = (bf16_t*)(a.ws + WS_KROPE);
    const float* qg = (const float*)a.in[19] + j * QR; const float* kg = (const float*)a.in[16]; const f32x2* rope = (const f32x2*)(a.ws + WS_ROPE);
    for (int row = gw; row < T; row += NGW) {
        { f32x2 v[3]; float s = 0.f;
#pragma unroll
          for (int q = 0; q < 3; ++q) { v[q] = *(const f32x2*)(CQRAW + (size_t)row * QR + 2 * lane + 128 * q); s += v[q].x * v[q].x + v[q].y * v[q].y; }
          const float r = 1.0f / sqrtf(wave_sum(s) * (1.0f / QR) + EPS);
#pragma unroll
          for (int q = 0; q < 3; ++q) { const int c = 2 * lane + 128 * q; const f32x2 gv = *(const f32x2*)(qg + c); *(unsigned*)(CQ + (size_t)row * QR + c) = pk2(v[q].x * r * gv.x, v[q].y * r * gv.y); } }
        if (j == 0) {
            const f32x4 v = *(const f32x4*)(CKVRAW + (size_t)row * 320 + 4 * lane);
            const float s = (v.x * v.x + v.y * v.y) + (v.z * v.z + v.w * v.w);
            const float r = 1.0f / sqrtf(wave_sum(s) * (1.0f / KVR) + EPS);
            const f32x4 gv = *(const f32x4*)(kg + 4 * lane);
            u32x2 o; o.x = pk2(v.x * r * gv.x, v.y * r * gv.y); o.y = pk2(v.z * r * gv.z, v.w * r * gv.w);
            *(u32x2*)(LAT + (size_t)row * KVR + 4 * lane) = o;
            if (lane < 32) { const float x1 = CKVRAW[(size_t)row * 320 + 256 + lane], x2 = CKVRAW[(size_t)row * 320 + 288 + lane]; const f32x2 cs = rope[(size_t)row * 32 + lane];
                KROPE[(size_t)row * 64 + lane] = (bf16_t)f2bf(x1 * cs.x - x2 * cs.y); KROPE[(size_t)row * 64 + 32 + lane] = (bf16_t)f2bf(x1 * cs.y + x2 * cs.x); }
        }
    }
}

__device__ __forceinline__ void phase_attn(const Args& a, LAS unsigned char* lds) {
    const int tid = otid(), lane = tid & 63, w = tid >> 6, fr = lane & 15, fq = lane >> 4, G = gridDim.x;
    constexpr int KP = 200, VP = 72;
    LAS bf16_t* Ks = (LAS bf16_t*)lds;
    LAS bf16_t* Vt = Ks + 64 * KP;
    LAS bf16_t* Ps = Vt + 128 * VP;
    const bf16_t* Q = (const bf16_t*)(a.ws + WS_Q); const bf16_t* KV = (const bf16_t*)(a.ws + WS_KV); const bf16_t* KR = (const bf16_t*)(a.ws + WS_KROPE);
    bf16_t* AO = (bf16_t*)(a.ws + WS_AO); const f32x2* rope = (const f32x2*)(a.ws + WS_ROPE);
    constexpr int NU = NB * NH * (SEQ / 128);
    for (int rd = 0; rd * G < NU; ++rd) {
        const int s = rd * G + ((rd & 1) ? (G - 1 - (int)blockIdx.x) : (int)blockIdx.x);
        if (s >= NU) continue;
        const int qb = (SEQ / 128 - 1) - s / (NB * NH), bh = s % (NB * NH), b = bh / NH, h = bh % NH;
        const int q0 = qb * 128; const size_t tb0 = (size_t)b * SEQ;
        bf16x8 qf[6];
        { const size_t row = tb0 + q0 + 16 * w + fr; const bf16_t* qp = Q + row * 1536 + h * DQK + 8 * fq;
#pragma unroll
          for (int ks = 0; ks < 6; ++ks) qf[ks] = *(const bf16x8*)(qp + 32 * ks);
#pragma unroll
          for (int j = 0; j < 8; ++j) { const f32x2 cs = rope[row * 32 + 8 * fq + j]; const float x1 = bf2f((unsigned short)qf[4][j]), x2 = bf2f((unsigned short)qf[5][j]);
              qf[4][j] = (short)f2bf(x1 * cs.x - x2 * cs.y); qf[5][j] = (short)f2bf(x1 * cs.y + x2 * cs.x); } }
        f32x4 o[8]; float m[4], lsum[4];
#pragma unroll
        for (int i = 0; i < 8; ++i) o[i] = (f32x4){0.f, 0.f, 0.f, 0.f};
#pragma unroll
        for (int i = 0; i < 4; ++i) { m[i] = -1e30f; lsum[i] = 0.f; }
        const int ntile = 2 * (qb + 1);
        for (int jt = 0; jt < ntile; ++jt) {
            __syncthreads();
#pragma unroll
            for (int i = 0; i < 3; ++i) { const int c = tid + NTHREADS * i, key = c / 24, ch = c % 24; const size_t tok = tb0 + jt * 64 + key;
                const u32x4 v = (ch < 16) ? *(const u32x4*)(KV + tok * 2048 + h * 256 + ch * 8) : *(const u32x4*)(KR + tok * 64 + (ch - 16) * 8);
                *(LAS u32x4*)(Ks + key * KP + ch * 8) = v; }
#pragma unroll
            for (int i = 0; i < 2; ++i) { const int c = tid + NTHREADS * i, key = c & 63, d8 = c >> 6; const size_t tok = tb0 + jt * 64 + key;
                const u32x4 v = *(const u32x4*)(KV + tok * 2048 + h * 256 + 128 + d8 * 8);
                LAS bf16_t* vp = Vt + (d8 * 8) * VP + key;
                vp[0 * VP] = (bf16_t)(v.x & 0xffffu); vp[1 * VP] = (bf16_t)(v.x >> 16); vp[2 * VP] = (bf16_t)(v.y & 0xffffu); vp[3 * VP] = (bf16_t)(v.y >> 16);
                vp[4 * VP] = (bf16_t)(v.z & 0xffffu); vp[5 * VP] = (bf16_t)(v.z >> 16); vp[6 * VP] = (bf16_t)(v.w & 0xffffu); vp[7 * VP] = (bf16_t)(v.w >> 16); }
            __syncthreads();
            f32x4 sc[4];
#pragma unroll
            for (int n = 0; n < 4; ++n) { sc[n] = (f32x4){0.f, 0.f, 0.f, 0.f};
#pragma unroll
                for (int ks = 0; ks < 6; ++ks) { const bf16x8 kf = *(const LAS bf16x8*)(Ks + (16 * n + fr) * KP + 32 * ks + 8 * fq);
                    sc[n] = __builtin_amdgcn_mfma_f32_16x16x32_bf16(qf[ks], kf, sc[n], 0, 0, 0); } }
            const bool diag = (jt * 64 + 63 > q0 + 16 * w);
#pragma unroll
            for (int n = 0; n < 4; ++n)
#pragma unroll
                for (int rg = 0; rg < 4; ++rg) { float v = sc[n][rg] * ATTN_SCALE;
                    if (diag && (jt * 64 + 16 * n + fr > q0 + 16 * w + 4 * fq + rg)) v = -1e30f;
                    sc[n][rg] = v; }
            float alpha[4];
#pragma unroll
            for (int rg = 0; rg < 4; ++rg) { float mx = fmaxf(fmaxf(sc[0][rg], sc[1][rg]), fmaxf(sc[2][rg], sc[3][rg]));
                mx = fmaxf(mx, __shfl_xor(mx, 1)); mx = fmaxf(mx, __shfl_xor(mx, 2)); mx = fmaxf(mx, __shfl_xor(mx, 4)); mx = fmaxf(mx, __shfl_xor(mx, 8));
                const float mn = fmaxf(m[rg], mx); alpha[rg] = __expf(m[rg] - mn); m[rg] = mn;
                float rs = 0.f;
#pragma unroll
                for (int n = 0; n < 4; ++n) { const float p = __expf(sc[n][rg] - mn); sc[n][rg] = p; rs += p; }
                rs += __shfl_xor(rs, 1); rs += __shfl_xor(rs, 2); rs += __shfl_xor(rs, 4); rs += __shfl_xor(rs, 8);
                lsum[rg] = lsum[rg] * alpha[rg] + rs; }
#pragma unroll
            for (int nd = 0; nd < 8; ++nd) { o[nd].x *= alpha[0]; o[nd].y *= alpha[1]; o[nd].z *= alpha[2]; o[nd].w *= alpha[3]; }
            LAS bf16_t* pw = Ps + w * 16 * VP;
#pragma unroll
            for (int n = 0; n < 4; ++n)
#pragma unroll
                for (int rg = 0; rg < 4; ++rg) pw[(4 * fq + rg) * VP + 16 * n + fr] = (bf16_t)f2bf(sc[n][rg]);
            __syncthreads();
#pragma unroll
            for (int s2 = 0; s2 < 2; ++s2) { const bf16x8 pf = *(const LAS bf16x8*)(pw + fr * VP + 32 * s2 + 8 * fq);
#pragma unroll
                for (int nd = 0; nd < 8; ++nd) { const bf16x8 vf = *(const LAS bf16x8*)(Vt + (16 * nd + fr) * VP + 32 * s2 + 8 * fq);
                    o[nd] = __builtin_amdgcn_mfma_f32_16x16x32_bf16(pf, vf, o[nd], 0, 0, 0); } }
        }
#pragma unroll
        for (int rg = 0; rg < 4; ++rg) { const float inv = 1.0f / lsum[rg]; const size_t row = tb0 + q0 + 16 * w + 4 * fq + rg;
#pragma unroll
            for (int nd = 0; nd < 8; ++nd) AO[row * D + h * 128 + 16 * nd + fr] = (bf16_t)f2bf(o[nd][rg] * inv); }
    }
}

constexpr int PH_PER_LAYER = 9, NPHASE = 2 + DEPTH * PH_PER_LAYER;
__global__ void __launch_bounds__(NTHREADS, 2) fwd(Args a) {
    extern __shared__ __attribute__((aligned(16))) unsigned char lds_raw[];
    LAS unsigned char* lds = (LAS unsigned char*)lds_raw;
    const int lo = a.ph_lo, hi = a.ph_hi;
    volatile LAS unsigned* misc = (volatile LAS unsigned*)(lds + 131072 + 320);
    if (threadIdx.x < 32) misc[threadIdx.x] = 0u;
    __syncthreads();
    XcdBarrier bar; bar.bar = (unsigned*)(a.ws + WS_CTL) + CW_BAR; bar.x = 0; bar.st = misc + 8;
    if (hi - lo > 1) bar = xcd_barrier_post((unsigned*)(a.ws + WS_CTL) + CW_BAR, misc + 8);
#define IN(k) (lo <= (k) && (k) < hi)
#define SEAM(k) do { if ((k) + 1 < hi) xcd_barrier(bar); } while (0)
    unsigned char* ws = a.ws;
    const float* mod = (const float*)(ws + WS_MOD);

    if (IN(0)) { phase_prologue(a, lds); SEAM(0); }
    if (IN(1)) { phase_mod0(a); SEAM(1); }
#pragma unroll 1
    for (int l = 0; l < DEPTH; ++l) {
        const int pb = 2 + PH_PER_LAYER * l;
        if (l < 2) {
            if (IN(pb + 0)) {
                const bf16_t* Bt = (const bf16_t*)(ws + WS_WIN) + (size_t)l * 2048 * 1024; bf16_t* U = (bf16_t*)(ws + WS_U); const float* bias = (const float*)a.in[8] + l * 2048;
                gemm_phase_plain(lds, (const bf16_t*)(ws + WS_HA), D, Bt, D, T / 128, 16, [&](int tm, int tn) { return EpiGLU{U, bias, tm * 128, tn}; }, 0, (T / 128) * 16);
                SEAM(pb + 0); }
            if (IN(pb + 1)) { phase_conv(a, lds, l); SEAM(pb + 1); }
            if (IN(pb + 2)) {
                const bf16_t* Bt = (const bf16_t*)(ws + WS_WOUT) + (size_t)l * D * D; float* X = a.out;
                gemm_phase_plain(lds, (const bf16_t*)(ws + WS_V2), D, Bt, D, T / 128, 8, [&](int tm, int tn) { return EpiResid{X, mod + ((size_t)l * 4 + (tm * 128) / SEQ) * 6144 + 2048, tm * 128, tn * 128}; }, 0, (T / 128) * 8);
                SEAM(pb + 2); }
        } else {
            const int j = l - 2;
            if (IN(pb + 0)) {
                const int nq = (T / 128) * 3, tot = nq + (j == 0 ? nq : 0);
                float* CQRAW = (float*)(ws + WS_CQRAW); float* CKVRAW = (float*)(ws + WS_CKVRAW);
                gemm_phase_plain(lds, (const bf16_t*)(ws + WS_HA), D, (const bf16_t*)(ws + WS_WDQ) + (size_t)j * QR * D, D, T / 128, 3, [&](int tm, int tn) { return EpiF32{CQRAW, QR, tm * 128, tn * 128, QR}; }, 0, tot);
                if (j == 0) gemm_phase_plain(lds, (const bf16_t*)(ws + WS_XKV), D, (const bf16_t*)(ws + WS_WDKV), D, T / 128, 3, [&](int tm, int tn) { return EpiF32{CKVRAW, 320, tm * 128, tn * 128, 320}; }, nq, tot);
                SEAM(pb + 0); }
            if (IN(pb + 1)) { phase_mla_norm(a, j); SEAM(pb + 1); }
            if (IN(pb + 2)) {
                const int nq = (T / 128) * 12, nkv = (T / 128) * 16, tot = nq + (j == 0 ? nkv : 0);
                bf16_t* Qb = (bf16_t*)(ws + WS_Q); bf16_t* KVb = (bf16_t*)(ws + WS_KV);
                gemm_phase_plain(lds, (const bf16_t*)(ws + WS_CQ), QR, (const bf16_t*)(ws + WS_WUQ) + (size_t)j * 1536 * QR, QR, T / 128, 12, [&](int tm, int tn) { return EpiBf16{Qb, 1536, tm * 128, tn * 128}; }, 0, tot);
                if (j == 0) gemm_phase_plain(lds, (const bf16_t*)(ws + WS_LAT), KVR, (const bf16_t*)(ws + WS_WUKV), KVR, T / 128, 16, [&](int tm, int tn) { return EpiBf16{KVb, 2048, tm * 128, tn * 128}; }, nq, tot);
                SEAM(pb + 2); }
            if (IN(pb + 3)) { phase_attn(a, lds); SEAM(pb + 3); }
            if (IN(pb + 4)) {
                const bf16_t* Bt = (const bf16_t*)(ws + WS_WO) + (size_t)j * D * D; float* X = a.out;
                gemm_phase_plain(lds, (const bf16_t*)(ws + WS_AO), D, Bt, D, T / 128, 8, [&](int tm, int tn) { return EpiResid{X, mod + ((size_t)l * 4 + (tm * 128) / SEQ) * 6144 + 2048, tm * 128, tn * 128}; }, 0, (T / 128) * 8);
                SEAM(pb + 4); }
        }
        if (IN(pb + 5)) { phase_route(a, lds, l); SEAM(pb + 5); }
        if (IN(pb + 6)) { phase_moe_up(a, lds, l); SEAM(pb + 6); }
        if (IN(pb + 7)) { phase_moe_down(a, lds, l); SEAM(pb + 7); }
        if (IN(pb + 8)) { phase_combine(a, lds, l); SEAM(pb + 8); }
    }
#undef IN
#undef SEAM
}

extern "C" void kernel_launch(void* const* d_in, const int* in_sizes, int n_in, void* d_out, int out_size, void* d_ws, size_t ws_size, hipStream_t stream) {
    static int grid = 0;
    if (grid == 0) {
        if (n_in != 28 || out_size != T * D || ws_size < WS_END) { fprintf(stderr, "kernel_launch: unexpected shapes (n_in %d out %d ws %zu)\n", n_in, out_size, ws_size); grid = -1; return; }
        int dev = 0, cus = 0, per_cu = 0;
        if (hipGetDevice(&dev) != hipSuccess || hipDeviceGetAttribute(&cus, hipDeviceAttributeMultiprocessorCount, dev) != hipSuccess) { grid = -1; return; }
        if (hipFuncSetAttribute((const void*)fwd, hipFuncAttributeMaxDynamicSharedMemorySize, LDS_BYTES) != hipSuccess) { fprintf(stderr, "kernel_launch: hipFuncSetAttribute failed\n"); grid = -1; return; }
        if (hipOccupancyMaxActiveBlocksPerMultiprocessor(&per_cu, (const void*)fwd, NTHREADS, LDS_BYTES) != hipSuccess || per_cu < 1) fprintf(stderr, "kernel_launch: occupancy query reports %d\n", per_cu);
        (void)hipGetLastError();
        grid = cus;
    }
    if (grid < 0) return;
    (void)hipMemsetAsync((char*)d_ws + WS_CTL, 0, CTL_BYTES, stream);
    Args a{};
    for (int i = 0; i < 28; ++i) a.in[i] = d_in[i];
    a.out = (float*)d_out; a.ws = (unsigned char*)d_ws;
#if MK_ONE_LAUNCH
    a.ph_lo = 0; a.ph_hi = NPHASE;
    hipLaunchKernelGGL(fwd, dim3(grid), dim3(NTHREADS), LDS_BYTES, stream, a);
#else
    for (int ph = 0; ph < NPHASE; ++ph) {
        if (ph >= 2) { const int l = (ph - 2) / PH_PER_LAYER, k = (ph - 2) % PH_PER_LAYER; if (l < 2 && (k == 3 || k == 4)) continue; }
        a.ph_lo = ph; a.ph_hi = ph + 1;
        hipLaunchKernelGGL(fwd, dim3(grid), dim3(NTHREADS), LDS_BYTES, stream, a);
    }
#endif
}
```

```cpp
#include <hip/hip_runtime.h>
#include <cstdio>
#include <cstdint>

#define LAS __attribute__((address_space(3)))
typedef unsigned short bf16_t;
typedef short bf16x8 __attribute__((ext_vector_type(8)));
typedef float f32x4 __attribute__((ext_vector_type(4)));
typedef float f32x2 __attribute__((ext_vector_type(2)));
typedef unsigned u32x4 __attribute__((ext_vector_type(4)));
typedef unsigned u32x2 __attribute__((ext_vector_type(2)));

#ifndef MK_ONE_LAUNCH
#define MK_ONE_LAUNCH 1
#endif

constexpr int NB = 4, SEQ = 4096, T = NB * SEQ, D = 1024, DEPTH = 4;
constexpr int CWID = 31, NH = 8, DQK = 192, QR = 384, KVR = 256;
constexpr int NE = 16, DE = 512;
constexpr float EPS = 1e-6f;
constexpr float ATTN_SCALE = 0.07216878364870322f;

constexpr size_t MiB = 1u << 20;
constexpr size_t WS_CTL = 0, CTL_BYTES = 1 * MiB;
constexpr size_t WS_MOD = 1 * MiB;
constexpr size_t WS_ROPE = 2 * MiB;
constexpr size_t WS_TOKINFO = 6 * MiB;
constexpr size_t WS_LIST = 7 * MiB;
constexpr size_t WS_WIN = 8 * MiB;
constexpr size_t WS_WOUT = 16 * MiB;
constexpr size_t WS_WDKV = 20 * MiB;
constexpr size_t WS_WUKV = 21 * MiB;
constexpr size_t WS_WDQ = 22 * MiB;
constexpr size_t WS_WUQ = 24 * MiB;
constexpr size_t WS_WO = 27 * MiB;
constexpr size_t WS_WGU = 32 * MiB;
constexpr size_t WS_WDN = 160 * MiB;
constexpr size_t WS_HA = 224 * MiB;
constexpr size_t WS_XKV = 256 * MiB;
constexpr size_t WS_U = 288 * MiB;
constexpr size_t WS_H2 = WS_U;
constexpr size_t WS_V2 = 320 * MiB;
constexpr size_t WS_AO = WS_V2;
constexpr size_t WS_YB = 352 * MiB;
constexpr size_t WS_CQRAW = 352 * MiB;
constexpr size_t WS_CKVRAW = 376 * MiB;
constexpr size_t WS_CQ = 396 * MiB;
constexpr size_t WS_LAT = 408 * MiB;
constexpr size_t WS_KROPE = 422 * MiB;
constexpr size_t WS_Q = 424 * MiB;
constexpr size_t WS_ACT = WS_Q;
constexpr size_t WS_KV = 472 * MiB;
constexpr size_t WS_END = 536 * MiB;
constexpr int NSLOT_MAX = 2 * T + NE * 128;

constexpr int CW_BAR = 4096;
constexpr int CW_CNT = 16384;

constexpr int LDS_BYTES = 147456;
constexpr int NTHREADS = 512;

#define XB_TMO      128
#define XB_XCNT(j)  (256  + 64 * (j))
#define XB_XSUB(j)  (1280 + 64 * (j))
#define XB_XGEN(j)  (2304 + 64 * (j))
#define XB_TOP      3328
#define XB_TOPGEN   3392
#define XCD_BAR_WORDS 3456
#define XB_SPIN_CAP (1u << 18)

__device__ __forceinline__ unsigned xb_ld(unsigned* p)              { return __hip_atomic_load(p, __ATOMIC_RELAXED, __HIP_MEMORY_SCOPE_AGENT); }
__device__ __forceinline__ unsigned xb_add(unsigned* p, unsigned v) { return __hip_atomic_fetch_add(p, v, __ATOMIC_RELAXED, __HIP_MEMORY_SCOPE_AGENT); }
__device__ __forceinline__ unsigned xb_xcc_id() { return (unsigned)__builtin_amdgcn_s_getreg((3 << 11) | 20) & 0xFu; }
#define XB_SPIN(cond, bar) do { unsigned _sp = 0; while (cond) { __builtin_amdgcn_s_sleep(1); \
    if ((++_sp & 255u) == 0u) { if (xb_ld(&(bar)[XB_TMO])) break; if (_sp > XB_SPIN_CAP) { atomicAdd(&(bar)[XB_TMO], 1u); break; } } } } while (0)

struct XcdBarrier { unsigned* bar; unsigned x; volatile LAS unsigned* st; };

__device__ __forceinline__ XcdBarrier xcd_barrier_post(unsigned* bar, volatile LAS unsigned* st) {
    XcdBarrier b; b.bar = bar; b.x = xb_xcc_id(); b.st = st;
    if (threadIdx.x == 0) (void)xb_add(&bar[XB_XCNT(b.x)], 1u);
    return b;
}
__device__ __forceinline__ void xcd_barrier_complete(unsigned* bar, unsigned x, unsigned& nloc, unsigned& nx) {
    const unsigned G = gridDim.x * gridDim.y * gridDim.z;
    unsigned sum, cnt, mine, sp = 0u;
    for (;;) {
        sum = 0u; cnt = 0u; mine = 0u;
#pragma unroll
        for (unsigned j = 0; j < 16; ++j) { const unsigned c = xb_ld(&bar[XB_XCNT(j)]); sum += c; cnt += (c > 0u) ? 1u : 0u; mine = (j == x) ? c : mine; }
        if (sum == G) break;
        __builtin_amdgcn_s_sleep(1);
        if ((++sp & 255u) == 0u) { if (xb_ld(&bar[XB_TMO])) break; if (sp > XB_SPIN_CAP) { atomicAdd(&bar[XB_TMO], 1u); break; } }
    }
    nloc = mine > 0u ? mine : 1u; nx = cnt > 0u ? cnt : 1u;
}
__device__ __forceinline__ void xcd_barrier(const XcdBarrier& b) {
    asm volatile("s_waitcnt vmcnt(0)" ::: "memory");
    __syncthreads();
    if (threadIdx.x == 0) {
        unsigned* bar = b.bar;
        __builtin_amdgcn_s_waitcnt(0);
        unsigned nloc = b.st[0], nx = b.st[1];
        if (nloc == 0u) { xcd_barrier_complete(bar, b.x, nloc, nx); b.st[0] = nloc; b.st[1] = nx; }
        const unsigned old = xb_add(&bar[XB_XSUB(b.x)], 1u);
        const unsigned gen = old / nloc;
        if (old + 1u == (gen + 1u) * nloc) {
            __builtin_amdgcn_fence(__ATOMIC_RELEASE, "agent");
            asm volatile("s_waitcnt vmcnt(0)" ::: "memory");
            const unsigned og = xb_add(&bar[XB_TOP], 1u);
            const unsigned tg = og / nx;
            if (og + 1u == (tg + 1u) * nx) xb_add(&bar[XB_TOPGEN], 1u);
            else XB_SPIN(xb_ld(&bar[XB_TOPGEN]) == tg, bar);
            __builtin_amdgcn_fence(__ATOMIC_ACQUIRE, "agent");
            xb_add(&bar[XB_XGEN(b.x)], 1u);
            asm volatile("s_waitcnt vmcnt(0)" ::: "memory");
        } else {
            XB_SPIN(xb_ld(&bar[XB_XGEN(b.x)]) == gen, bar);
            __builtin_amdgcn_fence(__ATOMIC_ACQUIRE, "agent");
            asm volatile("s_waitcnt vmcnt(0)" ::: "memory");
        }
    }
    __syncthreads();
}

__device__ __forceinline__ unsigned f2bf(float f) { unsigned u = __builtin_bit_cast(unsigned, f); return (u + 0x7fffu + ((u >> 16) & 1u)) >> 16; }
__device__ __forceinline__ unsigned pk2(float lo, float hi) { return f2bf(lo) | (f2bf(hi) << 16); }
__device__ __forceinline__ float bf2f(unsigned short b) { return __builtin_bit_cast(float, (unsigned)b << 16); }
__device__ __forceinline__ float bflo(unsigned w) { return __builtin_bit_cast(float, w << 16); }
__device__ __forceinline__ float bfhi(unsigned w) { return __builtin_bit_cast(float, w & 0xffff0000u); }
__device__ __forceinline__ float wave_sum(float v) {
#pragma unroll
    for (int o = 1; o < 64; o <<= 1) v += __shfl_xor(v, o);
    return v;
}
__device__ __forceinline__ float sigmoidf_(float x) { return 1.0f / (1.0f + __expf(-x)); }
__device__ __forceinline__ float siluf_(float x) { return x / (1.0f + __expf(-x)); }

struct Args { const void* in[28]; float* out; unsigned char* ws; int ph_lo, ph_hi; };
__device__ __forceinline__ int otid() { int t = threadIdx.x; asm volatile("" : "+v"(t)); return t; }
template <class P> __device__ __forceinline__ P* opq(P* p) { asm volatile("" : "+s"(p)); return p; }

constexpr int LDT = 72;
template <class Epi>
__device__ __forceinline__ void gemm_tile(LAS unsigned char* lds, const bf16_t* a0, const bf16_t* a1, const bf16_t* b0, const bf16_t* b1, int K, const Epi& epi) {
    const int tid = otid(), lane = tid & 63, wid = tid >> 6, wm = wid >> 2, wn = wid & 3, fr = lane & 15, fq = lane >> 4;
    const int srow = tid >> 3, skc = tid & 7;
    LAS bf16_t* As = (LAS bf16_t*)lds; LAS bf16_t* Bs = As + 128 * LDT;
    u32x4 ra0 = *(const u32x4*)a0, ra1 = *(const u32x4*)a1, rb0 = *(const u32x4*)b0, rb1 = *(const u32x4*)b1;
    f32x4 acc[4][2];
#pragma unroll
    for (int i = 0; i < 4; ++i)
#pragma unroll
        for (int j = 0; j < 2; ++j) acc[i][j] = (f32x4){0.f, 0.f, 0.f, 0.f};
    const int nk = K >> 6;
    for (int kt = 0; kt < nk; ++kt) {
        __syncthreads();
        *(LAS u32x4*)(As + srow * LDT + skc * 8) = ra0; *(LAS u32x4*)(As + (srow + 64) * LDT + skc * 8) = ra1;
        *(LAS u32x4*)(Bs + srow * LDT + skc * 8) = rb0; *(LAS u32x4*)(Bs + (srow + 64) * LDT + skc * 8) = rb1;
        __syncthreads();
        if (kt + 1 < nk) { const int o = (kt + 1) * 64; ra0 = *(const u32x4*)(a0 + o); ra1 = *(const u32x4*)(a1 + o); rb0 = *(const u32x4*)(b0 + o); rb1 = *(const u32x4*)(b1 + o); }
#pragma unroll
        for (int ks = 0; ks < 2; ++ks) {
            bf16x8 af[4], bfr[2];
#pragma unroll
            for (int mi = 0; mi < 4; ++mi) af[mi] = *(const LAS bf16x8*)(As + (wm * 64 + mi * 16 + fr) * LDT + ks * 32 + fq * 8);
#pragma unroll
            for (int ni = 0; ni < 2; ++ni) bfr[ni] = *(const LAS bf16x8*)(Bs + (wn * 32 + ni * 16 + fr) * LDT + ks * 32 + fq * 8);
#pragma unroll
            for (int mi = 0; mi < 4; ++mi)
#pragma unroll
                for (int ni = 0; ni < 2; ++ni) acc[mi][ni] = __builtin_amdgcn_mfma_f32_16x16x32_bf16(bfr[ni], af[mi], acc[mi][ni], 0, 0, 0);
        }
    }
    epi(wm * 64 + fr, wn, fq, acc);
}

__device__ __forceinline__ int pair_row(int ch, int half) { return (ch >> 6) * 128 + ((ch >> 4) & 3) * 32 + half * 16 + (ch & 15); }

template <int MODE>
__device__ __forceinline__ void cvt_item(const float* W, int K, int N, int ld, bf16_t* WT, int row_off_or_half, LAS float* scr, int item, int lane) {
    const int nblk = N / 32, kb = item / nblk, nb = item % nblk, k0 = 64 * kb, n0 = 32 * nb;
#pragma unroll 8
    for (int i = 0; i < 32; ++i) { const int kk = 2 * i + (lane >> 5); scr[kk * 33 + (lane & 31)] = W[(size_t)(k0 + kk) * ld + n0 + (lane & 31)]; }
    asm volatile("s_waitcnt lgkmcnt(0)" ::: "memory");
    const int c = lane & 7;
#pragma unroll
    for (int j = 0; j < 4; ++j) { const int n = (lane >> 3) + 8 * j; const LAS float* s = scr + (8 * c) * 33 + n;
        u32x4 o; o.x = pk2(s[0 * 33], s[1 * 33]); o.y = pk2(s[2 * 33], s[3 * 33]); o.z = pk2(s[4 * 33], s[5 * 33]); o.w = pk2(s[6 * 33], s[7 * 33]);
        const int drow = (MODE == 0) ? (row_off_or_half + n0 + n) : pair_row(n0 + n, row_off_or_half);
        *(u32x4*)(WT + (size_t)drow * K + k0 + 8 * c) = o; }
    asm volatile("s_waitcnt lgkmcnt(0)" ::: "memory");
}

__device__ __forceinline__ void phase_prologue(const Args& a, LAS unsigned char* lds) {
    const int tid = otid(), lane = tid & 63, wave = tid >> 6, G = gridDim.x;
    unsigned char* ws = opq(a.ws);
    {
        const float* c = (const float*)a.in[1]; const float* ada_w = (const float*)a.in[3]; const float* ada_b = (const float*)a.in[4];
        float* mod = (float*)(ws + WS_MOD);
        LAS float* cs = (LAS float*)lds;
        LAS float* red = cs + 4096;
        bool have = false;
        for (int it = blockIdx.x; it < 4 * 48; it += G) {
            if (!have) { for (int i = tid; i < 4096; i += NTHREADS) cs[i] = siluf_(c[i]); have = true; }
            __syncthreads();
            const int l = it / 48, n0 = (it % 48) * 128;
            const float* wp = ada_w + (size_t)l * D * 6144 + n0 + 2 * lane;
            float acc[4][2] = {{0.f, 0.f}, {0.f, 0.f}, {0.f, 0.f}, {0.f, 0.f}};
            const int kb = wave * 128;
#pragma unroll 4
            for (int k = 0; k < 128; ++k) {
                const f32x2 w = *(const f32x2*)(wp + (size_t)(kb + k) * 6144);
#pragma unroll
                for (int b = 0; b < 4; ++b) { const float cv = cs[b * 1024 + kb + k]; acc[b][0] += cv * w.x; acc[b][1] += cv * w.y; }
            }
#pragma unroll
            for (int b = 0; b < 4; ++b) { red[(wave * 4 + b) * 128 + 2 * lane] = acc[b][0]; red[(wave * 4 + b) * 128 + 2 * lane + 1] = acc[b][1]; }
            __syncthreads();
            { const int b = tid >> 7, col = tid & 127; float s = 0.f;
#pragma unroll
              for (int w = 0; w < 8; ++w) s += red[(w * 4 + b) * 128 + col];
              mod[((size_t)l * 4 + b) * 6144 + n0 + col] = s + ada_b[l * 6144 + n0 + col]; }
        }
        __syncthreads();
    }
    {
        const int* pos = (const int*)a.in[2]; f32x2* rt = (f32x2*)(ws + WS_ROPE);
        for (int idx = blockIdx.x * NTHREADS + tid; idx < T * 32; idx += G * NTHREADS) {
            const int t = idx >> 5, i = idx & 31;
            const float inv = exp2f(-(float)i * (13.287712379549449f / 32.0f));
            const float ang = (float)pos[t] * inv;
            const float kf = rintf(ang * 0.15915494309189535f);
            float r = fmaf(-kf, 6.28125f, ang); r = fmaf(-kf, 1.9353071795864769e-3f, r);
            rt[idx] = (f32x2){__cosf(r), __sinf(r)};
        }
    }
    {
        LAS float* scr = (LAS float*)(lds + wave * 16384);
        const int gw = blockIdx.x * 8 + wave, NGW = G * 8;
        const float* w_in = (const float*)a.in[7]; const float* w_out = (const float*)a.in[13]; const float* w_dkv = (const float*)a.in[15]; const float* w_ukv = (const float*)a.in[17];
        const float* w_dq = (const float*)a.in[18]; const float* w_uq = (const float*)a.in[20]; const float* w_o = (const float*)a.in[21];
        const float* wg = (const float*)a.in[24]; const float* wu = (const float*)a.in[25]; const float* wd = (const float*)a.in[26];
        constexpr int I_IN = 16 * 64, I_OUT = 16 * 32, I_DKV = 16 * 10, I_UKV = 4 * 64, I_DQ = 16 * 12, I_UQ = 6 * 48, I_O = 16 * 32;
        constexpr int I_G = 16 * 16, I_D = 8 * 32;
        constexpr int NSMALL = 2 * I_IN + 2 * I_OUT + I_DKV + I_UKV + 2 * I_DQ + 2 * I_UQ + 2 * I_O;
        constexpr int NEXP = 4 * 16 * (2 * I_G + I_D);
        for (int it = gw; it < NSMALL + NEXP; it += NGW) {
            int r = it;
            if (r < 2 * I_IN) { const int l = r / I_IN; r %= I_IN; const int half = r / 512;
                cvt_item<1>(w_in + (size_t)l * D * 2048 + half * 1024, D, 1024, 2048, (bf16_t*)(ws + WS_WIN) + (size_t)l * 2048 * 1024, half, scr, r % 512, lane); continue; }
            r -= 2 * I_IN;
            if (r < 2 * I_OUT) { const int l = r / I_OUT; cvt_item<0>(w_out + (size_t)l * D * D, D, D, D, (bf16_t*)(ws + WS_WOUT) + (size_t)l * D * D, 0, scr, r % I_OUT, lane); continue; }
            r -= 2 * I_OUT;
            if (r < I_DKV) { cvt_item<0>(w_dkv, D, 320, 320, (bf16_t*)(ws + WS_WDKV), 0, scr, r, lane); continue; }
            r -= I_DKV;
            if (r < I_UKV) { cvt_item<0>(w_ukv, KVR, 2048, 2048, (bf16_t*)(ws + WS_WUKV), 0, scr, r, lane); continue; }
            r -= I_UKV;
            if (r < 2 * I_DQ) { const int j = r / I_DQ; cvt_item<0>(w_dq + (size_t)j * D * QR, D, QR, QR, (bf16_t*)(ws + WS_WDQ) + (size_t)j * QR * D, 0, scr, r % I_DQ, lane); continue; }
            r -= 2 * I_DQ;
            if (r < 2 * I_UQ) { const int j = r / I_UQ; cvt_item<0>(w_uq + (size_t)j * QR * 1536, QR, 1536, 1536, (bf16_t*)(ws + WS_WUQ) + (size_t)j * 1536 * QR, 0, scr, r % I_UQ, lane); continue; }
            r -= 2 * I_UQ;
            if (r < 2 * I_O) { const int j = r / I_O; cvt_item<0>(w_o + (size_t)j * D * D, D, D, D, (bf16_t*)(ws + WS_WO) + (size_t)j * D * D, 0, scr, r % I_O, lane); continue; }
            r -= 2 * I_O;
            { const int per = 2 * I_G + I_D; const int le = r / per; r %= per;
              bf16_t* gu = (bf16_t*)(ws + WS_WGU) + (size_t)le * 1024 * 1024; bf16_t* dn = (bf16_t*)(ws + WS_WDN) + (size_t)le * 1024 * 512;
              if (r < I_G) cvt_item<1>(wg + (size_t)le * D * DE, D, DE, DE, gu, 0, scr, r, lane);
              else if (r < 2 * I_G) cvt_item<1>(wu + (size_t)le * D * DE, D, DE, DE, gu, 1, scr, r - I_G, lane);
              else cvt_item<0>(wd + (size_t)le * DE * D, DE, D, D, dn, 0, scr, r - 2 * I_G, lane); }
        }
        { u32x4* z = (u32x4*)((bf16_t*)(ws + WS_WDKV) + 320 * 1024); const int n16 = 64 * 1024 * 2 / 16;
          for (int i = blockIdx.x * NTHREADS + tid; i < n16; i += G * NTHREADS) z[i] = (u32x4){0u, 0u, 0u, 0u}; }
    }
}

__device__ __forceinline__ void row_load(const float* p, int lane, f32x4 (&v)[4]) {
#pragma unroll
    for (int j = 0; j < 4; ++j) v[j] = *(const f32x4*)(p + 4 * lane + 256 * j);
}
__device__ __forceinline__ float row_rstd(const f32x4 (&v)[4]) {
    float s = 0.f;
#pragma unroll
    for (int j = 0; j < 4; ++j) s += (v[j].x * v[j].x + v[j].y * v[j].y) + (v[j].z * v[j].z + v[j].w * v[j].w);
    return 1.0f / sqrtf(wave_sum(s) * (1.0f / D) + EPS);
}
__device__ __forceinline__ void row_modulate_store(const f32x4 (&v)[4], float r, const float* g, const float* sc, const float* sh, bf16_t* orow, int lane, f32x4 (*hout)[4] = nullptr) {
#pragma unroll
    for (int j = 0; j < 4; ++j) {
        const int c = 4 * lane + 256 * j;
        const f32x4 gv = *(const f32x4*)(g + c);
        f32x4 h = v[j] * r * gv;
        if (sc) { const f32x4 s1 = *(const f32x4*)(sc + c), s0 = *(const f32x4*)(sh + c); h = h * (s1 + 1.0f) + s0; }
        if (hout) (*hout)[j] = h;
        u32x2 o; o.x = pk2(h.x, h.y); o.y = pk2(h.z, h.w);
        *(u32x2*)(orow + c) = o;
    }
}

__device__ __forceinline__ void phase_mod0(const Args& a) {
    const int tid_ = otid(); const int lane = tid_ & 63, gw = blockIdx.x * 8 + (tid_ >> 6), NGW = gridDim.x * 8;
    const float* x = (const float*)a.in[0]; const float* g = (const float*)a.in[5]; const float* mod = (const float*)(a.ws + WS_MOD);
    bf16_t* HA = (bf16_t*)(a.ws + WS_HA);
    for (int row = gw; row < T; row += NGW) {
        f32x4 v[4]; row_load(x + (size_t)row * D, lane, v);
#pragma unroll
        for (int j = 0; j < 4; ++j) *(f32x4*)(a.out + (size_t)row * D + 4 * lane + 256 * j) = v[j];
        const float r = row_rstd(v); const int b = row / SEQ;
        row_modulate_store(v, r, g, mod + (size_t)b * 6144 + 1024, mod + (size_t)b * 6144, HA + (size_t)row * D, lane);
    }
}

struct EpiGLU {
    bf16_t* U; const float* bias; int row0, tn;
    __device__ __forceinline__ void operator()(int r0, int wn, int fq, const f32x4 (&acc)[4][2]) const {
        const int ch = tn * 64 + wn * 16 + 4 * fq;
        const f32x4 ba = *(const f32x4*)(bias + ch), bg = *(const f32x4*)(bias + 1024 + ch);
#pragma unroll
        for (int mi = 0; mi < 4; ++mi) { const f32x4 av = acc[mi][0] + ba, gv = acc[mi][1] + bg;
            u32x2 o; o.x = pk2(av.x * sigmoidf_(gv.x), av.y * sigmoidf_(gv.y)); o.y = pk2(av.z * sigmoidf_(gv.z), av.w * sigmoidf_(gv.w));
            *(u32x2*)(U + (size_t)(row0 + r0 + 16 * mi) * D + ch) = o; }
    }
};
struct EpiSwiGLU {
    bf16_t* ACT; int row0, tn;
    __device__ __forceinline__ void operator()(int r0, int wn, int fq, const f32x4 (&acc)[4][2]) const {
        const int ch = tn * 64 + wn * 16 + 4 * fq;
#pragma unroll
        for (int mi = 0; mi < 4; ++mi) { const f32x4 gv = acc[mi][0], uv = acc[mi][1];
            u32x2 o; o.x = pk2(siluf_(gv.x) * uv.x, siluf_(gv.y) * uv.y); o.y = pk2(siluf_(gv.z) * uv.z, siluf_(gv.w) * uv.w);
            *(u32x2*)(ACT + (size_t)(row0 + r0 + 16 * mi) * DE + ch) = o; }
    }
};
struct EpiResid {
    float* X; const float* gate; int row0, col0;
    __device__ __forceinline__ void operator()(int r0, int wn, int fq, const f32x4 (&acc)[4][2]) const {
#pragma unroll
        for (int ni = 0; ni < 2; ++ni) { const int c = col0 + wn * 32 + ni * 16 + 4 * fq; const f32x4 gv = *(const f32x4*)(gate + c);
#pragma unroll
            for (int mi = 0; mi < 4; ++mi) { float* p = X + (size_t)(row0 + r0 + 16 * mi) * D + c; *(f32x4*)p = *(const f32x4*)p + gv * acc[mi][ni]; } }
    }
};
struct EpiBf16 {
    bf16_t* O; int ldc, row0, col0;
    __device__ __forceinline__ void operator()(int r0, int wn, int fq, const f32x4 (&acc)[4][2]) const {
#pragma unroll
        for (int ni = 0; ni < 2; ++ni) { const int c = col0 + wn * 32 + ni * 16 + 4 * fq;
#pragma unroll
            for (int mi = 0; mi < 4; ++mi) { u32x2 o; o.x = pk2(acc[mi][ni].x, acc[mi][ni].y); o.y = pk2(acc[mi][ni].z, acc[mi][ni].w);
                *(u32x2*)(O + (size_t)(row0 + r0 + 16 * mi) * ldc + c) = o; } }
    }
};
struct EpiF32 {
    float* O; int ldc, row0, col0, ncols;
    __device__ __forceinline__ void operator()(int r0, int wn, int fq, const f32x4 (&acc)[4][2]) const {
#pragma unroll
        for (int ni = 0; ni < 2; ++ni) { const int c = col0 + wn * 32 + ni * 16 + 4 * fq;
            if (c < ncols) {
#pragma unroll
                for (int mi = 0; mi < 4; ++mi) *(f32x4*)(O + (size_t)(row0 + r0 + 16 * mi) * ldc + c) = acc[mi][ni]; } }
    }
};

template <class F>
__device__ __forceinline__ void gemm_phase_plain(LAS unsigned char* lds, const bf16_t* A, int lda, const bf16_t* Bt, int K, int ntm, int ntn, F&& mk, int ubase, int utotal) {
    const int tid_ = otid(); const int srow = tid_ >> 3, skc = tid_ & 7;
    for (int u = blockIdx.x; u < utotal; u += gridDim.x) {
        const int v = u - ubase; if (v < 0 || v >= ntm * ntn) continue;
        const int tm = v / ntn, tn = v % ntn;
        const bf16_t* a0 = A + (size_t)(tm * 128 + srow) * lda + skc * 8; const bf16_t* b0 = Bt + (size_t)(tn * 128 + srow) * K + skc * 8;
        gemm_tile(lds, a0, a0 + (size_t)64 * lda, b0, b0 + (size_t)64 * K, K, mk(tm, tn));
    }
}

__device__ __forceinline__ void phase_conv(const Args& a, LAS unsigned char* lds, int l) {
    const int tid = otid(), lane = tid & 63, wave = tid >> 6;
    const bf16_t* U = (const bf16_t*)(a.ws + WS_U); bf16_t* V2 = (bf16_t*)(a.ws + WS_V2);
    const float* w_dw = (const float*)a.in[9] + (size_t)l * CWID * D; const float* b_dw = (const float*)a.in[10] + l * D;
    const float* ln_g = (const float*)a.in[11] + l * D; const float* ln_b = (const float*)a.in[12] + l * D;
    constexpr int RC = 16, NR = RC + CWID - 1;
    LAS unsigned* ub = (LAS unsigned*)lds;
    LAS float* red = (LAS float*)(lds + NR * 2048);
    const int c = 2 * tid;
    float w0[CWID], w1[CWID];
#pragma unroll
    for (int j = 0; j < CWID; ++j) { const f32x2 w = *(const f32x2*)(w_dw + (size_t)j * D + c); w0[j] = w.x; w1[j] = w.y; }
    const f32x2 bd = *(const f32x2*)(b_dw + c), lg = *(const f32x2*)(ln_g + c), lb = *(const f32x2*)(ln_b + c);
    for (int it = blockIdx.x; it < T / RC; it += gridDim.x) {
        const int b = it / (SEQ / RC), t0 = (it % (SEQ / RC)) * RC;
        __syncthreads();
        for (int i = tid; i < NR * 128; i += NTHREADS) { const int rr = i >> 7, ch = i & 127; const int t = t0 - (CWID - 1) + rr;
            u32x4 val = (u32x4){0u, 0u, 0u, 0u};
            if (t >= 0) val = *(const u32x4*)(U + ((size_t)b * SEQ + t) * D + ch * 8);
            *(LAS u32x4*)(ub + rr * 512 + ch * 4) = val; }
        __syncthreads();
        float o0[RC], o1[RC];
#pragma unroll
        for (int t = 0; t < RC; ++t) { float s0 = bd.x, s1 = bd.y;
#pragma unroll
            for (int j = 0; j < CWID; ++j) { const unsigned w = ub[(t + j) * 512 + tid]; s0 += bflo(w) * w0[j]; s1 += bfhi(w) * w1[j]; }
            o0[t] = s0; o1[t] = s1; }
#pragma unroll
        for (int t = 0; t < RC; ++t) { const float s = wave_sum(o0[t] + o1[t]); const float q = wave_sum(o0[t] * o0[t] + o1[t] * o1[t]);
            if (lane == 0) { red[(wave * RC + t) * 2] = s; red[(wave * RC + t) * 2 + 1] = q; } }
        __syncthreads();
#pragma unroll
        for (int t = 0; t < RC; ++t) { float s = 0.f, q = 0.f;
#pragma unroll
            for (int w = 0; w < 8; ++w) { s += red[(w * RC + t) * 2]; q += red[(w * RC + t) * 2 + 1]; }
            const float mean = s * (1.0f / D); const float var = fmaxf(q * (1.0f / D) - mean * mean, 0.f); const float rstd = 1.0f / sqrtf(var + EPS);
            const float y0 = (o0[t] - mean) * rstd * lg.x + lb.x, y1 = (o1[t] - mean) * rstd * lg.y + lb.y;
            *(unsigned*)(V2 + ((size_t)b * SEQ + t0 + t) * D + c) = pk2(siluf_(y0), siluf_(y1)); }
    }
}

__device__ __forceinline__ float top2sum4(float a, float b, float c, float d) {
    return fmaxf(fmaxf(fmaxf(a + b, a + c), fmaxf(a + d, b + c)), fmaxf(b + d, c + d));
}
__device__ __forceinline__ void phase_route(const Args& a, LAS unsigned char* lds, int l) {
    const int tid = otid(), lane = tid & 63, wave = tid >> 6, G = gridDim.x;
    const float* X = a.out; bf16_t* H2 = (bf16_t*)(a.ws + WS_H2);
    const float* g = (const float*)a.in[6] + l * D; const float* mod = (const float*)(a.ws + WS_MOD) + (size_t)l * 4 * 6144;
    const float* rw_g = (const float*)a.in[22]; const float* rb = (const float*)a.in[23];
    unsigned* cnt = (unsigned*)(a.ws + WS_CTL) + CW_CNT + 64 * l;
    int* list = (int*)(a.ws + WS_LIST); int* tokinfo = (int*)(a.ws + WS_TOKINFO);
    LAS float* rw = (LAS float*)lds;
    LAS int* lcnt = (LAS int*)(lds + 65536);
    LAS int* sel = (LAS int*)(lds + 65536 + 256);
    for (int i = tid; i < 1024 * 16 / 4; i += NTHREADS) *(LAS f32x4*)(rw + 4 * i) = *(const f32x4*)(rw_g + 4 * i);
    if (tid < 32) lcnt[tid] = 0;
    __syncthreads();
    float rbv[16];
#pragma unroll
    for (int e = 0; e < 16; ++e) rbv[e] = rb[e];
    int nloc = 0;
    for (int base = blockIdx.x * 8; base < T; base += G * 8, ++nloc) {
        const int row = base + wave; const int b = row / SEQ;
        f32x4 v[4]; row_load(X + (size_t)row * D, lane, v);
        const float r = row_rstd(v);
        f32x4 h[4];
        row_modulate_store(v, r, g, mod + (size_t)b * 6144 + 4 * 1024, mod + (size_t)b * 6144 + 3 * 1024, H2 + (size_t)row * D, lane, &h);
        float lg[16];
#pragma unroll
        for (int e = 0; e < 16; ++e) lg[e] = 0.f;
#pragma unroll
        for (int j = 0; j < 4; ++j)
#pragma unroll
            for (int i = 0; i < 4; ++i) { const int c = 4 * lane + 256 * j + i; const float hv = h[j][i];
#pragma unroll
                for (int q = 0; q < 4; ++q) { const f32x4 w = *(const LAS f32x4*)(rw + c * 16 + 4 * q);
                    lg[4 * q + 0] += hv * w.x; lg[4 * q + 1] += hv * w.y; lg[4 * q + 2] += hv * w.z; lg[4 * q + 3] += hv * w.w; } }
        float s[16], sb[16];
#pragma unroll
        for (int e = 0; e < 16; ++e) { s[e] = 1.0f / (1.0f + expf(-wave_sum(lg[e]))); sb[e] = s[e] + rbv[e]; }
        float best = -1e30f; int gi = 0; float wb0 = 0, wb1 = 0, wb2 = 0, wb3 = 0, ws0 = 0, ws1 = 0, ws2 = 0, ws3 = 0;
#pragma unroll
        for (int q = 0; q < 4; ++q) { const float gs = top2sum4(sb[4 * q], sb[4 * q + 1], sb[4 * q + 2], sb[4 * q + 3]);
            if (gs > best) { best = gs; gi = q; wb0 = sb[4 * q]; wb1 = sb[4 * q + 1]; wb2 = sb[4 * q + 2]; wb3 = sb[4 * q + 3]; ws0 = s[4 * q]; ws1 = s[4 * q + 1]; ws2 = s[4 * q + 2]; ws3 = s[4 * q + 3]; } }
        int i1 = 0; float m1 = wb0, sv1 = ws0;
        if (wb1 > m1) { m1 = wb1; i1 = 1; sv1 = ws1; } if (wb2 > m1) { m1 = wb2; i1 = 2; sv1 = ws2; } if (wb3 > m1) { m1 = wb3; i1 = 3; sv1 = ws3; }
        int i2 = -1; float m2 = -1e30f, sv2 = 0.f;
        if (i1 != 0 && wb0 > m2) { m2 = wb0; i2 = 0; sv2 = ws0; } if (i1 != 1 && wb1 > m2) { m2 = wb1; i2 = 1; sv2 = ws1; }
        if (i1 != 2 && wb2 > m2) { m2 = wb2; i2 = 2; sv2 = ws2; } if (i1 != 3 && wb3 > m2) { m2 = wb3; i2 = 3; sv2 = ws3; }
        const int e0 = 4 * gi + i1, e1 = 4 * gi + i2; const float wsum = sv1 + sv2; const float w0 = sv1 / wsum, w1 = sv2 / wsum;
        if (lane == 0) { const int lp0 = atomicAdd((int*)&lcnt[e0], 1), lp1 = atomicAdd((int*)&lcnt[e1], 1);
            LAS int* sp = sel + (nloc * 8 + wave) * 8; sp[0] = row; sp[1] = e0; sp[2] = e1; sp[3] = lp0; sp[4] = lp1; sp[5] = __builtin_bit_cast(int, w0); sp[6] = __builtin_bit_cast(int, w1); }
    }
    __syncthreads();
    if (tid < 16) lcnt[16 + tid] = (int)atomicAdd(&cnt[tid], (unsigned)lcnt[tid]);
    __syncthreads();
    for (int i = tid; i < nloc * 8; i += NTHREADS) { const LAS int* sp = sel + i * 8; const int row = sp[0], e0 = sp[1], e1 = sp[2];
        const int p0 = lcnt[16 + e0] + sp[3], p1 = lcnt[16 + e1] + sp[4];
        list[(size_t)e0 * T + p0] = row; list[(size_t)e1 * T + p1] = row;
        int* ti = tokinfo + (size_t)row * 8; ti[0] = e0; ti[1] = p0; ti[2] = sp[5]; ti[3] = e1; ti[4] = p1; ti[5] = sp[6]; }
    __syncthreads();
}

__device__ __forceinline__ void moe_tiles(const unsigned* cnt, LAS int* tb, LAS int* cn) {
    if (threadIdx.x == 0) { int s = 0; for (int e = 0; e < 16; ++e) { const int c = (int)cnt[e]; cn[e] = c; tb[e] = s; s += (c + 127) >> 7; } tb[16] = s; }
    __syncthreads();
}
__device__ __forceinline__ void phase_moe_up(const Args& a, LAS unsigned char* lds, int l) {
    LAS int* tb = (LAS int*)(lds + 40960); LAS int* cn = tb + 32;
    const unsigned* cnt = (const unsigned*)(a.ws + WS_CTL) + CW_CNT + 64 * l;
    moe_tiles(cnt, tb, cn);
    const int NT = tb[16]; const int tid_ = otid(); const int srow = tid_ >> 3, skc = tid_ & 7;
    const bf16_t* H2 = (const bf16_t*)(a.ws + WS_H2); const int* list = (const int*)(a.ws + WS_LIST);
    const bf16_t* WGU = (const bf16_t*)(a.ws + WS_WGU) + (size_t)l * 16 * 1024 * 1024;
    for (int u = blockIdx.x; u < NT * 8; u += gridDim.x) {
        const int rt = u >> 3, tn = u & 7; int e = 0;
#pragma unroll
        for (int q = 1; q < 16; ++q) e += (rt >= tb[q]) ? 1 : 0;
        const int p0 = (rt - tb[e]) * 128 + srow, p1 = p0 + 64, c = cn[e];
        const int tok0 = p0 < c ? list[(size_t)e * T + p0] : 0, tok1 = p1 < c ? list[(size_t)e * T + p1] : 0;
        const bf16_t* b0 = WGU + ((size_t)e * 1024 + tn * 128 + srow) * 1024 + skc * 8;
        gemm_tile(lds, H2 + (size_t)tok0 * D + skc * 8, H2 + (size_t)tok1 * D + skc * 8, b0, b0 + (size_t)64 * 1024, D, EpiSwiGLU{(bf16_t*)(a.ws + WS_ACT), rt * 128, tn});
    }
}
__device__ __forceinline__ void phase_moe_down(const Args& a, LAS unsigned char* lds, int l) {
    LAS int* tb = (LAS int*)(lds + 40960); LAS int* cn = tb + 32;
    const unsigned* cnt = (const unsigned*)(a.ws + WS_CTL) + CW_CNT + 64 * l;
    moe_tiles(cnt, tb, cn);
    const int NT = tb[16]; const int tid_ = otid(); const int srow = tid_ >> 3, skc = tid_ & 7;
    const bf16_t* ACT = (const bf16_t*)(a.ws + WS_ACT);
    const bf16_t* WDN = (const bf16_t*)(a.ws + WS_WDN) + (size_t)l * 16 * 1024 * 512;
    for (int u = blockIdx.x; u < NT * 8; u += gridDim.x) {
        const int rt = u >> 3, tn = u & 7; int e = 0;
#pragma unroll
        for (int q = 1; q < 16; ++q) e += (rt >= tb[q]) ? 1 : 0;
        const bf16_t* a0 = ACT + (size_t)(rt * 128 + srow) * DE + skc * 8;
        const bf16_t* b0 = WDN + ((size_t)e * 1024 + tn * 128 + srow) * DE + skc * 8;
        gemm_tile(lds, a0, a0 + (size_t)64 * DE, b0, b0 + (size_t)64 * DE, DE, EpiBf16{(bf16_t*)(a.ws + WS_YB), D, rt * 128, tn * 128});
    }
}
__device__ __forceinline__ void phase_combine(const Args& a, LAS unsigned char* lds, int l) {
    LAS int* tb = (LAS int*)(lds + 40960); LAS int* cn = tb + 32;
    const unsigned* cnt = (const unsigned*)(a.ws + WS_CTL) + CW_CNT + 64 * l;
    moe_tiles(cnt, tb, cn);
    const int tid_ = otid(); const int lane = tid_ & 63, gw = blockIdx.x * 8 + (tid_ >> 6), NGW = gridDim.x * 8;
    float* X = a.out; const bf16_t* YB = (const bf16_t*)(a.ws + WS_YB); const int* tokinfo = (const int*)(a.ws + WS_TOKINFO);
    const float* mod = (const float*)(a.ws + WS_MOD);
    for (int row = gw; row < T; row += NGW) {
        const int b = row / SEQ; const int* ti = tokinfo + (size_t)row * 8;
        const int e0 = ti[0], p0 = ti[1], e1 = ti[3], p1 = ti[4]; const float w0 = __builtin_bit_cast(float, ti[2]), w1 = __builtin_bit_cast(float, ti[5]);
        const bf16_t* y0 = YB + (size_t)(tb[e0] * 128 + p0) * D; const bf16_t* y1 = YB + (size_t)(tb[e1] * 128 + p1) * D;
        const float* g2 = mod + ((size_t)l * 4 + b) * 6144 + 5 * 1024;
        f32x4 v[4]; row_load(X + (size_t)row * D, lane, v);
#pragma unroll
        for (int j = 0; j < 4; ++j) { const int c = 4 * lane + 256 * j; const u32x2 a0 = *(const u32x2*)(y0 + c), a1 = *(const u32x2*)(y1 + c); const f32x4 gv = *(const f32x4*)(g2 + c);
            f32x4 y; y.x = w0 * bflo(a0.x) + w1 * bflo(a1.x); y.y = w0 * bfhi(a0.x) + w1 * bfhi(a1.x); y.z = w0 * bflo(a0.y) + w1 * bflo(a1.y); y.w = w0 * bfhi(a0.y) + w1 * bfhi(a1.y);
            v[j] = v[j] + gv * y; }
        const float r = row_rstd(v);
        if (l == DEPTH - 1) {
            const float* fg = (const float*)a.in[27];
#pragma unroll
            for (int j = 0; j < 4; ++j) { const int c = 4 * lane + 256 * j; *(f32x4*)(X + (size_t)row * D + c) = v[j] * r * *(const f32x4*)(fg + c); }
        } else {
#pragma unroll
            for (int j = 0; j < 4; ++j) *(f32x4*)(X + (size_t)row * D + 4 * lane + 256 * j) = v[j];
            const float* mn = mod + ((size_t)(l + 1) * 4 + b) * 6144;
            row_modulate_store(v, r, (const float*)a.in[5] + (l + 1) * D, mn + 1024, mn, (bf16_t*)(a.ws + WS_HA) + (size_t)row * D, lane);
            if (l == 1) row_modulate_store(v, r, (const float*)a.in[14], nullptr, nullptr, (bf16_t*)(a.ws + WS_XKV) + (size_t)row * D, lane);
        }
    }
}

__device__ __forceinline__ void phase_mla_norm(const Args& a, int j) {
    const int tid_ = otid(); const int lane = tid_ & 63, gw = blockIdx.x * 8 + (tid_ >> 6), NGW = gridDim.x * 8;
    const float* CQRAW = (const float*)(a.ws + WS_CQRAW); const float* CKVRAW = (const float*)(a.ws + WS_CKVRAW);
    bf16_t* CQ = (bf16_t*)(a.ws + WS_CQ); bf16_t* LAT = (bf16_t*)(a.ws + WS_LAT); bf16_t* KROPE = (bf16_t*)(a.ws + WS_KROPE);
    const float* qg = (const float*)a.in[19] + j * QR; const float* kg = (const float*)a.in[16]; const f32x2* rope = (const f32x2*)(a.ws + WS_ROPE);
    for (int row = gw; row < T; row += NGW) {
        { f32x2 v[3]; float s = 0.f;
#pragma unroll
          for (int q = 0; q < 3; ++q) { v[q] = *(const f32x2*)(CQRAW + (size_t)row * QR + 2 * lane + 128 * q); s += v[q].x * v[q].x + v[q].y * v[q].y; }
          const float r = 1.0f / sqrtf(wave_sum(s) * (1.0f / QR) + EPS);
#pragma unroll
          for (int q = 0; q < 3; ++q) { const int c = 2 * lane + 128 * q; const f32x2 gv = *(const f32x2*)(qg + c); *(unsigned*)(CQ + (size_t)row * QR + c) = pk2(v[q].x * r * gv.x, v[q].y * r * gv.y); } }
        if (j == 0) {
            const f32x4 v = *(const f32x4*)(CKVRAW + (size_t)row * 320 + 4 * lane);
            const float s = (v.x * v.x + v.y * v.y) + (v.z * v.z + v.w * v.w);
            const float r = 1.0f / sqrtf(wave_sum(s) * (1.0f / KVR) + EPS);
            const f32x4 gv = *(const f32x4*)(kg + 4 * lane);
            u32x2 o; o.x = pk2(v.x * r * gv.x, v.y * r * gv.y); o.y = pk2(v.z * r * gv.z, v.w * r * gv.w);
            *(u32x2*)(LAT + (size_t)row * KVR + 4 * lane) = o;
            if (lane < 32) { const float x1 = CKVRAW[(size_t)row * 320 + 256 + lane], x2 = CKVRAW[(size_t)row * 320 + 288 + lane]; const f32x2 cs = rope[(size_t)row * 32 + lane];
                KROPE[(size_t)row * 64 + lane] = (bf16_t)f2bf(x1 * cs.x - x2 * cs.y); KROPE[(size_t)row * 64 + 32 + lane] = (bf16_t)f2bf(x1 * cs.y + x2 * cs.x); }
        }
    }
}

__device__ __forceinline__ void phase_attn(const Args& a, LAS unsigned char* lds) {
    const int tid = otid(), lane = tid & 63, w = tid >> 6, fr = lane & 15, fq = lane >> 4, G = gridDim.x;
    constexpr int KP = 200, VP = 72;
    LAS bf16_t* Ks = (LAS bf16_t*)lds;
    LAS bf16_t* Vt = Ks + 64 * KP;
    LAS bf16_t* Ps = Vt + 128 * VP;
    const bf16_t* Q = (const bf16_t*)(a.ws + WS_Q); const bf16_t* KV = (const bf16_t*)(a.ws + WS_KV); const bf16_t* KR = (const bf16_t*)(a.ws + WS_KROPE);
    bf16_t* AO = (bf16_t*)(a.ws + WS_AO); const f32x2* rope = (const f32x2*)(a.ws + WS_ROPE);
    constexpr int NU = NB * NH * (SEQ / 128);
    for (int rd = 0; rd * G < NU; ++rd) {
        const int s = rd * G + ((rd & 1) ? (G - 1 - (int)blockIdx.x) : (int)blockIdx.x);
        if (s >= NU) continue;
        const int qb = (SEQ / 128 - 1) - s / (NB * NH), bh = s % (NB * NH), b = bh / NH, h = bh % NH;
        const int q0 = qb * 128; const size_t tb0 = (size_t)b * SEQ;
        bf16x8 qf[6];
        { const size_t row = tb0 + q0 + 16 * w + fr; const bf16_t* qp = Q + row * 1536 + h * DQK + 8 * fq;
#pragma unroll
          for (int ks = 0; ks < 6; ++ks) qf[ks] = *(const bf16x8*)(qp + 32 * ks);
#pragma unroll
          for (int j = 0; j < 8; ++j) { const f32x2 cs = rope[row * 32 + 8 * fq + j]; const float x1 = bf2f((unsigned short)qf[4][j]), x2 = bf2f((unsigned short)qf[5][j]);
              qf[4][j] = (short)f2bf(x1 * cs.x - x2 * cs.y); qf[5][j] = (short)f2bf(x1 * cs.y + x2 * cs.x); } }
        f32x4 o[8]; float m[4], lsum[4];
#pragma unroll
        for (int i = 0; i < 8; ++i) o[i] = (f32x4){0.f, 0.f, 0.f, 0.f};
#pragma unroll
        for (int i = 0; i < 4; ++i) { m[i] = -1e30f; lsum[i] = 0.f; }
        const int ntile = 2 * (qb + 1);
        for (int jt = 0; jt < ntile; ++jt) {
            __syncthreads();
#pragma unroll
            for (int i = 0; i < 3; ++i) { const int c = tid + NTHREADS * i, key = c / 24, ch = c % 24; const size_t tok = tb0 + jt * 64 + key;
                const u32x4 v = (ch < 16) ? *(const u32x4*)(KV + tok * 2048 + h * 256 + ch * 8) : *(const u32x4*)(KR + tok * 64 + (ch - 16) * 8);
                *(LAS u32x4*)(Ks + key * KP + ch * 8) = v; }
#pragma unroll
            for (int i = 0; i < 2; ++i) { const int c = tid + NTHREADS * i, key = c & 63, d8 = c >> 6; const size_t tok = tb0 + jt * 64 + key;
                const u32x4 v = *(const u32x4*)(KV + tok * 2048 + h * 256 + 128 + d8 * 8);
                LAS bf16_t* vp = Vt + (d8 * 8) * VP + key;
                vp[0 * VP] = (bf16_t)(v.x & 0xffffu); vp[1 * VP] = (bf16_t)(v.x >> 16); vp[2 * VP] = (bf16_t)(v.y & 0xffffu); vp[3 * VP] = (bf16_t)(v.y >> 16);
                vp[4 * VP] = (bf16_t)(v.z & 0xffffu); vp[5 * VP] = (bf16_t)(v.z >> 16); vp[6 * VP] = (bf16_t)(v.w & 0xffffu); vp[7 * VP] = (bf16_t)(v.w >> 16); }
            __syncthreads();
            f32x4 sc[4];
#pragma unroll
            for (int n = 0; n < 4; ++n) { sc[n] = (f32x4){0.f, 0.f, 0.f, 0.f};
#pragma unroll
                for (int ks = 0; ks < 6; ++ks) { const bf16x8 kf = *(const LAS bf16x8*)(Ks + (16 * n + fr) * KP + 32 * ks + 8 * fq);
                    sc[n] = __builtin_amdgcn_mfma_f32_16x16x32_bf16(qf[ks], kf, sc[n], 0, 0, 0); } }
            const bool diag = (jt * 64 + 63 > q0 + 16 * w);
#pragma unroll
            for (int n = 0; n < 4; ++n)
#pragma unroll
                for (int rg = 0; rg < 4; ++rg) { float v = sc[n][rg] * ATTN_SCALE;
                    if (diag && (jt * 64 + 16 * n + fr > q0 + 16 * w + 4 * fq + rg)) v = -1e30f;
                    sc[n][rg] = v; }
            float alpha[4];
#pragma unroll
            for (int rg = 0; rg < 4; ++rg) { float mx = fmaxf(fmaxf(sc[0][rg], sc[1][rg]), fmaxf(sc[2][rg], sc[3][rg]));
                mx = fmaxf(mx, __shfl_xor(mx, 1)); mx = fmaxf(mx, __shfl_xor(mx, 2)); mx = fmaxf(mx, __shfl_xor(mx, 4)); mx = fmaxf(mx, __shfl_xor(mx, 8));
                const float mn = fmaxf(m[rg], mx); alpha[rg] = __expf(m[rg] - mn); m[rg] = mn;
                float rs = 0.f;
#pragma unroll
                for (int n = 0; n < 4; ++n) { const float p = __expf(sc[n][rg] - mn); sc[n][rg] = p; rs += p; }
                rs += __shfl_xor(rs, 1); rs += __shfl_xor(rs, 2); rs += __shfl_xor(rs, 4); rs += __shfl_xor(rs, 8);
                lsum[rg] = lsum[rg] * alpha[rg] + rs; }
#pragma unroll
            for (int nd = 0; nd < 8; ++nd) { o[nd].x *= alpha[0]; o[nd].y *= alpha[1]; o[nd].z *= alpha[2]; o[nd].w *= alpha[3]; }
            LAS bf16_t* pw = Ps + w * 16 * VP;
#pragma unroll
            for (int n = 0; n < 4; ++n)
#pragma unroll
                for (int rg = 0; rg < 4; ++rg) pw[(4 * fq + rg) * VP + 16 * n + fr] = (bf16_t)f2bf(sc[n][rg]);
            __syncthreads();
#pragma unroll
            for (int s2 = 0; s2 < 2; ++s2) { const bf16x8 pf = *(const LAS bf16x8*)(pw + fr * VP + 32 * s2 + 8 * fq);
#pragma unroll
                for (int nd = 0; nd < 8; ++nd) { const bf16x8 vf = *(const LAS bf16x8*)(Vt + (16 * nd + fr) * VP + 32 * s2 + 8 * fq);
                    o[nd] = __builtin_amdgcn_mfma_f32_16x16x32_bf16(pf, vf, o[nd], 0, 0, 0); } }
        }
#pragma unroll
        for (int rg = 0; rg < 4; ++rg) { const float inv = 1.0f / lsum[rg]; const size_t row = tb0 + q0 + 16 * w + 4 * fq + rg;
#pragma unroll
            for (int nd = 0; nd < 8; ++nd) AO[row * D + h * 128 + 16 * nd + fr] = (bf16_t)f2bf(o[nd][rg] * inv); }
    }
}

constexpr int PH_PER_LAYER = 9, NPHASE = 2 + DEPTH * PH_PER_LAYER;
__global__ void __launch_bounds__(NTHREADS, 2) fwd(Args a) {
    extern __shared__ __attribute__((aligned(16))) unsigned char lds_raw[];
    LAS unsigned char* lds = (LAS unsigned char*)lds_raw;
    const int lo = a.ph_lo, hi = a.ph_hi;
    volatile LAS unsigned* misc = (volatile LAS unsigned*)(lds + 131072 + 320);
    if (threadIdx.x < 32) misc[threadIdx.x] = 0u;
    __syncthreads();
    XcdBarrier bar; bar.bar = (unsigned*)(a.ws + WS_CTL) + CW_BAR; bar.x = 0; bar.st = misc + 8;
    if (hi - lo > 1) bar = xcd_barrier_post((unsigned*)(a.ws + WS_CTL) + CW_BAR, misc + 8);
#define IN(k) (lo <= (k) && (k) < hi)
#define SEAM(k) do { if ((k) + 1 < hi) xcd_barrier(bar); } while (0)
    unsigned char* ws = a.ws;
    const float* mod = (const float*)(ws + WS_MOD);

    if (IN(0)) { phase_prologue(a, lds); SEAM(0); }
    if (IN(1)) { phase_mod0(a); SEAM(1); }
#pragma unroll 1
    for (int l = 0; l < DEPTH; ++l) {
        const int pb = 2 + PH_PER_LAYER * l;
        if (l < 2) {
            if (IN(pb + 0)) {
                const bf16_t* Bt = (const bf16_t*)(ws + WS_WIN) + (size_t)l * 2048 * 1024; bf16_t* U = (bf16_t*)(ws + WS_U); const float* bias = (const float*)a.in[8] + l * 2048;
                gemm_phase_plain(lds, (const bf16_t*)(ws + WS_HA), D, Bt, D, T / 128, 16, [&](int tm, int tn) { return EpiGLU{U, bias, tm * 128, tn}; }, 0, (T / 128) * 16);
                SEAM(pb + 0); }
            if (IN(pb + 1)) { phase_conv(a, lds, l); SEAM(pb + 1); }
            if (IN(pb + 2)) {
                const bf16_t* Bt = (const bf16_t*)(ws + WS_WOUT) + (size_t)l * D * D; float* X = a.out;
                gemm_phase_plain(lds, (const bf16_t*)(ws + WS_V2), D, Bt, D, T / 128, 8, [&](int tm, int tn) { return EpiResid{X, mod + ((size_t)l * 4 + (tm * 128) / SEQ) * 6144 + 2048, tm * 128, tn * 128}; }, 0, (T / 128) * 8);
                SEAM(pb + 2); }
        } else {
            const int j = l - 2;
            if (IN(pb + 0)) {
                const int nq = (T / 128) * 3, tot = nq + (j == 0 ? nq : 0);
                float* CQRAW = (float*)(ws + WS_CQRAW); float* CKVRAW = (float*)(ws + WS_CKVRAW);
                gemm_phase_plain(lds, (const bf16_t*)(ws + WS_HA), D, (const bf16_t*)(ws + WS_WDQ) + (size_t)j * QR * D, D, T / 128, 3, [&](int tm, int tn) { return EpiF32{CQRAW, QR, tm * 128, tn * 128, QR}; }, 0, tot);
                if (j == 0) gemm_phase_plain(lds, (const bf16_t*)(ws + WS_XKV), D, (const bf16_t*)(ws + WS_WDKV), D, T / 128, 3, [&](int tm, int tn) { return EpiF32{CKVRAW, 320, tm * 128, tn * 128, 320}; }, nq, tot);
                SEAM(pb + 0); }
            if (IN(pb + 1)) { phase_mla_norm(a, j); SEAM(pb + 1); }
            if (IN(pb + 2)) {
                const int nq = (T / 128) * 12, nkv = (T / 128) * 16, tot = nq + (j == 0 ? nkv : 0);
                bf16_t* Qb = (bf16_t*)(ws + WS_Q); bf16_t* KVb = (bf16_t*)(ws + WS_KV);
                gemm_phase_plain(lds, (const bf16_t*)(ws + WS_CQ), QR, (const bf16_t*)(ws + WS_WUQ) + (size_t)j * 1536 * QR, QR, T / 128, 12, [&](int tm, int tn) { return EpiBf16{Qb, 1536, tm * 128, tn * 128}; }, 0, tot);
                if (j == 0) gemm_phase_plain(lds, (const bf16_t*)(ws + WS_LAT), KVR, (const bf16_t*)(ws + WS_WUKV), KVR, T / 128, 16, [&](int tm, int tn) { return EpiBf16{KVb, 2048, tm * 128, tn * 128}; }, nq, tot);
                SEAM(pb + 2); }
            if (IN(pb + 3)) { phase_attn(a, lds); SEAM(pb + 3); }
            if (IN(pb + 4)) {
                const bf16_t* Bt = (const bf16_t*)(ws + WS_WO) + (size_t)j * D * D; float* X = a.out;
                gemm_phase_plain(lds, (const bf16_t*)(ws + WS_AO), D, Bt, D, T / 128, 8, [&](int tm, int tn) { return EpiResid{X, mod + ((size_t)l * 4 + (tm * 128) / SEQ) * 6144 + 2048, tm * 128, tn * 128}; }, 0, (T / 128) * 8);
                SEAM(pb + 4); }
        }
        if (IN(pb + 5)) { phase_route(a, lds, l); SEAM(pb + 5); }
        if (IN(pb + 6)) { phase_moe_up(a, lds, l); SEAM(pb + 6); }
        if (IN(pb + 7)) { phase_moe_down(a, lds, l); SEAM(pb + 7); }
        if (IN(pb + 8)) { phase_combine(a, lds, l); SEAM(pb + 8); }
    }
#undef IN
#undef SEAM
}

extern "C" void kernel_launch(void* const* d_in, const int* in_sizes, int n_in, void* d_out, int out_size, void* d_ws, size_t ws_size, hipStream_t stream) {
    static int grid = 0;
    if (grid == 0) {
        if (n_in != 28 || out_size != T * D || ws_size < WS_END) { fprintf(stderr, "kernel_launch: unexpected shapes (n_in %d out %d ws %zu)\n", n_in, out_size, ws_size); grid = -1; return; }
        int dev = 0, cus = 0, per_cu = 0;
        if (hipGetDevice(&dev) != hipSuccess || hipDeviceGetAttribute(&cus, hipDeviceAttributeMultiprocessorCount, dev) != hipSuccess) { grid = -1; return; }
        if (hipFuncSetAttribute((const void*)fwd, hipFuncAttributeMaxDynamicSharedMemorySize, LDS_BYTES) != hipSuccess) { fprintf(stderr, "kernel_launch: hipFuncSetAttribute failed\n"); grid = -1; return; }
        if (hipOccupancyMaxActiveBlocksPerMultiprocessor(&per_cu, (const void*)fwd, NTHREADS, LDS_BYTES) != hipSuccess || per_cu < 1) fprintf(stderr, "kernel_launch: occupancy query reports %d\n", per_cu);
        (void)hipGetLastError();
        grid = cus;
    }
    if (grid < 0) return;
    (void)hipMemsetAsync((char*)d_ws + WS_CTL, 0, CTL_BYTES, stream);
    Args a{};
    for (int i = 0; i < 28; ++i) a.in[i] = d_in[i];
    a.out = (float*)d_out; a.ws = (unsigned char*)d_ws;
#if MK_ONE_LAUNCH
    a.ph_lo = 0; a.ph_hi = NPHASE;
    hipLaunchKernelGGL(fwd, dim3(grid), dim3(NTHREADS), LDS_BYTES, stream, a);
#else
    for (int ph = 0; ph < NPHASE; ++ph) {
        if (ph >= 2) { const int l = (ph - 2) / PH_PER_LAYER, k = (ph - 2) % PH_PER_LAYER; if (l < 2 && (k == 3 || k == 4)) continue; }
        a.ph_lo = ph; a.ph_hi = ph + 1;
        hipLaunchKernelGGL(fwd, dim3(grid), dim3(NTHREADS), LDS_BYTES, stream, a);
    }
#endif
}
```

```cpp
#include <hip/hip_runtime.h>
#include <cstdio>
#include <cstdint>

#define LAS __attribute__((address_space(3)))
typedef unsigned short bf16_t;
typedef short bf16x8 __attribute__((ext_vector_type(8)));
typedef float f32x4 __attribute__((ext_vector_type(4)));
typedef float f32x2 __attribute__((ext_vector_type(2)));
typedef unsigned u32x4 __attribute__((ext_vector_type(4)));
typedef unsigned u32x2 __attribute__((ext_vector_type(2)));

#ifndef MK_ONE_LAUNCH
#define MK_ONE_LAUNCH 1
#endif

constexpr int NB = 4, SEQ = 4096, T = NB * SEQ, D = 1024, DEPTH = 4;
constexpr int CWID = 31, NH = 8, DQK = 192, QR = 384, KVR = 256;
constexpr int NE = 16, DE = 512;
constexpr float EPS = 1e-6f;
constexpr float ATTN_SCALE = 0.07216878364870322f;

constexpr size_t MiB = 1u << 20;
constexpr size_t WS_CTL = 0, CTL_BYTES = 1 * MiB;
constexpr size_t WS_MOD = 1 * MiB;
constexpr size_t WS_ROPE = 2 * MiB;
constexpr size_t WS_TOKINFO = 6 * MiB;
constexpr size_t WS_LIST = 7 * MiB;
constexpr size_t WS_WIN = 8 * MiB;
constexpr size_t WS_WOUT = 16 * MiB;
constexpr size_t WS_WDKV = 20 * MiB;
constexpr size_t WS_WUKV = 21 * MiB;
constexpr size_t WS_WDQ = 22 * MiB;
constexpr size_t WS_WUQ = 24 * MiB;
constexpr size_t WS_WO = 27 * MiB;
constexpr size_t WS_WGU = 32 * MiB;
constexpr size_t WS_WDN = 160 * MiB;
constexpr size_t WS_HA = 224 * MiB;
constexpr size_t WS_XKV = 256 * MiB;
constexpr size_t WS_U = 288 * MiB;
constexpr size_t WS_H2 = WS_U;
constexpr size_t WS_V2 = 320 * MiB;
constexpr size_t WS_AO = WS_V2;
constexpr size_t WS_YB = 352 * MiB;
constexpr size_t WS_CQRAW = 352 * MiB;
constexpr size_t WS_CKVRAW = 376 * MiB;
constexpr size_t WS_CQ = 396 * MiB;
constexpr size_t WS_LAT = 408 * MiB;
constexpr size_t WS_KROPE = 424 * MiB;
constexpr size_t WS_Q = 426 * MiB;
constexpr size_t WS_ACT = WS_Q;
constexpr size_t WS_KV = 474 * MiB;
constexpr size_t WS_END = 538 * MiB;
constexpr int NSLOT_MAX = 2 * T + NE * 256;

constexpr int CW_BAR = 4096;
constexpr int CW_CNT = 16384;

constexpr int LDS_BYTES = 147456;
constexpr int LDS_EXTRA = 131072;
constexpr int LDS_MISC = LDS_EXTRA + 320;
constexpr int LDS_TB = LDS_EXTRA + 512;
constexpr int LDS_TOK = LDS_EXTRA + 1024;
constexpr int NTHREADS = 512;

#define XB_TMO      128
#define XB_XCNT(j)  (256  + 64 * (j))
#define XB_XSUB(j)  (1280 + 64 * (j))
#define XB_XGEN(j)  (2304 + 64 * (j))
#define XB_TOP      3328
#define XB_TOPGEN   3392
#define XCD_BAR_WORDS 3456
#define XB_SPIN_CAP (1u << 18)

__device__ __forceinline__ unsigned xb_ld(unsigned* p)              { return __hip_atomic_load(p, __ATOMIC_RELAXED, __HIP_MEMORY_SCOPE_AGENT); }
__device__ __forceinline__ unsigned xb_add(unsigned* p, unsigned v) { return __hip_atomic_fetch_add(p, v, __ATOMIC_RELAXED, __HIP_MEMORY_SCOPE_AGENT); }
__device__ __forceinline__ unsigned xb_xcc_id() { return (unsigned)__builtin_amdgcn_s_getreg((3 << 11) | 20) & 0xFu; }
#define XB_SPIN(cond, bar) do { unsigned _sp = 0; while (cond) { __builtin_amdgcn_s_sleep(1); \
    if ((++_sp & 255u) == 0u) { if (xb_ld(&(bar)[XB_TMO])) break; if (_sp > XB_SPIN_CAP) { atomicAdd(&(bar)[XB_TMO], 1u); break; } } } } while (0)

struct XcdBarrier { unsigned* bar; unsigned x; volatile LAS unsigned* st; };

__device__ __forceinline__ XcdBarrier xcd_barrier_post(unsigned* bar, volatile LAS unsigned* st) {
    XcdBarrier b; b.bar = bar; b.x = xb_xcc_id(); b.st = st;
    if (threadIdx.x == 0) (void)xb_add(&bar[XB_XCNT(b.x)], 1u);
    return b;
}
__device__ __forceinline__ void xcd_barrier_complete(unsigned* bar, unsigned x, unsigned& nloc, unsigned& nx) {
    const unsigned G = gridDim.x * gridDim.y * gridDim.z;
    unsigned sum, cnt, mine, sp = 0u;
    for (;;) {
        sum = 0u; cnt = 0u; mine = 0u;
#pragma unroll
        for (unsigned j = 0; j < 16; ++j) { const unsigned c = xb_ld(&bar[XB_XCNT(j)]); sum += c; cnt += (c > 0u) ? 1u : 0u; mine = (j == x) ? c : mine; }
        if (sum == G) break;
        __builtin_amdgcn_s_sleep(1);
        if ((++sp & 255u) == 0u) { if (xb_ld(&bar[XB_TMO])) break; if (sp > XB_SPIN_CAP) { atomicAdd(&bar[XB_TMO], 1u); break; } }
    }
    nloc = mine > 0u ? mine : 1u; nx = cnt > 0u ? cnt : 1u;
}
__device__ __forceinline__ void xcd_barrier(const XcdBarrier& b) {
    asm volatile("s_waitcnt vmcnt(0)" ::: "memory");
    __syncthreads();
    if (threadIdx.x == 0) {
        unsigned* bar = b.bar;
        __builtin_amdgcn_s_waitcnt(0);
        unsigned nloc = b.st[0], nx = b.st[1];
        if (nloc == 0u) { xcd_barrier_complete(bar, b.x, nloc, nx); b.st[0] = nloc; b.st[1] = nx; }
        const unsigned old = xb_add(&bar[XB_XSUB(b.x)], 1u);
        const unsigned gen = old / nloc;
        if (old + 1u == (gen + 1u) * nloc) {
            __builtin_amdgcn_fence(__ATOMIC_RELEASE, "agent");
            asm volatile("s_waitcnt vmcnt(0)" ::: "memory");
            const unsigned og = xb_add(&bar[XB_TOP], 1u);
            const unsigned tg = og / nx;
            if (og + 1u == (tg + 1u) * nx) xb_add(&bar[XB_TOPGEN], 1u);
            else XB_SPIN(xb_ld(&bar[XB_TOPGEN]) == tg, bar);
            __builtin_amdgcn_fence(__ATOMIC_ACQUIRE, "agent");
            xb_add(&bar[XB_XGEN(b.x)], 1u);
            asm volatile("s_waitcnt vmcnt(0)" ::: "memory");
        } else {
            XB_SPIN(xb_ld(&bar[XB_XGEN(b.x)]) == gen, bar);
            __builtin_amdgcn_fence(__ATOMIC_ACQUIRE, "agent");
            asm volatile("s_waitcnt vmcnt(0)" ::: "memory");
        }
    }
    __syncthreads();
}

__device__ __forceinline__ unsigned f2bf(float f) { unsigned u = __builtin_bit_cast(unsigned, f); return (u + 0x7fffu + ((u >> 16) & 1u)) >> 16; }
__device__ __forceinline__ unsigned pk2(float lo, float hi) { return f2bf(lo) | (f2bf(hi) << 16); }
__device__ __forceinline__ float bf2f(unsigned short b) { return __builtin_bit_cast(float, (unsigned)b << 16); }
__device__ __forceinline__ float bflo(unsigned w) { return __builtin_bit_cast(float, w << 16); }
__device__ __forceinline__ float bfhi(unsigned w) { return __builtin_bit_cast(float, w & 0xffff0000u); }
__device__ __forceinline__ float wave_sum(float v) {
#pragma unroll
    for (int o = 1; o < 64; o <<= 1) v += __shfl_xor(v, o);
    return v;
}
__device__ __forceinline__ float sigmoidf_(float x) { return 1.0f / (1.0f + __expf(-x)); }
__device__ __forceinline__ float siluf_(float x) { return x / (1.0f + __expf(-x)); }

struct Args { const void* in[28]; float* out; unsigned char* ws; int ph_lo, ph_hi; };
__device__ __forceinline__ int otid() { int t = threadIdx.x; asm volatile("" : "+v"(t)); return t; }
template <class P> __device__ __forceinline__ P* opq(P* p) { asm volatile("" : "+s"(p)); return p; }

namespace pg8 {
#define PG8_LAS __attribute__((address_space(3)))
constexpr int BM = 256, BK = 64, HALF = 128, HTB = HALF * BK * 2, STAGE_BYTES = 8 * HTB, NXCD = 8, WGM = 8;
__host__ __device__ __forceinline__ int lds_byte(int r, int c) { const int st = (r >> 4) * 2 + (c >> 5), rr = r & 15, cc = c & 31, ob = rr * 64 + cc * 2; return st * 1024 + (ob ^ (((ob >> 9) & 1) << 5)); }
__host__ __device__ __forceinline__ void stage_rc(int b, int& R, int& C) { const int st = b / 1024, sb = b % 1024, swz = sb ^ (((sb >> 9) & 1) << 5); R = (st >> 1) * 16 + swz / 64; C = (st & 1) * 32 + (swz % 64) / 2; }
__host__ __device__ __forceinline__ int perm32(int rho) { const int n = rho >> 4, i = rho & 15; return 8 * (i >> 2) + 4 * n + (i & 3); }
struct Unit { int pm, pn; };
struct Gemm { const bf16_t* A; const bf16_t* Bt; int M, N, K; };
struct StaticOrder {
    int nM, nN, nwg, G, c;
    __host__ __device__ void init(int M, int N, int G_, int c_) { nM = M / BM; nN = N / BM; nwg = nM * nN; G = G_; c = c_; }
    __host__ __device__ bool next(int i, Unit& u) const {
        const long L = (long)i * G + c; if (L >= nwg) return false;
        int wgid = (int)L; { const int q = nwg / NXCD, r = nwg % NXCD, xcd = wgid % NXCD, off = wgid / NXCD; wgid = (xcd < r ? xcd * (q + 1) : r * (q + 1) + (xcd - r) * q) + off; }
        const int nig = WGM * nN, gid = wgid / nig, fm = gid * WGM, gsz = (nM - fm) < WGM ? (nM - fm) : WGM;
        u.pm = fm + ((wgid % nig) % gsz); u.pn = (wgid % nig) / gsz; return true;
    }
    __device__ __forceinline__ const PG8_LAS int* tok(int) const { return nullptr; }
};
struct MoeOrder {
    const PG8_LAS int* tb; const PG8_LAS int* toks; int G, c;
    __device__ __forceinline__ bool next(int i, Unit& u) const {
        const int x = c & 7, idx = c >> 3, rt = i * (G >> 2) + (idx >> 2) * 8 + x;
        if (rt >= tb[16]) return false;
        int e = 0;
#pragma unroll
        for (int q = 1; q < 16; ++q) e += (rt >= tb[q]) ? 1 : 0;
        u.pm = rt; u.pn = e * 4 + (idx & 3); return true;
    }
    __device__ __forceinline__ const PG8_LAS int* tok(int ui) const { return toks + ui * 256; }
};

template <class Epi, class Sched, bool ALIGN_EPI = false, bool SP2 = false, bool GATHER = false>
__device__ __forceinline__ void gemm_phase(PG8_LAS unsigned char* lds, const Gemm g, const Sched& S, const Epi& E) {
    const int tid = otid(), wid = __builtin_amdgcn_readfirstlane(tid >> 6), lane = tid & 63, wr = wid >> 2, wc = wid & 3, fr = lane & 15, fq = lane >> 4;
    const int K = g.K, nt = K / BK;
    unsigned voffA[2], voffB[2];
#pragma unroll
    for (int i = 0; i < 2; ++i) { int R, C; stage_rc(tid * 16 + i * 8192, R, C); const int Rb = Epi::PERM ? ((R & ~31) + perm32(R & 31)) : R;
        voffA[i] = (unsigned)(R * K + C) * 2u; voffB[i] = (unsigned)(Rb * K + C) * 2u; }
    const size_t kstep = (size_t)(BK * 2);
    const size_t hstep = (size_t)HALF * K * 2;
    const size_t tstep = 2 * hstep;
    const unsigned ldsw = (unsigned)wid * 1024u;
    const int aoff = lds_byte(wr * 64 + fr, fq * 8), boff = lds_byte(wc * 32 + fr, fq * 8);
#define PG8_SA(b, h) (((b) * 2 + (h)) * HTB)
#define PG8_SB(b, h) ((4 + (b) * 2 + (h)) * HTB)
#define PG8_STAGE(bufoff, gbase, voff) do { _Pragma("unroll") for (int _i = 0; _i < 2; ++_i) \
        __builtin_amdgcn_global_load_lds((const unsigned*)((const char*)(gbase) + (voff)[_i]), (PG8_LAS unsigned*)(lds + (bufoff) + ldsw + _i * 8192), 16, 0, 0); } while (0)
#define PG8_STAGE_A(bufoff, gbase, hh, VO) do { if constexpr (GATHER) { PG8_STAGE(bufoff, gbase, VO[hh]); } else { PG8_STAGE(bufoff, (gbase) + (hh) * hstep, voffA); } } while (0)
#define PG8_LDA(dst, b, h) do { _Pragma("unroll") for (int m = 0; m < 4; ++m) _Pragma("unroll") for (int k = 0; k < 2; ++k) dst[m][k] = *(const PG8_LAS bf16x8*)(lds + PG8_SA(b, h) + aoff + m * 2048 + k * 1024); } while (0)
#define PG8_LDB(dst, b, h) do { _Pragma("unroll") for (int n = 0; n < 2; ++n) _Pragma("unroll") for (int k = 0; k < 2; ++k) dst[n][k] = *(const PG8_LAS bf16x8*)(lds + PG8_SB(b, h) + boff + n * 2048 + k * 1024); } while (0)
#define PG8_MMA(ai, bj, At, Bt) do { __builtin_amdgcn_s_setprio(1); _Pragma("unroll") for (int m = 0; m < 4; ++m) _Pragma("unroll") for (int n = 0; n < 2; ++n) _Pragma("unroll") for (int k = 0; k < 2; ++k) \
        acc[ai][bj][m][n] = __builtin_amdgcn_mfma_f32_16x16x32_bf16(Bt[n][k], At[m][k], acc[ai][bj][m][n], 0, 0, 0); __builtin_amdgcn_s_setprio(0); } while (0)
#define PG8_WAIT_V(n) asm volatile("s_waitcnt vmcnt(" #n ")" ::: "memory")
#define PG8_WAIT_L(n) asm volatile("s_waitcnt lgkmcnt(" #n ")" ::: "memory")
#define PG8_BAR __builtin_amdgcn_s_barrier()
#define PG8_SCHED __builtin_amdgcn_sched_barrier(0)
#define PG8_GOFF(dst, tk) do { _Pragma("unroll") for (int _i = 0; _i < 2; ++_i) { int _R, _C; stage_rc(tid * 16 + _i * 8192, _R, _C); _Pragma("unroll") for (int _h = 0; _h < 2; ++_h) dst[_h][_i] = (unsigned)((tk)[_h * 128 + _R] * K + _C) * 2u; } } while (0)
    Unit cur, nxt; int ui = 0;
    if (!S.next(0, cur)) return;
    f32x4 acc[2][2][4][2];
#pragma unroll
    for (int a = 0; a < 2; ++a)
#pragma unroll
        for (int b = 0; b < 2; ++b)
#pragma unroll
            for (int m = 0; m < 4; ++m)
#pragma unroll
                for (int n = 0; n < 2; ++n) acc[a][b][m][n] = (f32x4){0.f, 0.f, 0.f, 0.f};
    bf16x8 At[4][2], B0[2][2], B1[2][2];
    unsigned gA[2][2] = {{0u, 0u}, {0u, 0u}}, gAn[2][2] = {{0u, 0u}, {0u, 0u}}, gS[2][2] = {{0u, 0u}, {0u, 0u}};
    if constexpr (GATHER) { PG8_GOFF(gA, S.tok(0)); }
    const char* cA = GATHER ? (const char*)g.A : (const char*)g.A + (size_t)cur.pm * tstep; const char* cB = (const char*)g.Bt + (size_t)cur.pn * tstep;
    if constexpr (SP2) {
        PG8_STAGE(PG8_SB(0, 0), cB, voffB); PG8_STAGE(PG8_SB(0, 1), cB + hstep, voffB); PG8_STAGE_A(PG8_SA(0, 0), cA, 0, gA); PG8_STAGE_A(PG8_SA(0, 1), cA, 1, gA);
        if (wr == 1) PG8_BAR;
        PG8_WAIT_V(2); PG8_BAR;
        PG8_STAGE(PG8_SB(1, 0), cB + kstep, voffB); PG8_STAGE_A(PG8_SA(1, 0), cA + kstep, 0, gA); PG8_STAGE(PG8_SB(1, 1), cB + hstep + kstep, voffB);
        PG8_WAIT_V(6); PG8_BAR;
    } else {
        PG8_STAGE(PG8_SB(0, 0), cB, voffB); PG8_STAGE_A(PG8_SA(0, 0), cA, 0, gA); PG8_STAGE(PG8_SB(0, 1), cB + hstep, voffB); PG8_STAGE_A(PG8_SA(0, 1), cA, 1, gA);
        if (wr == 1) PG8_BAR;
        PG8_WAIT_V(4); PG8_BAR;
        PG8_STAGE(PG8_SB(1, 0), cB + kstep, voffB); PG8_STAGE_A(PG8_SA(1, 0), cA + kstep, 0, gA); PG8_STAGE(PG8_SB(1, 1), cB + hstep + kstep, voffB);
        PG8_WAIT_V(6); PG8_BAR;
    }
    for (;;) {
        const bool has_next = S.next(ui + 1, nxt);
        const char* nA = GATHER ? (const char*)g.A : (has_next ? (const char*)g.A + (size_t)nxt.pm * tstep : cA); const char* nB = has_next ? (const char*)g.Bt + (size_t)nxt.pn * tstep : cB;
        if constexpr (GATHER) { if (has_next) { PG8_GOFF(gAn, S.tok(ui + 1)); } else {
#pragma unroll
            for (int _h = 0; _h < 2; ++_h)
#pragma unroll
                for (int _i = 0; _i < 2; ++_i) gAn[_h][_i] = gA[_h][_i]; } }
        for (int t = 0; t < nt; t += 2) {
            const bool last = (t == nt - 2);
            const char* a1 = cA + (size_t)(t + 1) * kstep;
            const char* a2 = last ? nA : cA + (size_t)(t + 2) * kstep; const char* b2 = last ? nB : cB + (size_t)(t + 2) * kstep;
            const char* a3 = a2 + kstep; const char* b3 = b2 + kstep;
            if constexpr (GATHER) {
#pragma unroll
                for (int _h = 0; _h < 2; ++_h)
#pragma unroll
                    for (int _i = 0; _i < 2; ++_i) gS[_h][_i] = last ? gAn[_h][_i] : gA[_h][_i]; }
            if constexpr (SP2) {
            PG8_LDB(B0, 0, 0); PG8_LDB(B1, 0, 1); PG8_SCHED; PG8_LDA(At, 0, 0); PG8_STAGE_A(PG8_SA(1, 1), a1, 1, gA);
            PG8_WAIT_V(8); PG8_WAIT_L(0); PG8_BAR; PG8_MMA(0, 0, At, B0); PG8_MMA(0, 1, At, B1); PG8_BAR; PG8_SCHED;
            PG8_LDA(At, 0, 1); PG8_STAGE(PG8_SB(0, 0), b2, voffB); PG8_STAGE(PG8_SB(0, 1), b2 + hstep, voffB); PG8_STAGE_A(PG8_SA(0, 0), a2, 0, gS);
            PG8_WAIT_V(8); PG8_WAIT_L(0); PG8_BAR; PG8_MMA(1, 0, At, B0); PG8_MMA(1, 1, At, B1); PG8_BAR; PG8_SCHED;
            PG8_LDB(B0, 1, 0); PG8_LDB(B1, 1, 1); PG8_SCHED; PG8_LDA(At, 1, 0); PG8_STAGE_A(PG8_SA(0, 1), a2, 1, gS);
            PG8_WAIT_V(8); PG8_WAIT_L(0); PG8_BAR; PG8_MMA(0, 0, At, B0); PG8_MMA(0, 1, At, B1); PG8_BAR; PG8_SCHED;
            PG8_LDA(At, 1, 1); PG8_STAGE(PG8_SB(1, 0), b3, voffB); PG8_STAGE(PG8_SB(1, 1), b3 + hstep, voffB); PG8_STAGE_A(PG8_SA(1, 0), a3, 0, gS);
            PG8_WAIT_V(8); PG8_WAIT_L(0); PG8_BAR; PG8_MMA(1, 0, At, B0); PG8_MMA(1, 1, At, B1); PG8_BAR; PG8_SCHED;
            } else {
            PG8_LDB(B0, 0, 0); PG8_SCHED; PG8_LDA(At, 0, 0); PG8_STAGE_A(PG8_SA(1, 1), a1, 1, gA);
            PG8_WAIT_L(8); PG8_BAR; PG8_WAIT_L(0); PG8_MMA(0, 0, At, B0); PG8_BAR; PG8_SCHED;
            PG8_LDB(B1, 0, 1); PG8_STAGE(PG8_SB(0, 0), b2, voffB);
            PG8_BAR; PG8_WAIT_L(0); PG8_MMA(0, 1, At, B1); PG8_BAR;
            PG8_LDA(At, 0, 1); PG8_STAGE_A(PG8_SA(0, 0), a2, 0, gS);
            PG8_BAR; PG8_WAIT_L(0); PG8_MMA(1, 0, At, B0); PG8_BAR; PG8_SCHED;
            PG8_STAGE(PG8_SB(0, 1), b2 + hstep, voffB);
            PG8_WAIT_V(6); PG8_BAR; PG8_MMA(1, 1, At, B1); PG8_BAR;
            PG8_LDB(B0, 1, 0); PG8_SCHED; PG8_LDA(At, 1, 0); PG8_STAGE_A(PG8_SA(0, 1), a2, 1, gS);
            PG8_WAIT_L(8); PG8_BAR; PG8_WAIT_L(0); PG8_MMA(0, 0, At, B0); PG8_BAR; PG8_SCHED;
            PG8_LDB(B1, 1, 1); PG8_STAGE(PG8_SB(1, 0), b3, voffB);
            PG8_BAR; PG8_WAIT_L(0); PG8_MMA(0, 1, At, B1); PG8_BAR;
            PG8_LDA(At, 1, 1); PG8_STAGE_A(PG8_SA(1, 0), a3, 0, gS);
            PG8_BAR; PG8_WAIT_L(0); PG8_MMA(1, 0, At, B0); PG8_BAR; PG8_SCHED;
            PG8_STAGE(PG8_SB(1, 1), b3 + hstep, voffB);
            PG8_WAIT_V(6); PG8_BAR; PG8_MMA(1, 1, At, B1); PG8_BAR;
            }
        }
        if constexpr (ALIGN_EPI) { if (wr == 0) PG8_BAR; }
        E(acc, cur, wr, wc, fr, fq);
        if (!has_next) break;
#pragma unroll
        for (int a = 0; a < 2; ++a)
#pragma unroll
            for (int b = 0; b < 2; ++b)
#pragma unroll
                for (int m = 0; m < 4; ++m)
#pragma unroll
                    for (int n = 0; n < 2; ++n) acc[a][b][m][n] = (f32x4){0.f, 0.f, 0.f, 0.f};
        cur = nxt; cA = nA; cB = nB; ++ui;
        if constexpr (GATHER) {
#pragma unroll
            for (int _h = 0; _h < 2; ++_h)
#pragma unroll
                for (int _i = 0; _i < 2; ++_i) gA[_h][_i] = gAn[_h][_i]; }
        if constexpr (ALIGN_EPI) { if (wr == 1) PG8_BAR; }
    }
    PG8_WAIT_V(0);
    if constexpr (!ALIGN_EPI) { if (wr == 0) PG8_BAR; }
    PG8_BAR;
#undef PG8_SA
#undef PG8_SB
#undef PG8_STAGE
#undef PG8_STAGE_A
#undef PG8_LDA
#undef PG8_LDB
#undef PG8_MMA
#undef PG8_WAIT_V
#undef PG8_WAIT_L
#undef PG8_BAR
#undef PG8_SCHED
#undef PG8_GOFF
}
__device__ __forceinline__ unsigned cvt_pk_bf16(float lo, float hi) { unsigned r; asm volatile("v_cvt_pk_bf16_f32 %0, %1, %2" : "=v"(r) : "v"(lo), "v"(hi)); return r; }
struct EpiBf16 {
    static constexpr bool PERM = true;
    bf16_t* O; int ldc, pnmask;
    __device__ __forceinline__ void operator()(const f32x4 (&acc)[2][2][4][2], const Unit& u, int wr, int wc, int fr, int fq) const {
        const int row0 = u.pm * BM + wr * 64 + fr, col0 = (u.pn & pnmask) * BM + wc * 32 + 8 * fq;
#pragma unroll
        for (int ai = 0; ai < 2; ++ai)
#pragma unroll
            for (int m = 0; m < 4; ++m) { bf16_t* rowp = O + (size_t)(row0 + ai * HALF + m * 16) * ldc + col0;
#pragma unroll
                for (int bj = 0; bj < 2; ++bj) { const f32x4 v0 = acc[ai][bj][m][0], v1 = acc[ai][bj][m][1];
                    u32x4 w; w.x = cvt_pk_bf16(v0[0], v0[1]); w.y = cvt_pk_bf16(v0[2], v0[3]); w.z = cvt_pk_bf16(v1[0], v1[1]); w.w = cvt_pk_bf16(v1[2], v1[3]);
                    *(u32x4*)(rowp + bj * HALF) = w; } }
    }
};
template <int MODE  > struct EpiGated {
    static constexpr bool PERM = true;
    bf16_t* O; int ldc, pnmask; const float* bias;
    __device__ __forceinline__ void operator()(const f32x4 (&acc)[2][2][4][2], const Unit& u, int wr, int wc, int fr, int fq) const {
        const int row0 = u.pm * BM + wr * 64 + fr, ch0 = (u.pn & pnmask) * HALF + wc * 32 + 8 * fq;
        f32x4 ba[2], bg[2];
#pragma unroll
        for (int n = 0; n < 2; ++n) { ba[n] = (f32x4){0.f, 0.f, 0.f, 0.f}; bg[n] = ba[n]; if (MODE == 0) { ba[n] = *(const f32x4*)(bias + ch0 + 4 * n); bg[n] = *(const f32x4*)(bias + 1024 + ch0 + 4 * n); } }
#pragma unroll
        for (int ai = 0; ai < 2; ++ai)
#pragma unroll
            for (int m = 0; m < 4; ++m) { float r[8];
#pragma unroll
                for (int n = 0; n < 2; ++n) { const f32x4 x = acc[ai][0][m][n] + ba[n], y = acc[ai][1][m][n] + bg[n];
#pragma unroll
                    for (int q = 0; q < 4; ++q) r[4 * n + q] = (MODE == 0) ? x[q] * sigmoidf_(y[q]) : siluf_(x[q]) * y[q]; }
                u32x4 w; w.x = cvt_pk_bf16(r[0], r[1]); w.y = cvt_pk_bf16(r[2], r[3]); w.z = cvt_pk_bf16(r[4], r[5]); w.w = cvt_pk_bf16(r[6], r[7]);
                *(u32x4*)(O + (size_t)(row0 + ai * HALF + m * 16) * ldc + ch0) = w; }
    }
};
struct EpiResid {
    static constexpr bool PERM = false;
    float* X; const float* gate;
    __device__ __forceinline__ void operator()(const f32x4 (&acc)[2][2][4][2], const Unit& u, int wr, int wc, int fr, int fq) const {
        const int row0 = u.pm * BM + wr * 64 + fr, col0 = u.pn * BM + wc * 32 + 4 * fq; const float* gp = gate + (size_t)((u.pm * BM) / SEQ) * 6144 + col0;
#pragma unroll
        for (int bj = 0; bj < 2; ++bj)
#pragma unroll
            for (int n = 0; n < 2; ++n) { const f32x4 gv = *(const f32x4*)(gp + bj * HALF + n * 16);
#pragma unroll
                for (int ai = 0; ai < 2; ++ai)
#pragma unroll
                    for (int m = 0; m < 4; ++m) { float* p = X + (size_t)(row0 + ai * HALF + m * 16) * D + col0 + bj * HALF + n * 16; *(f32x4*)p = *(const f32x4*)p + gv * acc[ai][bj][m][n]; } }
    }
};
struct EpiF32 {
    static constexpr bool PERM = false;
    float* O; int ldc, ncols;
    __device__ __forceinline__ void operator()(const f32x4 (&acc)[2][2][4][2], const Unit& u, int wr, int wc, int fr, int fq) const {
        const int row0 = u.pm * BM + wr * 64 + fr, col0 = u.pn * BM + wc * 32 + 4 * fq;
#pragma unroll
        for (int bj = 0; bj < 2; ++bj)
#pragma unroll
            for (int n = 0; n < 2; ++n) { const int c = col0 + bj * HALF + n * 16;
                if (c < ncols) {
#pragma unroll
                    for (int ai = 0; ai < 2; ++ai)
#pragma unroll
                        for (int m = 0; m < 4; ++m) *(f32x4*)(O + (size_t)(row0 + ai * HALF + m * 16) * ldc + c) = acc[ai][bj][m][n]; } }
    }
};
}

__device__ __forceinline__ int pair_row(int ch, int half) { return (ch >> 7) * 256 + half * 128 + (ch & 127); }

template <int MODE>
__device__ __forceinline__ void cvt_item(const float* W, int K, int N, int ld, bf16_t* WT, int row_off_or_half, LAS float* scr, int item, int lane) {
    const int nblk = N / 32, kb = item / nblk, nb = item % nblk, k0 = 64 * kb, n0 = 32 * nb;
#pragma unroll 8
    for (int i = 0; i < 32; ++i) { const int kk = 2 * i + (lane >> 5); scr[kk * 33 + (lane & 31)] = W[(size_t)(k0 + kk) * ld + n0 + (lane & 31)]; }
    asm volatile("s_waitcnt lgkmcnt(0)" ::: "memory");
    const int c = lane & 7;
#pragma unroll
    for (int j = 0; j < 4; ++j) { const int n = (lane >> 3) + 8 * j; const LAS float* s = scr + (8 * c) * 33 + n;
        u32x4 o; o.x = pk2(s[0 * 33], s[1 * 33]); o.y = pk2(s[2 * 33], s[3 * 33]); o.z = pk2(s[4 * 33], s[5 * 33]); o.w = pk2(s[6 * 33], s[7 * 33]);
        const int drow = (MODE == 0) ? (row_off_or_half + n0 + n) : pair_row(n0 + n, row_off_or_half);
        *(u32x4*)(WT + (size_t)drow * K + k0 + 8 * c) = o; }
    asm volatile("s_waitcnt lgkmcnt(0)" ::: "memory");
}

__device__ __forceinline__ void phase_prologue(const Args& a, LAS unsigned char* lds) {
    const int tid = otid(), lane = tid & 63, wave = tid >> 6, G = gridDim.x;
    unsigned char* ws = opq(a.ws);
    {
        const float* c = (const float*)a.in[1]; const float* ada_w = (const float*)a.in[3]; const float* ada_b = (const float*)a.in[4];
        float* mod = (float*)(ws + WS_MOD);
        LAS float* cs = (LAS float*)lds;
        LAS float* red = cs + 4096;
        bool have = false;
        for (int it = blockIdx.x; it < 4 * 48; it += G) {
            if (!have) { for (int i = tid; i < 4096; i += NTHREADS) cs[i] = siluf_(c[i]); have = true; }
            __syncthreads();
            const int l = it / 48, n0 = (it % 48) * 128;
            const float* wp = ada_w + (size_t)l * D * 6144 + n0 + 2 * lane;
            float acc[4][2] = {{0.f, 0.f}, {0.f, 0.f}, {0.f, 0.f}, {0.f, 0.f}};
            const int kb = wave * 128;
#pragma unroll 4
            for (int k = 0; k < 128; ++k) {
                const f32x2 w = *(const f32x2*)(wp + (size_t)(kb + k) * 6144);
#pragma unroll
                for (int b = 0; b < 4; ++b) { const float cv = cs[b * 1024 + kb + k]; acc[b][0] += cv * w.x; acc[b][1] += cv * w.y; }
            }
#pragma unroll
            for (int b = 0; b < 4; ++b) { red[(wave * 4 + b) * 128 + 2 * lane] = acc[b][0]; red[(wave * 4 + b) * 128 + 2 * lane + 1] = acc[b][1]; }
            __syncthreads();
            { const int b = tid >> 7, col = tid & 127; float s = 0.f;
#pragma unroll
              for (int w = 0; w < 8; ++w) s += red[(w * 4 + b) * 128 + col];
              mod[((size_t)l * 4 + b) * 6144 + n0 + col] = s + ada_b[l * 6144 + n0 + col]; }
        }
        __syncthreads();
    }
    {
        const int* pos = (const int*)a.in[2]; f32x2* rt = (f32x2*)(ws + WS_ROPE);
        for (int idx = blockIdx.x * NTHREADS + tid; idx < T * 32; idx += G * NTHREADS) {
            const int t = idx >> 5, i = idx & 31;
            const float inv = exp2f(-(float)i * (13.287712379549449f / 32.0f));
            const float ang = (float)pos[t] * inv;
            const float kf = rintf(ang * 0.15915494309189535f);
            float r = fmaf(-kf, 6.28125f, ang); r = fmaf(-kf, 1.9353071795864769e-3f, r);
            rt[idx] = (f32x2){__cosf(r), __sinf(r)};
        }
    }
    {
        LAS float* scr = (LAS float*)(lds + wave * 16384);
        const int gw = blockIdx.x * 8 + wave, NGW = G * 8;
        const float* w_in = (const float*)a.in[7]; const float* w_out = (const float*)a.in[13]; const float* w_dkv = (const float*)a.in[15]; const float* w_ukv = (const float*)a.in[17];
        const float* w_dq = (const float*)a.in[18]; const float* w_uq = (const float*)a.in[20]; const float* w_o = (const float*)a.in[21];
        const float* wg = (const float*)a.in[24]; const float* wu = (const float*)a.in[25]; const float* wd = (const float*)a.in[26];
        constexpr int I_IN = 16 * 64, I_OUT = 16 * 32, I_DKV = 16 * 10, I_UKV = 4 * 64, I_DQ = 16 * 12, I_UQ = 6 * 48, I_O = 16 * 32;
        constexpr int I_G = 16 * 16, I_D = 8 * 32;
        constexpr int NSMALL = 2 * I_IN + 2 * I_OUT + I_DKV + I_UKV + 2 * I_DQ + 2 * I_UQ + 2 * I_O;
        constexpr int NEXP = 4 * 16 * (2 * I_G + I_D);
        for (int it = gw; it < NSMALL + NEXP; it += NGW) {
            int r = it;
            if (r < 2 * I_IN) { const int l = r / I_IN; r %= I_IN; const int half = r / 512;
                cvt_item<1>(w_in + (size_t)l * D * 2048 + half * 1024, D, 1024, 2048, (bf16_t*)(ws + WS_WIN) + (size_t)l * 2048 * 1024, half, scr, r % 512, lane); continue; }
            r -= 2 * I_IN;
            if (r < 2 * I_OUT) { const int l = r / I_OUT; cvt_item<0>(w_out + (size_t)l * D * D, D, D, D, (bf16_t*)(ws + WS_WOUT) + (size_t)l * D * D, 0, scr, r % I_OUT, lane); continue; }
            r -= 2 * I_OUT;
            if (r < I_DKV) { cvt_item<0>(w_dkv, D, 320, 320, (bf16_t*)(ws + WS_WDKV), 0, scr, r, lane); continue; }
            r -= I_DKV;
            if (r < I_UKV) { cvt_item<0>(w_ukv, KVR, 2048, 2048, (bf16_t*)(ws + WS_WUKV), 0, scr, r, lane); continue; }
            r -= I_UKV;
            if (r < 2 * I_DQ) { const int j = r / I_DQ; cvt_item<0>(w_dq + (size_t)j * D * QR, D, QR, QR, (bf16_t*)(ws + WS_WDQ) + (size_t)j * 512 * D, 0, scr, r % I_DQ, lane); continue; }
            r -= 2 * I_DQ;
            if (r < 2 * I_UQ) { const int j = r / I_UQ; cvt_item<0>(w_uq + (size_t)j * QR * 1536, QR, 1536, 1536, (bf16_t*)(ws + WS_WUQ) + (size_t)j * 1536 * QR, 0, scr, r % I_UQ, lane); continue; }
            r -= 2 * I_UQ;
            if (r < 2 * I_O) { const int j = r / I_O; cvt_item<0>(w_o + (size_t)j * D * D, D, D, D, (bf16_t*)(ws + WS_WO) + (size_t)j * D * D, 0, scr, r % I_O, lane); continue; }
            r -= 2 * I_O;
            { const int per = 2 * I_G + I_D; const int le = r / per; r %= per;
              bf16_t* gu = (bf16_t*)(ws + WS_WGU) + (size_t)le * 1024 * 1024; bf16_t* dn = (bf16_t*)(ws + WS_WDN) + (size_t)le * 1024 * 512;
              if (r < I_G) cvt_item<1>(wg + (size_t)le * D * DE, D, DE, DE, gu, 0, scr, r, lane);
              else if (r < 2 * I_G) cvt_item<1>(wu + (size_t)le * D * DE, D, DE, DE, gu, 1, scr, r - I_G, lane);
              else cvt_item<0>(wd + (size_t)le * DE * D, DE, D, D, dn, 0, scr, r - 2 * I_G, lane); }
        }
        { const int gt = blockIdx.x * NTHREADS + tid, NT_ = G * NTHREADS; const u32x4 z = (u32x4){0u, 0u, 0u, 0u};
          u32x4* z0 = (u32x4*)((bf16_t*)(ws + WS_WDKV) + 320 * 1024); for (int i = gt; i < 192 * 1024 * 2 / 16; i += NT_) z0[i] = z;
          for (int j = 0; j < 2; ++j) { u32x4* z1 = (u32x4*)((bf16_t*)(ws + WS_WDQ) + (size_t)j * 512 * 1024 + 384 * 1024); for (int i = gt; i < 128 * 1024 * 2 / 16; i += NT_) z1[i] = z; } }
    }
}

__device__ __forceinline__ void row_load(const float* p, int lane, f32x4 (&v)[4]) {
#pragma unroll
    for (int j = 0; j < 4; ++j) v[j] = *(const f32x4*)(p + 4 * lane + 256 * j);
}
__device__ __forceinline__ float row_rstd(const f32x4 (&v)[4]) {
    float s = 0.f;
#pragma unroll
    for (int j = 0; j < 4; ++j) s += (v[j].x * v[j].x + v[j].y * v[j].y) + (v[j].z * v[j].z + v[j].w * v[j].w);
    return 1.0f / sqrtf(wave_sum(s) * (1.0f / D) + EPS);
}
__device__ __forceinline__ void row_modulate_store(const f32x4 (&v)[4], float r, const float* g, const float* sc, const float* sh, bf16_t* orow, int lane, f32x4 (*hout)[4] = nullptr) {
#pragma unroll
    for (int j = 0; j < 4; ++j) {
        const int c = 4 * lane + 256 * j;
        const f32x4 gv = *(const f32x4*)(g + c);
        f32x4 h = v[j] * r * gv;
        if (sc) { const f32x4 s1 = *(const f32x4*)(sc + c), s0 = *(const f32x4*)(sh + c); h = h * (s1 + 1.0f) + s0; }
        if (hout) (*hout)[j] = h;
        u32x2 o; o.x = pk2(h.x, h.y); o.y = pk2(h.z, h.w);
        *(u32x2*)(orow + c) = o;
    }
}

__device__ __forceinline__ void phase_mod0(const Args& a) {
    const int tid_ = otid(); const int lane = tid_ & 63, gw = blockIdx.x * 8 + (tid_ >> 6), NGW = gridDim.x * 8;
    const float* x = (const float*)a.in[0]; const float* g = (const float*)a.in[5]; const float* mod = (const float*)(a.ws + WS_MOD);
    bf16_t* HA = (bf16_t*)(a.ws + WS_HA);
    for (int row = gw; row < T; row += NGW) {
        f32x4 v[4]; row_load(x + (size_t)row * D, lane, v);
#pragma unroll
        for (int j = 0; j < 4; ++j) *(f32x4*)(a.out + (size_t)row * D + 4 * lane + 256 * j) = v[j];
        const float r = row_rstd(v); const int b = row / SEQ;
        row_modulate_store(v, r, g, mod + (size_t)b * 6144 + 1024, mod + (size_t)b * 6144, HA + (size_t)row * D, lane);
    }
}

__device__ __forceinline__ void phase_conv(const Args& a, LAS unsigned char* lds, int l) {
    const int tid = otid(), lane = tid & 63, wave = tid >> 6;
    const bf16_t* U = (const bf16_t*)(a.ws + WS_U); bf16_t* V2 = (bf16_t*)(a.ws + WS_V2);
    const float* w_dw = (const float*)a.in[9] + (size_t)l * CWID * D; const float* b_dw = (const float*)a.in[10] + l * D;
    const float* ln_g = (const float*)a.in[11] + l * D; const float* ln_b = (const float*)a.in[12] + l * D;
    constexpr int RC = 16, NR = RC + CWID - 1;
    LAS unsigned* ub = (LAS unsigned*)lds;
    LAS float* red = (LAS float*)(lds + NR * 2048);
    const int c = 2 * tid;
    float w0[CWID], w1[CWID];
#pragma unroll
    for (int j = 0; j < CWID; ++j) { const f32x2 w = *(const f32x2*)(w_dw + (size_t)j * D + c); w0[j] = w.x; w1[j] = w.y; }
    const f32x2 bd = *(const f32x2*)(b_dw + c), lg = *(const f32x2*)(ln_g + c), lb = *(const f32x2*)(ln_b + c);
    for (int it = blockIdx.x; it < T / RC; it += gridDim.x) {
        const int b = it / (SEQ / RC), t0 = (it % (SEQ / RC)) * RC;
        __syncthreads();
        for (int i = tid; i < NR * 128; i += NTHREADS) { const int rr = i >> 7, ch = i & 127; const int t = t0 - (CWID - 1) + rr;
            u32x4 val = (u32x4){0u, 0u, 0u, 0u};
            if (t >= 0) val = *(const u32x4*)(U + ((size_t)b * SEQ + t) * D + ch * 8);
            *(LAS u32x4*)(ub + rr * 512 + ch * 4) = val; }
        __syncthreads();
        float o0[RC], o1[RC];
#pragma unroll
        for (int t = 0; t < RC; ++t) { float s0 = bd.x, s1 = bd.y;
#pragma unroll
            for (int j = 0; j < CWID; ++j) { const unsigned w = ub[(t + j) * 512 + tid]; s0 += bflo(w) * w0[j]; s1 += bfhi(w) * w1[j]; }
            o0[t] = s0; o1[t] = s1; }
#pragma unroll
        for (int t = 0; t < RC; ++t) { const float s = wave_sum(o0[t] + o1[t]); const float q = wave_sum(o0[t] * o0[t] + o1[t] * o1[t]);
            if (lane == 0) { red[(wave * RC + t) * 2] = s; red[(wave * RC + t) * 2 + 1] = q; } }
        __syncthreads();
#pragma unroll
        for (int t = 0; t < RC; ++t) { float s = 0.f, q = 0.f;
#pragma unroll
            for (int w = 0; w < 8; ++w) { s += red[(w * RC + t) * 2]; q += red[(w * RC + t) * 2 + 1]; }
            const float mean = s * (1.0f / D); const float var = fmaxf(q * (1.0f / D) - mean * mean, 0.f); const float rstd = 1.0f / sqrtf(var + EPS);
            const float y0 = (o0[t] - mean) * rstd * lg.x + lb.x, y1 = (o1[t] - mean) * rstd * lg.y + lb.y;
            *(unsigned*)(V2 + ((size_t)b * SEQ + t0 + t) * D + c) = pk2(siluf_(y0), siluf_(y1)); }
    }
}

__device__ __forceinline__ float top2sum4(float a, float b, float c, float d) {
    return fmaxf(fmaxf(fmaxf(a + b, a + c), fmaxf(a + d, b + c)), fmaxf(b + d, c + d));
}
__device__ __forceinline__ void phase_route(const Args& a, LAS unsigned char* lds, int l) {
    const int tid = otid(), lane = tid & 63, wave = tid >> 6, G = gridDim.x;
    const float* X = a.out; bf16_t* H2 = (bf16_t*)(a.ws + WS_H2);
    const float* g = (const float*)a.in[6] + l * D; const float* mod = (const float*)(a.ws + WS_MOD) + (size_t)l * 4 * 6144;
    const float* rw_g = (const float*)a.in[22]; const float* rb = (const float*)a.in[23];
    unsigned* cnt = (unsigned*)(a.ws + WS_CTL) + CW_CNT + 64 * l;
    int* list = (int*)(a.ws + WS_LIST); int* tokinfo = (int*)(a.ws + WS_TOKINFO);
    LAS float* rw = (LAS float*)lds;
    LAS int* lcnt = (LAS int*)(lds + 65536);
    LAS int* sel = (LAS int*)(lds + 65536 + 256);
    for (int i = tid; i < 1024 * 16 / 4; i += NTHREADS) *(LAS f32x4*)(rw + 4 * i) = *(const f32x4*)(rw_g + 4 * i);
    if (tid < 32) lcnt[tid] = 0;
    __syncthreads();
    float rbv[16];
#pragma unroll
    for (int e = 0; e < 16; ++e) rbv[e] = rb[e];
    int nloc = 0;
    for (int base = blockIdx.x * 8; base < T; base += G * 8, ++nloc) {
        const int row = base + wave; const int b = row / SEQ;
        f32x4 v[4]; row_load(X + (size_t)row * D, lane, v);
        const float r = row_rstd(v);
        f32x4 h[4];
        row_modulate_store(v, r, g, mod + (size_t)b * 6144 + 4 * 1024, mod + (size_t)b * 6144 + 3 * 1024, H2 + (size_t)row * D, lane, &h);
        float lg[16];
#pragma unroll
        for (int e = 0; e < 16; ++e) lg[e] = 0.f;
#pragma unroll
        for (int j = 0; j < 4; ++j)
#pragma unroll
            for (int i = 0; i < 4; ++i) { const int c = 4 * lane + 256 * j + i; const float hv = h[j][i];
#pragma unroll
                for (int q = 0; q < 4; ++q) { const f32x4 w = *(const LAS f32x4*)(rw + c * 16 + 4 * q);
                    lg[4 * q + 0] += hv * w.x; lg[4 * q + 1] += hv * w.y; lg[4 * q + 2] += hv * w.z; lg[4 * q + 3] += hv * w.w; } }
        float s[16], sb[16];
#pragma unroll
        for (int e = 0; e < 16; ++e) { s[e] = 1.0f / (1.0f + expf(-wave_sum(lg[e]))); sb[e] = s[e] + rbv[e]; }
        float best = -1e30f; int gi = 0; float wb0 = 0, wb1 = 0, wb2 = 0, wb3 = 0, ws0 = 0, ws1 = 0, ws2 = 0, ws3 = 0;
#pragma unroll
        for (int q = 0; q < 4; ++q) { const float gs = top2sum4(sb[4 * q], sb[4 * q + 1], sb[4 * q + 2], sb[4 * q + 3]);
            if (gs > best) { best = gs; gi = q; wb0 = sb[4 * q]; wb1 = sb[4 * q + 1]; wb2 = sb[4 * q + 2]; wb3 = sb[4 * q + 3]; ws0 = s[4 * q]; ws1 = s[4 * q + 1]; ws2 = s[4 * q + 2]; ws3 = s[4 * q + 3]; } }
        int i1 = 0; float m1 = wb0, sv1 = ws0;
        if (wb1 > m1) { m1 = wb1; i1 = 1; sv1 = ws1; } if (wb2 > m1) { m1 = wb2; i1 = 2; sv1 = ws2; } if (wb3 > m1) { m1 = wb3; i1 = 3; sv1 = ws3; }
        int i2 = -1; float m2 = -1e30f, sv2 = 0.f;
        if (i1 != 0 && wb0 > m2) { m2 = wb0; i2 = 0; sv2 = ws0; } if (i1 != 1 && wb1 > m2) { m2 = wb1; i2 = 1; sv2 = ws1; }
        if (i1 != 2 && wb2 > m2) { m2 = wb2; i2 = 2; sv2 = ws2; } if (i1 != 3 && wb3 > m2) { m2 = wb3; i2 = 3; sv2 = ws3; }
        const int e0 = 4 * gi + i1, e1 = 4 * gi + i2; const float wsum = sv1 + sv2; const float w0 = sv1 / wsum, w1 = sv2 / wsum;
        if (lane == 0) { const int lp0 = atomicAdd((int*)&lcnt[e0], 1), lp1 = atomicAdd((int*)&lcnt[e1], 1);
            LAS int* sp = sel + (nloc * 8 + wave) * 8; sp[0] = row; sp[1] = e0; sp[2] = e1; sp[3] = lp0; sp[4] = lp1; sp[5] = __builtin_bit_cast(int, w0); sp[6] = __builtin_bit_cast(int, w1); }
    }
    __syncthreads();
    if (tid < 16) lcnt[16 + tid] = (int)atomicAdd(&cnt[tid], (unsigned)lcnt[tid]);
    __syncthreads();
    for (int i = tid; i < nloc * 8; i += NTHREADS) { const LAS int* sp = sel + i * 8; const int row = sp[0], e0 = sp[1], e1 = sp[2];
        const int p0 = lcnt[16 + e0] + sp[3], p1 = lcnt[16 + e1] + sp[4];
        list[(size_t)e0 * T + p0] = row; list[(size_t)e1 * T + p1] = row;
        int* ti = tokinfo + (size_t)row * 8; ti[0] = e0; ti[1] = p0; ti[2] = sp[5]; ti[3] = e1; ti[4] = p1; ti[5] = sp[6]; }
    __syncthreads();
}

__device__ __forceinline__ void moe_tiles(const unsigned* cnt, LAS int* tb, LAS int* cn) {
    __syncthreads();
    if (otid() == 0) { int s = 0; for (int e = 0; e < 16; ++e) { const int c = (int)cnt[e]; cn[e] = c; tb[e] = s; s += (c + 255) >> 8; } tb[16] = s; }
    __syncthreads();
}
__device__ __forceinline__ void phase_moe_up(const Args& a, LAS unsigned char* lds, int l) {
    LAS int* tb = (LAS int*)(lds + LDS_TB); LAS int* cn = tb + 32; LAS int* toks = (LAS int*)(lds + LDS_TOK);
    unsigned char* ws = opq(a.ws);
    moe_tiles((const unsigned*)(ws + WS_CTL) + CW_CNT + 64 * l, tb, cn);
    pg8::MoeOrder S{tb, toks, (int)gridDim.x, (int)blockIdx.x};
    { const int tid = otid(); const int* list = (const int*)(ws + WS_LIST); pg8::Unit u;
      for (int ui = 0; ui < 12 && S.next(ui, u); ++ui) { const int e = u.pn >> 2;
          for (int r = tid; r < 256; r += NTHREADS) { const int pos = (u.pm - tb[e]) * 256 + r; toks[ui * 256 + r] = pos < cn[e] ? list[(size_t)e * T + pos] : 0; } }
      __syncthreads(); }
    const pg8::Gemm g{(const bf16_t*)(ws + WS_H2), (const bf16_t*)(ws + WS_WGU) + (size_t)l * 16 * 1024 * 1024, 0, 0, D};
    pg8::gemm_phase<pg8::EpiGated<1>, pg8::MoeOrder, true, true, true>(lds, g, S, pg8::EpiGated<1>{(bf16_t*)(ws + WS_ACT), DE, 3, nullptr});
}
__device__ __forceinline__ void phase_moe_down(const Args& a, LAS unsigned char* lds, int l) {
    LAS int* tb = (LAS int*)(lds + LDS_TB); LAS int* cn = tb + 32; LAS int* toks = (LAS int*)(lds + LDS_TOK);
    unsigned char* ws = opq(a.ws);
    moe_tiles((const unsigned*)(ws + WS_CTL) + CW_CNT + 64 * l, tb, cn);
    pg8::MoeOrder S{tb, toks, (int)gridDim.x, (int)blockIdx.x};
    const pg8::Gemm g{(const bf16_t*)(ws + WS_ACT), (const bf16_t*)(ws + WS_WDN) + (size_t)l * 16 * 1024 * 512, 0, 0, DE};
    pg8::gemm_phase<pg8::EpiBf16, pg8::MoeOrder, true, true, false>(lds, g, S, pg8::EpiBf16{(bf16_t*)(ws + WS_YB), D, 3});
}
__device__ __forceinline__ void phase_combine(const Args& a, LAS unsigned char* lds, int l) {
    LAS int* tb = (LAS int*)(lds + LDS_TB); LAS int* cn = tb + 32;
    const unsigned* cnt = (const unsigned*)(a.ws + WS_CTL) + CW_CNT + 64 * l;
    moe_tiles(cnt, tb, cn);
    const int tid_ = otid(); const int lane = tid_ & 63, gw = blockIdx.x * 8 + (tid_ >> 6), NGW = gridDim.x * 8;
    float* X = a.out; const bf16_t* YB = (const bf16_t*)(a.ws + WS_YB); const int* tokinfo = (const int*)(a.ws + WS_TOKINFO);
    const float* mod = (const float*)(a.ws + WS_MOD);
    for (int row = gw; row < T; row += NGW) {
        const int b = row / SEQ; const int* ti = tokinfo + (size_t)row * 8;
        const int e0 = ti[0], p0 = ti[1], e1 = ti[3], p1 = ti[4]; const float w0 = __builtin_bit_cast(float, ti[2]), w1 = __builtin_bit_cast(float, ti[5]);
        const bf16_t* y0 = YB + (size_t)(tb[e0] * 256 + p0) * D; const bf16_t* y1 = YB + (size_t)(tb[e1] * 256 + p1) * D;
        const float* g2 = mod + ((size_t)l * 4 + b) * 6144 + 5 * 1024;
        f32x4 v[4]; row_load(X + (size_t)row * D, lane, v);
#pragma unroll
        for (int j = 0; j < 4; ++j) { const int c = 4 * lane + 256 * j; const u32x2 a0 = *(const u32x2*)(y0 + c), a1 = *(const u32x2*)(y1 + c); const f32x4 gv = *(const f32x4*)(g2 + c);
            f32x4 y; y.x = w0 * bflo(a0.x) + w1 * bflo(a1.x); y.y = w0 * bfhi(a0.x) + w1 * bfhi(a1.x); y.z = w0 * bflo(a0.y) + w1 * bflo(a1.y); y.w = w0 * bfhi(a0.y) + w1 * bfhi(a1.y);
            v[j] = v[j] + gv * y; }
        const float r = row_rstd(v);
        if (l == DEPTH - 1) {
            const float* fg = (const float*)a.in[27];
#pragma unroll
            for (int j = 0; j < 4; ++j) { const int c = 4 * lane + 256 * j; *(f32x4*)(X + (size_t)row * D + c) = v[j] * r * *(const f32x4*)(fg + c); }
        } else {
#pragma unroll
            for (int j = 0; j < 4; ++j) *(f32x4*)(X + (size_t)row * D + 4 * lane + 256 * j) = v[j];
            const float* mn = mod + ((size_t)(l + 1) * 4 + b) * 6144;
            row_modulate_store(v, r, (const float*)a.in[5] + (l + 1) * D, mn + 1024, mn, (bf16_t*)(a.ws + WS_HA) + (size_t)row * D, lane);
            if (l == 1) row_modulate_store(v, r, (const float*)a.in[14], nullptr, nullptr, (bf16_t*)(a.ws + WS_XKV) + (size_t)row * D, lane);
        }
    }
}

__device__ __forceinline__ void phase_mla_norm(const Args& a, int j) {
    const int tid_ = otid(); const int lane = tid_ & 63, gw = blockIdx.x * 8 + (tid_ >> 6), NGW = gridDim.x * 8;
    const float* CQRAW = (const float*)(a.ws + WS_CQRAW); const float* CKVRAW = (const float*)(a.ws + WS_CKVRAW);
    bf16_t* CQ = (bf16_t*)(a.ws + WS_CQ); bf16_t* LAT = (bf16_t*)(a.ws + WS_LAT); bf16_t* KROPE = (bf16_t*)(a.ws + WS_KROPE);
    const float* qg = (const float*)a.in[19] + j * QR; const float* kg = (const float*)a.in[16]; const f32x2* rope = (const f32x2*)(a.ws + WS_ROPE);
    for (int row = gw; row < T; row += NGW) {
        { f32x2 v[3]; float s = 0.f;
#pragma unroll
          for (int q = 0; q < 3; ++q) { v[q] = *(const f32x2*)(CQRAW + (size_t)row * QR + 2 * lane + 128 * q); s += v[q].x * v[q].x + v[q].y * v[q].y; }
          const float r = 1.0f / sqrtf(wave_sum(s) * (1.0f / QR) + EPS);
#pragma unroll
          for (int q = 0; q < 3; ++q) { const int c = 2 * lane + 128 * q; const f32x2 gv = *(const f32x2*)(qg + c); *(unsigned*)(CQ + (size_t)row * QR + c) = pk2(v[q].x * r * gv.x, v[q].y * r * gv.y); } }
        if (j == 0) {
            const f32x4 v = *(const f32x4*)(CKVRAW + (size_t)row * 320 + 4 * lane);
            const float s = (v.x * v.x + v.y * v.y) + (v.z * v.z + v.w * v.w);
            const float r = 1.0f / sqrtf(wave_sum(s) * (1.0f / KVR) + EPS);
            const f32x4 gv = *(const f32x4*)(kg + 4 * lane);
            u32x2 o; o.x = pk2(v.x * r * gv.x, v.y * r * gv.y); o.y = pk2(v.z * r * gv.z, v.w * r * gv.w);
            *(u32x2*)(LAT + (size_t)row * KVR + 4 * lane) = o;
            if (lane < 32) { const float x1 = CKVRAW[(size_t)row * 320 + 256 + lane], x2 = CKVRAW[(size_t)row * 320 + 288 + lane]; const f32x2 cs = rope[(size_t)row * 32 + lane];
                KROPE[(size_t)row * 64 + lane] = (bf16_t)f2bf(x1 * cs.x - x2 * cs.y); KROPE[(size_t)row * 64 + 32 + lane] = (bf16_t)f2bf(x1 * cs.y + x2 * cs.x); }
        }
    }
}

__device__ __forceinline__ void phase_attn(const Args& a, LAS unsigned char* lds) {
    const int tid = otid(), lane = tid & 63, w = tid >> 6, fr = lane & 15, fq = lane >> 4, G = gridDim.x;
    constexpr int KP = 200, VP = 72;
    LAS bf16_t* Ks = (LAS bf16_t*)lds;
    LAS bf16_t* Vt = Ks + 64 * KP;
    LAS bf16_t* Ps = Vt + 128 * VP;
    const bf16_t* Q = (const bf16_t*)(a.ws + WS_Q); const bf16_t* KV = (const bf16_t*)(a.ws + WS_KV); const bf16_t* KR = (const bf16_t*)(a.ws + WS_KROPE);
    bf16_t* AO = (bf16_t*)(a.ws + WS_AO); const f32x2* rope = (const f32x2*)(a.ws + WS_ROPE);
    constexpr int NU = NB * NH * (SEQ / 128);
    for (int rd = 0; rd * G < NU; ++rd) {
        const int s = rd * G + ((rd & 1) ? (G - 1 - (int)blockIdx.x) : (int)blockIdx.x);
        if (s >= NU) continue;
        const int qb = (SEQ / 128 - 1) - s / (NB * NH), bh = s % (NB * NH), b = bh / NH, h = bh % NH;
        const int q0 = qb * 128; const size_t tb0 = (size_t)b * SEQ;
        bf16x8 qf[6];
        { const size_t row = tb0 + q0 + 16 * w + fr; const bf16_t* qp = Q + row * 1536 + h * DQK + 8 * fq;
#pragma unroll
          for (int ks = 0; ks < 6; ++ks) qf[ks] = *(const bf16x8*)(qp + 32 * ks);
#pragma unroll
          for (int j = 0; j < 8; ++j) { const f32x2 cs = rope[row * 32 + 8 * fq + j]; const float x1 = bf2f((unsigned short)qf[4][j]), x2 = bf2f((unsigned short)qf[5][j]);
              qf[4][j] = (short)f2bf(x1 * cs.x - x2 * cs.y); qf[5][j] = (short)f2bf(x1 * cs.y + x2 * cs.x); } }
        f32x4 o[8]; float m[4], lsum[4];
#pragma unroll
        for (int i = 0; i < 8; ++i) o[i] = (f32x4){0.f, 0.f, 0.f, 0.f};
#pragma unroll
        for (int i = 0; i < 4; ++i) { m[i] = -1e30f; lsum[i] = 0.f; }
        const int ntile = 2 * (qb + 1);
        for (int jt = 0; jt < ntile; ++jt) {
            __syncthreads();
#pragma unroll
            for (int i = 0; i < 3; ++i) { const int c = tid + NTHREADS * i, key = c / 24, ch = c % 24; const size_t tok = tb0 + jt * 64 + key;
                const u32x4 v = (ch < 16) ? *(const u32x4*)(KV + tok * 2048 + h * 256 + ch * 8) : *(const u32x4*)(KR + tok * 64 + (ch - 16) * 8);
                *(LAS u32x4*)(Ks + key * KP + ch * 8) = v; }
#pragma unroll
            for (int i = 0; i < 2; ++i) { const int c = tid + NTHREADS * i, key = c & 63, d8 = c >> 6; const size_t tok = tb0 + jt * 64 + key;
                const u32x4 v = *(const u32x4*)(KV + tok * 2048 + h * 256 + 128 + d8 * 8);
                LAS bf16_t* vp = Vt + (d8 * 8) * VP + key;
                vp[0 * VP] = (bf16_t)(v.x & 0xffffu); vp[1 * VP] = (bf16_t)(v.x >> 16); vp[2 * VP] = (bf16_t)(v.y & 0xffffu); vp[3 * VP] = (bf16_t)(v.y >> 16);
                vp[4 * VP] = (bf16_t)(v.z & 0xffffu); vp[5 * VP] = (bf16_t)(v.z >> 16); vp[6 * VP] = (bf16_t)(v.w & 0xffffu); vp[7 * VP] = (bf16_t)(v.w >> 16); }
            __syncthreads();
            f32x4 sc[4];
#pragma unroll
            for (int n = 0; n < 4; ++n) { sc[n] = (f32x4){0.f, 0.f, 0.f, 0.f};
#pragma unroll
                for (int ks = 0; ks < 6; ++ks) { const bf16x8 kf = *(const LAS bf16x8*)(Ks + (16 * n + fr) * KP + 32 * ks + 8 * fq);
                    sc[n] = __builtin_amdgcn_mfma_f32_16x16x32_bf16(qf[ks], kf, sc[n], 0, 0, 0); } }
            const bool diag = (jt * 64 + 63 > q0 + 16 * w);
#pragma unroll
            for (int n = 0; n < 4; ++n)
#pragma unroll
                for (int rg = 0; rg < 4; ++rg) { float v = sc[n][rg] * ATTN_SCALE;
                    if (diag && (jt * 64 + 16 * n + fr > q0 + 16 * w + 4 * fq + rg)) v = -1e30f;
                    sc[n][rg] = v; }
            float alpha[4];
#pragma unroll
            for (int rg = 0; rg < 4; ++rg) { float mx = fmaxf(fmaxf(sc[0][rg], sc[1][rg]), fmaxf(sc[2][rg], sc[3][rg]));
                mx = fmaxf(mx, __shfl_xor(mx, 1)); mx = fmaxf(mx, __shfl_xor(mx, 2)); mx = fmaxf(mx, __shfl_xor(mx, 4)); mx = fmaxf(mx, __shfl_xor(mx, 8));
                const float mn = fmaxf(m[rg], mx); alpha[rg] = __expf(m[rg] - mn); m[rg] = mn;
                float rs = 0.f;
#pragma unroll
                for (int n = 0; n < 4; ++n) { const float p = __expf(sc[n][rg] - mn); sc[n][rg] = p; rs += p; }
                rs += __shfl_xor(rs, 1); rs += __shfl_xor(rs, 2); rs += __shfl_xor(rs, 4); rs += __shfl_xor(rs, 8);
                lsum[rg] = lsum[rg] * alpha[rg] + rs; }
#pragma unroll
            for (int nd = 0; nd < 8; ++nd) { o[nd].x *= alpha[0]; o[nd].y *= alpha[1]; o[nd].z *= alpha[2]; o[nd].w *= alpha[3]; }
            LAS bf16_t* pw = Ps + w * 16 * VP;
#pragma unroll
            for (int n = 0; n < 4; ++n)
#pragma unroll
                for (int rg = 0; rg < 4; ++rg) pw[(4 * fq + rg) * VP + 16 * n + fr] = (bf16_t)f2bf(sc[n][rg]);
            __syncthreads();
#pragma unroll
            for (int s2 = 0; s2 < 2; ++s2) { const bf16x8 pf = *(const LAS bf16x8*)(pw + fr * VP + 32 * s2 + 8 * fq);
#pragma unroll
                for (int nd = 0; nd < 8; ++nd) { const bf16x8 vf = *(const LAS bf16x8*)(Vt + (16 * nd + fr) * VP + 32 * s2 + 8 * fq);
                    o[nd] = __builtin_amdgcn_mfma_f32_16x16x32_bf16(pf, vf, o[nd], 0, 0, 0); } }
        }
#pragma unroll
        for (int rg = 0; rg < 4; ++rg) { const float inv = 1.0f / lsum[rg]; const size_t row = tb0 + q0 + 16 * w + 4 * fq + rg;
#pragma unroll
            for (int nd = 0; nd < 8; ++nd) AO[row * D + h * 128 + 16 * nd + fr] = (bf16_t)f2bf(o[nd][rg] * inv); }
    }
}

constexpr int PH_PER_LAYER = 9, NPHASE = 2 + DEPTH * PH_PER_LAYER;
__global__ void __launch_bounds__(NTHREADS, 2) fwd(Args a) {
    extern __shared__ __attribute__((aligned(16))) unsigned char lds_raw[];
    LAS unsigned char* lds = (LAS unsigned char*)lds_raw;
    const int lo = a.ph_lo, hi = a.ph_hi;
    volatile LAS unsigned* misc = (volatile LAS unsigned*)(lds + LDS_MISC);
    if (threadIdx.x < 32) misc[threadIdx.x] = 0u;
    __syncthreads();
    XcdBarrier bar; bar.bar = (unsigned*)(a.ws + WS_CTL) + CW_BAR; bar.x = 0; bar.st = misc + 8;
    if (hi - lo > 1) bar = xcd_barrier_post((unsigned*)(a.ws + WS_CTL) + CW_BAR, misc + 8);
#define IN(k) (lo <= (k) && (k) < hi)
#define SEAM(k) do { if ((k) + 1 < hi) xcd_barrier(bar); } while (0)
    unsigned char* ws = a.ws;
    const float* mod = (const float*)(ws + WS_MOD);

    if (IN(0)) { phase_prologue(a, lds); SEAM(0); }
    if (IN(1)) { phase_mod0(a); SEAM(1); }
#pragma unroll 1
    for (int l = 0; l < DEPTH; ++l) {
        const int pb = 2 + PH_PER_LAYER * l;
        if (l < 2) {
            if (IN(pb + 0)) {
                const pg8::Gemm g{(const bf16_t*)(ws + WS_HA), (const bf16_t*)(ws + WS_WIN) + (size_t)l * 2048 * 1024, T, 2048, D};
                pg8::StaticOrder S; S.init(T, 2048, (int)gridDim.x, (int)blockIdx.x);
                pg8::gemm_phase<pg8::EpiGated<0>, pg8::StaticOrder, true, true, false>(lds, g, S, pg8::EpiGated<0>{(bf16_t*)(ws + WS_U), D, 0xffff, (const float*)a.in[8] + l * 2048});
                SEAM(pb + 0); }
            if (IN(pb + 1)) { phase_conv(a, lds, l); SEAM(pb + 1); }
            if (IN(pb + 2)) {
                const pg8::Gemm g{(const bf16_t*)(ws + WS_V2), (const bf16_t*)(ws + WS_WOUT) + (size_t)l * D * D, T, D, D};
                pg8::StaticOrder S; S.init(T, D, (int)gridDim.x, (int)blockIdx.x);
                pg8::gemm_phase<pg8::EpiResid, pg8::StaticOrder, true, true, false>(lds, g, S, pg8::EpiResid{a.out, mod + (size_t)l * 4 * 6144 + 2048});
                SEAM(pb + 2); }
        } else {
            const int j = l - 2;
            if (IN(pb + 0)) {
                { const pg8::Gemm g{(const bf16_t*)(ws + WS_HA), (const bf16_t*)(ws + WS_WDQ) + (size_t)j * 512 * D, T, 512, D};
                  pg8::StaticOrder S; S.init(T, 512, (int)gridDim.x, (int)blockIdx.x);
                  pg8::gemm_phase<pg8::EpiF32, pg8::StaticOrder, true, true, false>(lds, g, S, pg8::EpiF32{(float*)(ws + WS_CQRAW), QR, QR}); }
                if (j == 0) { const pg8::Gemm g{(const bf16_t*)(ws + WS_XKV), (const bf16_t*)(ws + WS_WDKV), T, 512, D};
                  pg8::StaticOrder S; S.init(T, 512, (int)gridDim.x, (int)((blockIdx.x + gridDim.x / 2) % gridDim.x));
                  pg8::gemm_phase<pg8::EpiF32, pg8::StaticOrder, true, true, false>(lds, g, S, pg8::EpiF32{(float*)(ws + WS_CKVRAW), 320, 320}); }
                SEAM(pb + 0); }
            if (IN(pb + 1)) { phase_mla_norm(a, j); SEAM(pb + 1); }
            if (IN(pb + 2)) {
                { const pg8::Gemm g{(const bf16_t*)(ws + WS_CQ), (const bf16_t*)(ws + WS_WUQ) + (size_t)j * 1536 * QR, T, 1536, QR};
                  pg8::StaticOrder S; S.init(T, 1536, (int)gridDim.x, (int)blockIdx.x);
                  pg8::gemm_phase<pg8::EpiBf16, pg8::StaticOrder, true, true, false>(lds, g, S, pg8::EpiBf16{(bf16_t*)(ws + WS_Q), 1536, 0xffff}); }
                if (j == 0) { const pg8::Gemm g{(const bf16_t*)(ws + WS_LAT), (const bf16_t*)(ws + WS_WUKV), T, 2048, KVR};
                  pg8::StaticOrder S; S.init(T, 2048, (int)gridDim.x, (int)((blockIdx.x + gridDim.x / 2) % gridDim.x));
                  pg8::gemm_phase<pg8::EpiBf16, pg8::StaticOrder, true, true, false>(lds, g, S, pg8::EpiBf16{(bf16_t*)(ws + WS_KV), 2048, 0xffff}); }
                SEAM(pb + 2); }
            if (IN(pb + 3)) { phase_attn(a, lds); SEAM(pb + 3); }
            if (IN(pb + 4)) {
                const pg8::Gemm g{(const bf16_t*)(ws + WS_AO), (const bf16_t*)(ws + WS_WO) + (size_t)j * D * D, T, D, D};
                pg8::StaticOrder S; S.init(T, D, (int)gridDim.x, (int)blockIdx.x);
                pg8::gemm_phase<pg8::EpiResid, pg8::StaticOrder, true, true, false>(lds, g, S, pg8::EpiResid{a.out, mod + (size_t)l * 4 * 6144 + 2048});
                SEAM(pb + 4); }
        }
        if (IN(pb + 5)) { phase_route(a, lds, l); SEAM(pb + 5); }
        if (IN(pb + 6)) { phase_moe_up(a, lds, l); SEAM(pb + 6); }
        if (IN(pb + 7)) { phase_moe_down(a, lds, l); SEAM(pb + 7); }
        if (IN(pb + 8)) { phase_combine(a, lds, l); SEAM(pb + 8); }
    }
#undef IN
#undef SEAM
}

extern "C" void kernel_launch(void* const* d_in, const int* in_sizes, int n_in, void* d_out, int out_size, void* d_ws, size_t ws_size, hipStream_t stream) {
    static int grid = 0;
    if (grid == 0) {
        if (n_in != 28 || out_size != T * D || ws_size < WS_END) { fprintf(stderr, "kernel_launch: unexpected shapes (n_in %d out %d ws %zu)\n", n_in, out_size, ws_size); grid = -1; return; }
        int dev = 0, cus = 0, per_cu = 0;
        if (hipGetDevice(&dev) != hipSuccess || hipDeviceGetAttribute(&cus, hipDeviceAttributeMultiprocessorCount, dev) != hipSuccess) { grid = -1; return; }
        if (hipFuncSetAttribute((const void*)fwd, hipFuncAttributeMaxDynamicSharedMemorySize, LDS_BYTES) != hipSuccess) { fprintf(stderr, "kernel_launch: hipFuncSetAttribute failed\n"); grid = -1; return; }
        if (hipOccupancyMaxActiveBlocksPerMultiprocessor(&per_cu, (const void*)fwd, NTHREADS, LDS_BYTES) != hipSuccess || per_cu < 1) fprintf(stderr, "kernel_launch: occupancy query reports %d\n", per_cu);
        (void)hipGetLastError();
        grid = cus;
    }
    if (grid < 0) return;
    (void)hipMemsetAsync((char*)d_ws + WS_CTL, 0, CTL_BYTES, stream);
    Args a{};
    for (int i = 0; i < 28; ++i) a.in[i] = d_in[i];
    a.out = (float*)d_out; a.ws = (unsigned char*)d_ws;
#if MK_ONE_LAUNCH
    a.ph_lo = 0; a.ph_hi = NPHASE;
    hipLaunchKernelGGL(fwd, dim3(grid), dim3(NTHREADS), LDS_BYTES, stream, a);
#else
    for (int ph = 0; ph < NPHASE; ++ph) {
        if (ph >= 2) { const int l = (ph - 2) / PH_PER_LAYER, k = (ph - 2) % PH_PER_LAYER; if (l < 2 && (k == 3 || k == 4)) continue; }
        a.ph_lo = ph; a.ph_hi = ph + 1;
        hipLaunchKernelGGL(fwd, dim3(grid), dim3(NTHREADS), LDS_BYTES, stream, a);
    }
#endif
}
```

```cpp
#include <hip/hip_runtime.h>
#include <cstdio>
#include <cstdint>

#define LAS __attribute__((address_space(3)))
typedef unsigned short bf16_t;
typedef short bf16x8 __attribute__((ext_vector_type(8)));
typedef float f32x4 __attribute__((ext_vector_type(4)));
typedef float f32x2 __attribute__((ext_vector_type(2)));
typedef unsigned u32x4 __attribute__((ext_vector_type(4)));
typedef unsigned u32x2 __attribute__((ext_vector_type(2)));

#ifndef MK_ONE_LAUNCH
#define MK_ONE_LAUNCH 1
#endif

constexpr int NB = 4, SEQ = 4096, T = NB * SEQ, D = 1024, DEPTH = 4;
constexpr int CWID = 31, NH = 8, DQK = 192, QR = 384, KVR = 256;
constexpr int NE = 16, DE = 512;
constexpr float EPS = 1e-6f;
constexpr float ATTN_SCALE = 0.07216878364870322f;

constexpr size_t MiB = 1u << 20;
constexpr size_t WS_CTL = 0, CTL_BYTES = 1 * MiB;
constexpr size_t WS_MOD = 1 * MiB;
constexpr size_t WS_ROPE = 2 * MiB;
constexpr size_t WS_TOKINFO = 6 * MiB;
constexpr size_t WS_LIST = 7 * MiB;
constexpr size_t WS_WIN = 8 * MiB;
constexpr size_t WS_WOUT = 16 * MiB;
constexpr size_t WS_WDKV = 20 * MiB;
constexpr size_t WS_WUKV = 21 * MiB;
constexpr size_t WS_WDQ = 22 * MiB;
constexpr size_t WS_WUQ = 24 * MiB;
constexpr size_t WS_WO = 27 * MiB;
constexpr size_t WS_WGU = 32 * MiB;
constexpr size_t WS_WDN = 160 * MiB;
constexpr size_t WS_HA = 224 * MiB;
constexpr size_t WS_XKV = 256 * MiB;
constexpr size_t WS_U = 288 * MiB;
constexpr size_t WS_H2 = WS_U;
constexpr size_t WS_V2 = 320 * MiB;
constexpr size_t WS_AO = WS_V2;
constexpr size_t WS_YB = 352 * MiB;
constexpr size_t WS_CQRAW = 352 * MiB;
constexpr size_t WS_CKVRAW = 376 * MiB;
constexpr size_t WS_CQ = 396 * MiB;
constexpr size_t WS_LAT = 408 * MiB;
constexpr size_t WS_KROPE = 424 * MiB;
constexpr size_t WS_Q = 426 * MiB;
constexpr size_t WS_ACT = WS_Q;
constexpr size_t WS_KV = 474 * MiB;
constexpr size_t WS_END = 538 * MiB;
constexpr int NSLOT_MAX = 2 * T + NE * 256;

constexpr int CW_BAR = 4096;
constexpr int CW_CNT = 16384;

constexpr int LDS_BYTES = 147456;
constexpr int LDS_EXTRA = 131072;
constexpr int LDS_MISC = LDS_EXTRA + 320;
constexpr int LDS_TB = LDS_EXTRA + 512;
constexpr int LDS_TOK = LDS_EXTRA + 1024;
constexpr int NTHREADS = 512;

#define XB_TMO      128
#define XB_XCNT(j)  (256  + 64 * (j))
#define XB_XSUB(j)  (1280 + 64 * (j))
#define XB_XGEN(j)  (2304 + 64 * (j))
#define XB_TOP      3328
#define XB_TOPGEN   3392
#define XCD_BAR_WORDS 3456
#define XB_SPIN_CAP (1u << 18)

__device__ __forceinline__ unsigned xb_ld(unsigned* p)              { return __hip_atomic_load(p, __ATOMIC_RELAXED, __HIP_MEMORY_SCOPE_AGENT); }
__device__ __forceinline__ unsigned xb_add(unsigned* p, unsigned v) { return __hip_atomic_fetch_add(p, v, __ATOMIC_RELAXED, __HIP_MEMORY_SCOPE_AGENT); }
__device__ __forceinline__ unsigned xb_xcc_id() { return (unsigned)__builtin_amdgcn_s_getreg((3 << 11) | 20) & 0xFu; }
#define XB_SPIN(cond, bar) do { unsigned _sp = 0; while (cond) { __builtin_amdgcn_s_sleep(1); \
    if ((++_sp & 255u) == 0u) { if (xb_ld(&(bar)[XB_TMO])) break; if (_sp > XB_SPIN_CAP) { atomicAdd(&(bar)[XB_TMO], 1u); break; } } } } while (0)

struct XcdBarrier { unsigned* bar; unsigned x; volatile LAS unsigned* st; };

__device__ __forceinline__ XcdBarrier xcd_barrier_post(unsigned* bar, volatile LAS unsigned* st) {
    XcdBarrier b; b.bar = bar; b.x = xb_xcc_id(); b.st = st;
    if (threadIdx.x == 0) (void)xb_add(&bar[XB_XCNT(b.x)], 1u);
    return b;
}
__device__ __forceinline__ void xcd_barrier_complete(unsigned* bar, unsigned x, unsigned& nloc, unsigned& nx) {
    const unsigned G = gridDim.x * gridDim.y * gridDim.z;
    unsigned sum, cnt, mine, sp = 0u;
    for (;;) {
        sum = 0u; cnt = 0u; mine = 0u;
#pragma unroll
        for (unsigned j = 0; j < 16; ++j) { const unsigned c = xb_ld(&bar[XB_XCNT(j)]); sum += c; cnt += (c > 0u) ? 1u : 0u; mine = (j == x) ? c : mine; }
        if (sum == G) break;
        __builtin_amdgcn_s_sleep(1);
        if ((++sp & 255u) == 0u) { if (xb_ld(&bar[XB_TMO])) break; if (sp > XB_SPIN_CAP) { atomicAdd(&bar[XB_TMO], 1u); break; } }
    }
    nloc = mine > 0u ? mine : 1u; nx = cnt > 0u ? cnt : 1u;
}
__device__ __forceinline__ void xcd_barrier(const XcdBarrier& b, bool leader) {
    asm volatile("s_waitcnt vmcnt(0)" ::: "memory");
    __syncthreads();
    if (leader) {
        unsigned* bar = b.bar;
        __builtin_amdgcn_s_waitcnt(0);
        unsigned nloc = b.st[0], nx = b.st[1];
        if (nloc == 0u) { xcd_barrier_complete(bar, b.x, nloc, nx); b.st[0] = nloc; b.st[1] = nx; }
        const unsigned old = xb_add(&bar[XB_XSUB(b.x)], 1u);
        const unsigned gen = old / nloc;
        if (old + 1u == (gen + 1u) * nloc) {
            __builtin_amdgcn_fence(__ATOMIC_RELEASE, "agent");
            asm volatile("s_waitcnt vmcnt(0)" ::: "memory");
            const unsigned og = xb_add(&bar[XB_TOP], 1u);
            const unsigned tg = og / nx;
            if (og + 1u == (tg + 1u) * nx) xb_add(&bar[XB_TOPGEN], 1u);
            else XB_SPIN(xb_ld(&bar[XB_TOPGEN]) == tg, bar);
            __builtin_amdgcn_fence(__ATOMIC_ACQUIRE, "agent");
            xb_add(&bar[XB_XGEN(b.x)], 1u);
            asm volatile("s_waitcnt vmcnt(0)" ::: "memory");
        } else {
            XB_SPIN(xb_ld(&bar[XB_XGEN(b.x)]) == gen, bar);
            __builtin_amdgcn_fence(__ATOMIC_ACQUIRE, "agent");
            asm volatile("s_waitcnt vmcnt(0)" ::: "memory");
        }
    }
    __syncthreads();
}

__device__ __forceinline__ unsigned f2bf(float f) { unsigned u = __builtin_bit_cast(unsigned, f); return (u + 0x7fffu + ((u >> 16) & 1u)) >> 16; }
__device__ __forceinline__ unsigned pk2(float lo, float hi) { return f2bf(lo) | (f2bf(hi) << 16); }
__device__ __forceinline__ float bf2f(unsigned short b) { return __builtin_bit_cast(float, (unsigned)b << 16); }
__device__ __forceinline__ float bflo(unsigned w) { return __builtin_bit_cast(float, w << 16); }
__device__ __forceinline__ float bfhi(unsigned w) { return __builtin_bit_cast(float, w & 0xffff0000u); }
__device__ __forceinline__ float wave_sum(float v) {
#pragma unroll
    for (int o = 1; o < 64; o <<= 1) v += __shfl_xor(v, o);
    return v;
}
__device__ __forceinline__ float sigmoidf_(float x) { return 1.0f / (1.0f + __expf(-x)); }
__device__ __forceinline__ float siluf_(float x) { return x / (1.0f + __expf(-x)); }

struct Args { const void* in[28]; float* out; unsigned char* ws; int ph_lo, ph_hi; };
__device__ __forceinline__ int otid(int wv) { int t; asm volatile("v_mbcnt_lo_u32_b32 %0, -1, 0\n\tv_mbcnt_hi_u32_b32 %0, -1, %0" : "=v"(t)); return (wv << 6) + t; }
#define CAS __attribute__((address_space(4)))
__device__ __forceinline__ Args oargs() {
    const CAS Args* q = (const CAS Args*)__builtin_amdgcn_kernarg_segment_ptr(); asm volatile("" : "+s"(q));
    Args r;
#pragma unroll
    for (int i = 0; i < 28; ++i) r.in[i] = q->in[i];
    r.out = q->out; r.ws = q->ws; r.ph_lo = q->ph_lo; r.ph_hi = q->ph_hi; return r;
}
template <class P> __device__ __forceinline__ P* opq(P* p) { asm volatile("" : "+s"(p)); return p; }

namespace pg8 {
#define PG8_LAS __attribute__((address_space(3)))
constexpr int BM = 256, BK = 64, HALF = 128, HTB = HALF * BK * 2, STAGE_BYTES = 8 * HTB, NXCD = 8, WGM = 8;
__host__ __device__ __forceinline__ int lds_byte(int r, int c) { const int st = (r >> 4) * 2 + (c >> 5), rr = r & 15, cc = c & 31, ob = rr * 64 + cc * 2; return st * 1024 + (ob ^ (((ob >> 9) & 1) << 5)); }
__host__ __device__ __forceinline__ void stage_rc(int b, int& R, int& C) { const int st = b / 1024, sb = b % 1024, swz = sb ^ (((sb >> 9) & 1) << 5); R = (st >> 1) * 16 + swz / 64; C = (st & 1) * 32 + (swz % 64) / 2; }
__host__ __device__ __forceinline__ int perm32(int rho) { const int n = rho >> 4, i = rho & 15; return 8 * (i >> 2) + 4 * n + (i & 3); }
struct Unit { int pm, pn; };
struct Gemm { const bf16_t* A; const bf16_t* Bt; int M, N, K; };
struct StaticOrder {
    int nM, nN, nwg, G, c;
    __host__ __device__ void init(int M, int N, int G_, int c_) { nM = M / BM; nN = N / BM; nwg = nM * nN; G = G_; c = c_; }
    __host__ __device__ bool next(int i, Unit& u) const {
        const long L = (long)i * G + c; if (L >= nwg) return false;
        int wgid = (int)L; { const int q = nwg / NXCD, r = nwg % NXCD, xcd = wgid % NXCD, off = wgid / NXCD; wgid = (xcd < r ? xcd * (q + 1) : r * (q + 1) + (xcd - r) * q) + off; }
        const int nig = WGM * nN, gid = wgid / nig, fm = gid * WGM, gsz = (nM - fm) < WGM ? (nM - fm) : WGM;
        u.pm = fm + ((wgid % nig) % gsz); u.pn = (wgid % nig) / gsz; return true;
    }
    __device__ __forceinline__ const PG8_LAS int* tok(int) const { return nullptr; }
};
struct MoeOrder {
    const PG8_LAS int* tb; const PG8_LAS int* toks; int G, c;
    __device__ __forceinline__ bool next(int i, Unit& u) const {
        const int x = c & 7, idx = c >> 3, rt = i * (G >> 2) + (idx >> 2) * 8 + x;
        if (rt >= tb[16]) return false;
        int e = 0;
#pragma unroll
        for (int q = 1; q < 16; ++q) e += (rt >= tb[q]) ? 1 : 0;
        u.pm = rt; u.pn = e * 4 + (idx & 3); return true;
    }
    __device__ __forceinline__ const PG8_LAS int* tok(int ui) const { return toks + ui * 256; }
};

template <class Epi, class Sched, bool ALIGN_EPI = false, bool SP2 = false, bool GATHER = false>
__device__ __forceinline__ void gemm_phase(PG8_LAS unsigned char* lds, int wv, const Gemm g, const Sched& S, const Epi& E) {
    const int tid = otid(wv), wid = __builtin_amdgcn_readfirstlane(tid >> 6), lane = tid & 63, wr = wid >> 2, wc = wid & 3, fr = lane & 15, fq = lane >> 4;
    const int K = g.K, nt = K / BK;
    unsigned voffA[2], voffB[2];
#pragma unroll
    for (int i = 0; i < 2; ++i) { int R, C; stage_rc(tid * 16 + i * 8192, R, C); const int Rb = Epi::PERM ? ((R & ~31) + perm32(R & 31)) : R;
        voffA[i] = (unsigned)(R * K + C) * 2u; voffB[i] = (unsigned)(Rb * K + C) * 2u; }
    const size_t kstep = (size_t)(BK * 2);
    const size_t hstep = (size_t)HALF * K * 2;
    const size_t tstep = 2 * hstep;
    const unsigned ldsw = (unsigned)wid * 1024u;
    const int aoff = lds_byte(wr * 64 + fr, fq * 8), boff = lds_byte(wc * 32 + fr, fq * 8);
#define PG8_SA(b, h) (((b) * 2 + (h)) * HTB)
#define PG8_SB(b, h) ((4 + (b) * 2 + (h)) * HTB)
#define PG8_STAGE(bufoff, gbase, voff) do { _Pragma("unroll") for (int _i = 0; _i < 2; ++_i) \
        __builtin_amdgcn_global_load_lds((const unsigned*)((const char*)(gbase) + (voff)[_i]), (PG8_LAS unsigned*)(lds + (bufoff) + ldsw + _i * 8192), 16, 0, 0); } while (0)
#define PG8_STAGE_A(bufoff, gbase, hh, VO) do { if constexpr (GATHER) { PG8_STAGE(bufoff, gbase, VO[hh]); } else { PG8_STAGE(bufoff, (gbase) + (hh) * hstep, voffA); } } while (0)
#define PG8_LDA(dst, b, h) do { _Pragma("unroll") for (int m = 0; m < 4; ++m) _Pragma("unroll") for (int k = 0; k < 2; ++k) dst[m][k] = *(const PG8_LAS bf16x8*)(lds + PG8_SA(b, h) + aoff + m * 2048 + k * 1024); } while (0)
#define PG8_LDB(dst, b, h) do { _Pragma("unroll") for (int n = 0; n < 2; ++n) _Pragma("unroll") for (int k = 0; k < 2; ++k) dst[n][k] = *(const PG8_LAS bf16x8*)(lds + PG8_SB(b, h) + boff + n * 2048 + k * 1024); } while (0)
#define PG8_MMA(ai, bj, At, Bt) do { __builtin_amdgcn_s_setprio(1); _Pragma("unroll") for (int m = 0; m < 4; ++m) _Pragma("unroll") for (int n = 0; n < 2; ++n) _Pragma("unroll") for (int k = 0; k < 2; ++k) \
        acc[ai][bj][m][n] = __builtin_amdgcn_mfma_f32_16x16x32_bf16(Bt[n][k], At[m][k], acc[ai][bj][m][n], 0, 0, 0); __builtin_amdgcn_s_setprio(0); } while (0)
#define PG8_WAIT_V(n) asm volatile("s_waitcnt vmcnt(" #n ")" ::: "memory")
#define PG8_WAIT_L(n) asm volatile("s_waitcnt lgkmcnt(" #n ")" ::: "memory")
#define PG8_BAR __builtin_amdgcn_s_barrier()
#define PG8_SCHED __builtin_amdgcn_sched_barrier(0)
#define PG8_GOFF(dst, tk) do { _Pragma("unroll") for (int _i = 0; _i < 2; ++_i) { int _R, _C; stage_rc(tid * 16 + _i * 8192, _R, _C); _Pragma("unroll") for (int _h = 0; _h < 2; ++_h) dst[_h][_i] = (unsigned)((tk)[_h * 128 + _R] * K + _C) * 2u; } } while (0)
    Unit cur, nxt; int ui = 0;
    if (!S.next(0, cur)) return;
    f32x4 acc[2][2][4][2];
#pragma unroll
    for (int a = 0; a < 2; ++a)
#pragma unroll
        for (int b = 0; b < 2; ++b)
#pragma unroll
            for (int m = 0; m < 4; ++m)
#pragma unroll
                for (int n = 0; n < 2; ++n) acc[a][b][m][n] = (f32x4){0.f, 0.f, 0.f, 0.f};
    bf16x8 At[4][2], B0[2][2], B1[2][2];
    unsigned gA[2][2] = {{0u, 0u}, {0u, 0u}}, gAn[2][2] = {{0u, 0u}, {0u, 0u}}, gS[2][2] = {{0u, 0u}, {0u, 0u}};
    if constexpr (GATHER) { PG8_GOFF(gA, S.tok(0)); }
    const char* cA = GATHER ? (const char*)g.A : (const char*)g.A + (size_t)cur.pm * tstep; const char* cB = (const char*)g.Bt + (size_t)cur.pn * tstep;
    if constexpr (SP2) {
        PG8_STAGE(PG8_SB(0, 0), cB, voffB); PG8_STAGE(PG8_SB(0, 1), cB + hstep, voffB); PG8_STAGE_A(PG8_SA(0, 0), cA, 0, gA); PG8_STAGE_A(PG8_SA(0, 1), cA, 1, gA);
        if (wr == 1) PG8_BAR;
        PG8_WAIT_V(2); PG8_BAR;
        PG8_STAGE(PG8_SB(1, 0), cB + kstep, voffB); PG8_STAGE_A(PG8_SA(1, 0), cA + kstep, 0, gA); PG8_STAGE(PG8_SB(1, 1), cB + hstep + kstep, voffB);
        PG8_WAIT_V(6); PG8_BAR;
    } else {
        PG8_STAGE(PG8_SB(0, 0), cB, voffB); PG8_STAGE_A(PG8_SA(0, 0), cA, 0, gA); PG8_STAGE(PG8_SB(0, 1), cB + hstep, voffB); PG8_STAGE_A(PG8_SA(0, 1), cA, 1, gA);
        if (wr == 1) PG8_BAR;
        PG8_WAIT_V(4); PG8_BAR;
        PG8_STAGE(PG8_SB(1, 0), cB + kstep, voffB); PG8_STAGE_A(PG8_SA(1, 0), cA + kstep, 0, gA); PG8_STAGE(PG8_SB(1, 1), cB + hstep + kstep, voffB);
        PG8_WAIT_V(6); PG8_BAR;
    }
    for (;;) {
        const bool has_next = S.next(ui + 1, nxt);
        const char* nA = GATHER ? (const char*)g.A : (has_next ? (const char*)g.A + (size_t)nxt.pm * tstep : cA); const char* nB = has_next ? (const char*)g.Bt + (size_t)nxt.pn * tstep : cB;
        if constexpr (GATHER) { if (has_next) { PG8_GOFF(gAn, S.tok(ui + 1)); } else {
#pragma unroll
            for (int _h = 0; _h < 2; ++_h)
#pragma unroll
                for (int _i = 0; _i < 2; ++_i) gAn[_h][_i] = gA[_h][_i]; } }
        for (int t = 0; t < nt; t += 2) {
            const bool last = (t == nt - 2);
            const char* a1 = cA + (size_t)(t + 1) * kstep;
            const char* a2 = last ? nA : cA + (size_t)(t + 2) * kstep; const char* b2 = last ? nB : cB + (size_t)(t + 2) * kstep;
            const char* a3 = a2 + kstep; const char* b3 = b2 + kstep;
            if constexpr (GATHER) {
#pragma unroll
                for (int _h = 0; _h < 2; ++_h)
#pragma unroll
                    for (int _i = 0; _i < 2; ++_i) gS[_h][_i] = last ? gAn[_h][_i] : gA[_h][_i]; }
            if constexpr (SP2) {
            PG8_LDB(B0, 0, 0); PG8_LDB(B1, 0, 1); PG8_SCHED; PG8_LDA(At, 0, 0); PG8_STAGE_A(PG8_SA(1, 1), a1, 1, gA);
            PG8_WAIT_V(8); PG8_WAIT_L(0); PG8_BAR; PG8_MMA(0, 0, At, B0); PG8_MMA(0, 1, At, B1); PG8_BAR; PG8_SCHED;
            PG8_LDA(At, 0, 1); PG8_STAGE(PG8_SB(0, 0), b2, voffB); PG8_STAGE(PG8_SB(0, 1), b2 + hstep, voffB); PG8_STAGE_A(PG8_SA(0, 0), a2, 0, gS);
            PG8_WAIT_V(8); PG8_WAIT_L(0); PG8_BAR; PG8_MMA(1, 0, At, B0); PG8_MMA(1, 1, At, B1); PG8_BAR; PG8_SCHED;
            PG8_LDB(B0, 1, 0); PG8_LDB(B1, 1, 1); PG8_SCHED; PG8_LDA(At, 1, 0); PG8_STAGE_A(PG8_SA(0, 1), a2, 1, gS);
            PG8_WAIT_V(8); PG8_WAIT_L(0); PG8_BAR; PG8_MMA(0, 0, At, B0); PG8_MMA(0, 1, At, B1); PG8_BAR; PG8_SCHED;
            PG8_LDA(At, 1, 1); PG8_STAGE(PG8_SB(1, 0), b3, voffB); PG8_STAGE(PG8_SB(1, 1), b3 + hstep, voffB); PG8_STAGE_A(PG8_SA(1, 0), a3, 0, gS);
            PG8_WAIT_V(8); PG8_WAIT_L(0); PG8_BAR; PG8_MMA(1, 0, At, B0); PG8_MMA(1, 1, At, B1); PG8_BAR; PG8_SCHED;
            } else {
            PG8_LDB(B0, 0, 0); PG8_SCHED; PG8_LDA(At, 0, 0); PG8_STAGE_A(PG8_SA(1, 1), a1, 1, gA);
            PG8_WAIT_L(8); PG8_BAR; PG8_WAIT_L(0); PG8_MMA(0, 0, At, B0); PG8_BAR; PG8_SCHED;
            PG8_LDB(B1, 0, 1); PG8_STAGE(PG8_SB(0, 0), b2, voffB);
            PG8_BAR; PG8_WAIT_L(0); PG8_MMA(0, 1, At, B1); PG8_BAR;
            PG8_LDA(At, 0, 1); PG8_STAGE_A(PG8_SA(0, 0), a2, 0, gS);
            PG8_BAR; PG8_WAIT_L(0); PG8_MMA(1, 0, At, B0); PG8_BAR; PG8_SCHED;
            PG8_STAGE(PG8_SB(0, 1), b2 + hstep, voffB);
            PG8_WAIT_V(6); PG8_BAR; PG8_MMA(1, 1, At, B1); PG8_BAR;
            PG8_LDB(B0, 1, 0); PG8_SCHED; PG8_LDA(At, 1, 0); PG8_STAGE_A(PG8_SA(0, 1), a2, 1, gS);
            PG8_WAIT_L(8); PG8_BAR; PG8_WAIT_L(0); PG8_MMA(0, 0, At, B0); PG8_BAR; PG8_SCHED;
            PG8_LDB(B1, 1, 1); PG8_STAGE(PG8_SB(1, 0), b3, voffB);
            PG8_BAR; PG8_WAIT_L(0); PG8_MMA(0, 1, At, B1); PG8_BAR;
            PG8_LDA(At, 1, 1); PG8_STAGE_A(PG8_SA(1, 0), a3, 0, gS);
            PG8_BAR; PG8_WAIT_L(0); PG8_MMA(1, 0, At, B0); PG8_BAR; PG8_SCHED;
            PG8_STAGE(PG8_SB(1, 1), b3 + hstep, voffB);
            PG8_WAIT_V(6); PG8_BAR; PG8_MMA(1, 1, At, B1); PG8_BAR;
            }
        }
        if constexpr (ALIGN_EPI) { if (wr == 0) PG8_BAR; }
        E(acc, cur, wr, wc, fr, fq);
        if (!has_next) break;
#pragma unroll
        for (int a = 0; a < 2; ++a)
#pragma unroll
            for (int b = 0; b < 2; ++b)
#pragma unroll
                for (int m = 0; m < 4; ++m)
#pragma unroll
                    for (int n = 0; n < 2; ++n) acc[a][b][m][n] = (f32x4){0.f, 0.f, 0.f, 0.f};
        cur = nxt; cA = nA; cB = nB; ++ui;
        if constexpr (GATHER) {
#pragma unroll
            for (int _h = 0; _h < 2; ++_h)
#pragma unroll
                for (int _i = 0; _i < 2; ++_i) gA[_h][_i] = gAn[_h][_i]; }
        if constexpr (ALIGN_EPI) { if (wr == 1) PG8_BAR; }
    }
    PG8_WAIT_V(0);
    if constexpr (!ALIGN_EPI) { if (wr == 0) PG8_BAR; }
    PG8_BAR;
#undef PG8_SA
#undef PG8_SB
#undef PG8_STAGE
#undef PG8_STAGE_A
#undef PG8_LDA
#undef PG8_LDB
#undef PG8_MMA
#undef PG8_WAIT_V
#undef PG8_WAIT_L
#undef PG8_BAR
#undef PG8_SCHED
#undef PG8_GOFF
}
__device__ __forceinline__ unsigned cvt_pk_bf16(float lo, float hi) { unsigned r; asm volatile("v_cvt_pk_bf16_f32 %0, %1, %2" : "=v"(r) : "v"(lo), "v"(hi)); return r; }
struct EpiBf16 {
    static constexpr bool PERM = true;
    bf16_t* O; int ldc, pnmask;
    __device__ __forceinline__ void operator()(const f32x4 (&acc)[2][2][4][2], const Unit& u, int wr, int wc, int fr, int fq) const {
        const int row0 = u.pm * BM + wr * 64 + fr, col0 = (u.pn & pnmask) * BM + wc * 32 + 8 * fq;
#pragma unroll
        for (int ai = 0; ai < 2; ++ai)
#pragma unroll
            for (int m = 0; m < 4; ++m) { bf16_t* rowp = O + (size_t)(row0 + ai * HALF + m * 16) * ldc + col0;
#pragma unroll
                for (int bj = 0; bj < 2; ++bj) { const f32x4 v0 = acc[ai][bj][m][0], v1 = acc[ai][bj][m][1];
                    u32x4 w; w.x = cvt_pk_bf16(v0[0], v0[1]); w.y = cvt_pk_bf16(v0[2], v0[3]); w.z = cvt_pk_bf16(v1[0], v1[1]); w.w = cvt_pk_bf16(v1[2], v1[3]);
                    *(u32x4*)(rowp + bj * HALF) = w; } }
    }
};
template <int MODE  > struct EpiGated {
    static constexpr bool PERM = true;
    bf16_t* O; int ldc, pnmask; const float* bias;
    __device__ __forceinline__ void operator()(const f32x4 (&acc)[2][2][4][2], const Unit& u, int wr, int wc, int fr, int fq) const {
        const int row0 = u.pm * BM + wr * 64 + fr, ch0 = (u.pn & pnmask) * HALF + wc * 32 + 8 * fq;
        f32x4 ba[2], bg[2];
#pragma unroll
        for (int n = 0; n < 2; ++n) { ba[n] = (f32x4){0.f, 0.f, 0.f, 0.f}; bg[n] = ba[n]; if (MODE == 0) { ba[n] = *(const f32x4*)(bias + ch0 + 4 * n); bg[n] = *(const f32x4*)(bias + 1024 + ch0 + 4 * n); } }
#pragma unroll
        for (int ai = 0; ai < 2; ++ai)
#pragma unroll
            for (int m = 0; m < 4; ++m) { float r[8];
#pragma unroll
                for (int n = 0; n < 2; ++n) { const f32x4 x = acc[ai][0][m][n] + ba[n], y = acc[ai][1][m][n] + bg[n];
#pragma unroll
                    for (int q = 0; q < 4; ++q) r[4 * n + q] = (MODE == 0) ? x[q] * sigmoidf_(y[q]) : siluf_(x[q]) * y[q]; }
                u32x4 w; w.x = cvt_pk_bf16(r[0], r[1]); w.y = cvt_pk_bf16(r[2], r[3]); w.z = cvt_pk_bf16(r[4], r[5]); w.w = cvt_pk_bf16(r[6], r[7]);
                *(u32x4*)(O + (size_t)(row0 + ai * HALF + m * 16) * ldc + ch0) = w; }
    }
};
struct EpiResid {
    static constexpr bool PERM = false;
    float* X; const float* gate;
    __device__ __forceinline__ void operator()(const f32x4 (&acc)[2][2][4][2], const Unit& u, int wr, int wc, int fr, int fq) const {
        const int row0 = u.pm * BM + wr * 64 + fr, col0 = u.pn * BM + wc * 32 + 4 * fq; const float* gp = gate + (size_t)((u.pm * BM) / SEQ) * 6144 + col0;
#pragma unroll
        for (int bj = 0; bj < 2; ++bj)
#pragma unroll
            for (int n = 0; n < 2; ++n) { const f32x4 gv = *(const f32x4*)(gp + bj * HALF + n * 16);
#pragma unroll
                for (int ai = 0; ai < 2; ++ai)
#pragma unroll
                    for (int m = 0; m < 4; ++m) { float* p = X + (size_t)(row0 + ai * HALF + m * 16) * D + col0 + bj * HALF + n * 16; *(f32x4*)p = *(const f32x4*)p + gv * acc[ai][bj][m][n]; } }
    }
};
struct EpiF32 {
    static constexpr bool PERM = false;
    float* O; int ldc, ncols;
    __device__ __forceinline__ void operator()(const f32x4 (&acc)[2][2][4][2], const Unit& u, int wr, int wc, int fr, int fq) const {
        const int row0 = u.pm * BM + wr * 64 + fr, col0 = u.pn * BM + wc * 32 + 4 * fq;
#pragma unroll
        for (int bj = 0; bj < 2; ++bj)
#pragma unroll
            for (int n = 0; n < 2; ++n) { const int c = col0 + bj * HALF + n * 16;
                if (c < ncols) {
#pragma unroll
                    for (int ai = 0; ai < 2; ++ai)
#pragma unroll
                        for (int m = 0; m < 4; ++m) *(f32x4*)(O + (size_t)(row0 + ai * HALF + m * 16) * ldc + c) = acc[ai][bj][m][n]; } }
    }
};
}

__device__ __forceinline__ int pair_row(int ch, int half) { return (ch >> 7) * 256 + half * 128 + (ch & 127); }

template <int MODE>
__device__ __forceinline__ void cvt_item(const float* W, int K, int N, int ld, bf16_t* WT, int row_off_or_half, LAS float* scr, int item, int lane) {
    const int nblk = N / 32, kb = item / nblk, nb = item % nblk, k0 = 64 * kb, n0 = 32 * nb;
#pragma unroll 8
    for (int i = 0; i < 32; ++i) { const int kk = 2 * i + (lane >> 5); scr[kk * 33 + (lane & 31)] = W[(size_t)(k0 + kk) * ld + n0 + (lane & 31)]; }
    asm volatile("s_waitcnt lgkmcnt(0)" ::: "memory");
    const int c = lane & 7;
#pragma unroll
    for (int j = 0; j < 4; ++j) { const int n = (lane >> 3) + 8 * j; const LAS float* s = scr + (8 * c) * 33 + n;
        u32x4 o; o.x = pk2(s[0 * 33], s[1 * 33]); o.y = pk2(s[2 * 33], s[3 * 33]); o.z = pk2(s[4 * 33], s[5 * 33]); o.w = pk2(s[6 * 33], s[7 * 33]);
        const int drow = (MODE == 0) ? (row_off_or_half + n0 + n) : pair_row(n0 + n, row_off_or_half);
        *(u32x4*)(WT + (size_t)drow * K + k0 + 8 * c) = o; }
    asm volatile("s_waitcnt lgkmcnt(0)" ::: "memory");
}

__device__ __forceinline__ void phase_prologue(LAS unsigned char* lds, int wv) {
    const Args a = oargs();
    const int tid = otid(wv), lane = tid & 63, wave = tid >> 6, G = gridDim.x;
    unsigned char* ws = a.ws;
    {
        const float* c = (const float*)a.in[1]; const float* ada_w = (const float*)a.in[3]; const float* ada_b = (const float*)a.in[4];
        float* mod = (float*)(ws + WS_MOD);
        LAS float* cs = (LAS float*)lds;
        LAS float* red = cs + 4096;
        bool have = false;
        for (int it = blockIdx.x; it < 4 * 48; it += G) {
            if (!have) { for (int i = tid; i < 4096; i += NTHREADS) cs[i] = siluf_(c[i]); have = true; }
            __syncthreads();
            const int l = it / 48, n0 = (it % 48) * 128;
            const float* wp = ada_w + (size_t)l * D * 6144 + n0 + 2 * lane;
            float acc[4][2] = {{0.f, 0.f}, {0.f, 0.f}, {0.f, 0.f}, {0.f, 0.f}};
            const int kb = wave * 128;
#pragma unroll 4
            for (int k = 0; k < 128; ++k) {
                const f32x2 w = *(const f32x2*)(wp + (size_t)(kb + k) * 6144);
#pragma unroll
                for (int b = 0; b < 4; ++b) { const float cv = cs[b * 1024 + kb + k]; acc[b][0] += cv * w.x; acc[b][1] += cv * w.y; }
            }
#pragma unroll
            for (int b = 0; b < 4; ++b) { red[(wave * 4 + b) * 128 + 2 * lane] = acc[b][0]; red[(wave * 4 + b) * 128 + 2 * lane + 1] = acc[b][1]; }
            __syncthreads();
            { const int b = tid >> 7, col = tid & 127; float s = 0.f;
#pragma unroll
              for (int w = 0; w < 8; ++w) s += red[(w * 4 + b) * 128 + col];
              mod[((size_t)l * 4 + b) * 6144 + n0 + col] = s + ada_b[l * 6144 + n0 + col]; }
        }
        __syncthreads();
    }
    {
        const int* pos = (const int*)a.in[2]; f32x2* rt = (f32x2*)(ws + WS_ROPE);
        for (int idx = blockIdx.x * NTHREADS + tid; idx < T * 32; idx += G * NTHREADS) {
            const int t = idx >> 5, i = idx & 31;
            const float inv = exp2f(-(float)i * (13.287712379549449f / 32.0f));
            const float ang = (float)pos[t] * inv;
            const float kf = rintf(ang * 0.15915494309189535f);
            float r = fmaf(-kf, 6.28125f, ang); r = fmaf(-kf, 1.9353071795864769e-3f, r);
            rt[idx] = (f32x2){__cosf(r), __sinf(r)};
        }
    }
    {
        LAS float* scr = (LAS float*)(lds + wave * 16384);
        const int gw = blockIdx.x * 8 + wave, NGW = G * 8;
        const float* w_in = (const float*)a.in[7]; const float* w_out = (const float*)a.in[13]; const float* w_dkv = (const float*)a.in[15]; const float* w_ukv = (const float*)a.in[17];
        const float* w_dq = (const float*)a.in[18]; const float* w_uq = (const float*)a.in[20]; const float* w_o = (const float*)a.in[21];
        const float* wg = (const float*)a.in[24]; const float* wu = (const float*)a.in[25]; const float* wd = (const float*)a.in[26];
        constexpr int I_IN = 16 * 64, I_OUT = 16 * 32, I_DKV = 16 * 10, I_UKV = 4 * 64, I_DQ = 16 * 12, I_UQ = 6 * 48, I_O = 16 * 32;
        constexpr int I_G = 16 * 16, I_D = 8 * 32;
        constexpr int NSMALL = 2 * I_IN + 2 * I_OUT + I_DKV + I_UKV + 2 * I_DQ + 2 * I_UQ + 2 * I_O;
        constexpr int NEXP = 4 * 16 * (2 * I_G + I_D);
        for (int it = gw; it < NSMALL + NEXP; it += NGW) {
            int r = it;
            if (r < 2 * I_IN) { const int l = r / I_IN; r %= I_IN; const int half = r / 512;
                cvt_item<1>(w_in + (size_t)l * D * 2048 + half * 1024, D, 1024, 2048, (bf16_t*)(ws + WS_WIN) + (size_t)l * 2048 * 1024, half, scr, r % 512, lane); continue; }
            r -= 2 * I_IN;
            if (r < 2 * I_OUT) { const int l = r / I_OUT; cvt_item<0>(w_out + (size_t)l * D * D, D, D, D, (bf16_t*)(ws + WS_WOUT) + (size_t)l * D * D, 0, scr, r % I_OUT, lane); continue; }
            r -= 2 * I_OUT;
            if (r < I_DKV) { cvt_item<0>(w_dkv, D, 320, 320, (bf16_t*)(ws + WS_WDKV), 0, scr, r, lane); continue; }
            r -= I_DKV;
            if (r < I_UKV) { cvt_item<0>(w_ukv, KVR, 2048, 2048, (bf16_t*)(ws + WS_WUKV), 0, scr, r, lane); continue; }
            r -= I_UKV;
            if (r < 2 * I_DQ) { const int j = r / I_DQ; cvt_item<0>(w_dq + (size_t)j * D * QR, D, QR, QR, (bf16_t*)(ws + WS_WDQ) + (size_t)j * 512 * D, 0, scr, r % I_DQ, lane); continue; }
            r -= 2 * I_DQ;
            if (r < 2 * I_UQ) { const int j = r / I_UQ; cvt_item<0>(w_uq + (size_t)j * QR * 1536, QR, 1536, 1536, (bf16_t*)(ws + WS_WUQ) + (size_t)j * 1536 * QR, 0, scr, r % I_UQ, lane); continue; }
            r -= 2 * I_UQ;
            if (r < 2 * I_O) { const int j = r / I_O; cvt_item<0>(w_o + (size_t)j * D * D, D, D, D, (bf16_t*)(ws + WS_WO) + (size_t)j * D * D, 0, scr, r % I_O, lane); continue; }
            r -= 2 * I_O;
            { const int per = 2 * I_G + I_D; const int le = r / per; r %= per;
              bf16_t* gu = (bf16_t*)(ws + WS_WGU) + (size_t)le * 1024 * 1024; bf16_t* dn = (bf16_t*)(ws + WS_WDN) + (size_t)le * 1024 * 512;
              if (r < I_G) cvt_item<1>(wg + (size_t)le * D * DE, D, DE, DE, gu, 0, scr, r, lane);
              else if (r < 2 * I_G) cvt_item<1>(wu + (size_t)le * D * DE, D, DE, DE, gu, 1, scr, r - I_G, lane);
              else cvt_item<0>(wd + (size_t)le * DE * D, DE, D, D, dn, 0, scr, r - 2 * I_G, lane); }
        }
        { const int gt = blockIdx.x * NTHREADS + tid, NT_ = G * NTHREADS; const u32x4 z = (u32x4){0u, 0u, 0u, 0u};
          u32x4* z0 = (u32x4*)((bf16_t*)(ws + WS_WDKV) + 320 * 1024); for (int i = gt; i < 192 * 1024 * 2 / 16; i += NT_) z0[i] = z;
          for (int j = 0; j < 2; ++j) { u32x4* z1 = (u32x4*)((bf16_t*)(ws + WS_WDQ) + (size_t)j * 512 * 1024 + 384 * 1024); for (int i = gt; i < 128 * 1024 * 2 / 16; i += NT_) z1[i] = z; } }
    }
}

__device__ __forceinline__ void row_load(const float* p, int lane, f32x4 (&v)[4]) {
#pragma unroll
    for (int j = 0; j < 4; ++j) v[j] = *(const f32x4*)(p + 4 * lane + 256 * j);
}
__device__ __forceinline__ float row_rstd(const f32x4 (&v)[4]) {
    float s = 0.f;
#pragma unroll
    for (int j = 0; j < 4; ++j) s += (v[j].x * v[j].x + v[j].y * v[j].y) + (v[j].z * v[j].z + v[j].w * v[j].w);
    return 1.0f / sqrtf(wave_sum(s) * (1.0f / D) + EPS);
}
__device__ __forceinline__ void row_modulate_store(const f32x4 (&v)[4], float r, const float* g, const float* sc, const float* sh, bf16_t* orow, int lane, f32x4 (*hout)[4] = nullptr) {
#pragma unroll
    for (int j = 0; j < 4; ++j) {
        const int c = 4 * lane + 256 * j;
        const f32x4 gv = *(const f32x4*)(g + c);
        f32x4 h = v[j] * r * gv;
        if (sc) { const f32x4 s1 = *(const f32x4*)(sc + c), s0 = *(const f32x4*)(sh + c); h = h * (s1 + 1.0f) + s0; }
        if (hout) (*hout)[j] = h;
        u32x2 o; o.x = pk2(h.x, h.y); o.y = pk2(h.z, h.w);
        *(u32x2*)(orow + c) = o;
    }
}

__device__ __forceinline__ void phase_mod0(int wv) {
    const Args a = oargs();
    const int tid_ = otid(wv); const int lane = tid_ & 63, gw = blockIdx.x * 8 + (tid_ >> 6), NGW = gridDim.x * 8;
    const float* x = (const float*)a.in[0]; const float* g = (const float*)a.in[5]; const float* mod = (const float*)(a.ws + WS_MOD);
    bf16_t* HA = (bf16_t*)(a.ws + WS_HA);
    for (int row = gw; row < T; row += NGW) {
        f32x4 v[4]; row_load(x + (size_t)row * D, lane, v);
#pragma unroll
        for (int j = 0; j < 4; ++j) *(f32x4*)(a.out + (size_t)row * D + 4 * lane + 256 * j) = v[j];
        const float r = row_rstd(v); const int b = row / SEQ;
        row_modulate_store(v, r, g, mod + (size_t)b * 6144 + 1024, mod + (size_t)b * 6144, HA + (size_t)row * D, lane);
    }
}

__device__ __forceinline__ void phase_conv(LAS unsigned char* lds, int wv, int l) {
    const Args a = oargs();
    const int tid = otid(wv), lane = tid & 63, wave = tid >> 6;
    const bf16_t* U = (const bf16_t*)(a.ws + WS_U); bf16_t* V2 = (bf16_t*)(a.ws + WS_V2);
    const float* w_dw = (const float*)a.in[9] + (size_t)l * CWID * D; const float* b_dw = (const float*)a.in[10] + l * D;
    const float* ln_g = (const float*)a.in[11] + l * D; const float* ln_b = (const float*)a.in[12] + l * D;
    constexpr int RC = 16, NR = RC + CWID - 1;
    LAS unsigned* ub = (LAS unsigned*)lds;
    LAS float* red = (LAS float*)(lds + NR * 2048);
    const int c = 2 * tid;
    float w0[CWID], w1[CWID];
#pragma unroll
    for (int j = 0; j < CWID; ++j) { const f32x2 w = *(const f32x2*)(w_dw + (size_t)j * D + c); w0[j] = w.x; w1[j] = w.y; }
    const f32x2 bd = *(const f32x2*)(b_dw + c), lg = *(const f32x2*)(ln_g + c), lb = *(const f32x2*)(ln_b + c);
    for (int it = blockIdx.x; it < T / RC; it += gridDim.x) {
        const int b = it / (SEQ / RC), t0 = (it % (SEQ / RC)) * RC;
        __syncthreads();
        for (int i = tid; i < NR * 128; i += NTHREADS) { const int rr = i >> 7, ch = i & 127; const int t = t0 - (CWID - 1) + rr;
            u32x4 val = (u32x4){0u, 0u, 0u, 0u};
            if (t >= 0) val = *(const u32x4*)(U + ((size_t)b * SEQ + t) * D + ch * 8);
            *(LAS u32x4*)(ub + rr * 512 + ch * 4) = val; }
        __syncthreads();
        float o0[RC], o1[RC];
#pragma unroll
        for (int t = 0; t < RC; ++t) { float s0 = bd.x, s1 = bd.y;
#pragma unroll
            for (int j = 0; j < CWID; ++j) { const unsigned w = ub[(t + j) * 512 + tid]; s0 += bflo(w) * w0[j]; s1 += bfhi(w) * w1[j]; }
            o0[t] = s0; o1[t] = s1; }
#pragma unroll
        for (int t = 0; t < RC; ++t) { const float s = wave_sum(o0[t] + o1[t]); const float q = wave_sum(o0[t] * o0[t] + o1[t] * o1[t]);
            if (lane == 0) { red[(wave * RC + t) * 2] = s; red[(wave * RC + t) * 2 + 1] = q; } }
        __syncthreads();
#pragma unroll
        for (int t = 0; t < RC; ++t) { float s = 0.f, q = 0.f;
#pragma unroll
            for (int w = 0; w < 8; ++w) { s += red[(w * RC + t) * 2]; q += red[(w * RC + t) * 2 + 1]; }
            const float mean = s * (1.0f / D); const float var = fmaxf(q * (1.0f / D) - mean * mean, 0.f); const float rstd = 1.0f / sqrtf(var + EPS);
            const float y0 = (o0[t] - mean) * rstd * lg.x + lb.x, y1 = (o1[t] - mean) * rstd * lg.y + lb.y;
            *(unsigned*)(V2 + ((size_t)b * SEQ + t0 + t) * D + c) = pk2(siluf_(y0), siluf_(y1)); }
    }
}

__device__ __forceinline__ float top2sum4(float a, float b, float c, float d) {
    return fmaxf(fmaxf(fmaxf(a + b, a + c), fmaxf(a + d, b + c)), fmaxf(b + d, c + d));
}
__device__ __forceinline__ void phase_route(LAS unsigned char* lds, int wv, int l) {
    const Args a = oargs();
    const int tid = otid(wv), lane = tid & 63, wave = tid >> 6, G = gridDim.x;
    const float* X = a.out; bf16_t* H2 = (bf16_t*)(a.ws + WS_H2);
    const float* g = (const float*)a.in[6] + l * D; const float* mod = (const float*)(a.ws + WS_MOD) + (size_t)l * 4 * 6144;
    const float* rw_g = (const float*)a.in[22]; const float* rb = (const float*)a.in[23];
    unsigned* cnt = (unsigned*)(a.ws + WS_CTL) + CW_CNT + 64 * l;
    int* list = (int*)(a.ws + WS_LIST); int* tokinfo = (int*)(a.ws + WS_TOKINFO);
    LAS float* rw = (LAS float*)lds;
    LAS int* lcnt = (LAS int*)(lds + 65536);
    LAS int* sel = (LAS int*)(lds + 65536 + 256);
    for (int i = tid; i < 1024 * 16 / 4; i += NTHREADS) *(LAS f32x4*)(rw + 4 * i) = *(const f32x4*)(rw_g + 4 * i);
    if (tid < 32) lcnt[tid] = 0;
    __syncthreads();
    float rbv[16];
#pragma unroll
    for (int e = 0; e < 16; ++e) rbv[e] = rb[e];
    int nloc = 0;
    for (int base = blockIdx.x * 8; base < T; base += G * 8, ++nloc) {
        const int row = base + wave; const int b = row / SEQ;
        f32x4 v[4]; row_load(X + (size_t)row * D, lane, v);
        const float r = row_rstd(v);
        f32x4 h[4];
        row_modulate_store(v, r, g, mod + (size_t)b * 6144 + 4 * 1024, mod + (size_t)b * 6144 + 3 * 1024, H2 + (size_t)row * D, lane, &h);
        float lg[16];
#pragma unroll
        for (int e = 0; e < 16; ++e) lg[e] = 0.f;
#pragma unroll
        for (int j = 0; j < 4; ++j)
#pragma unroll
            for (int i = 0; i < 4; ++i) { const int c = 4 * lane + 256 * j + i; const float hv = h[j][i];
#pragma unroll
                for (int q = 0; q < 4; ++q) { const f32x4 w = *(const LAS f32x4*)(rw + c * 16 + 4 * q);
                    lg[4 * q + 0] += hv * w.x; lg[4 * q + 1] += hv * w.y; lg[4 * q + 2] += hv * w.z; lg[4 * q + 3] += hv * w.w; } }
        float s[16], sb[16];
#pragma unroll
        for (int e = 0; e < 16; ++e) { s[e] = 1.0f / (1.0f + expf(-wave_sum(lg[e]))); sb[e] = s[e] + rbv[e]; }
        float best = -1e30f; int gi = 0; float wb0 = 0, wb1 = 0, wb2 = 0, wb3 = 0, ws0 = 0, ws1 = 0, ws2 = 0, ws3 = 0;
#pragma unroll
        for (int q = 0; q < 4; ++q) { const float gs = top2sum4(sb[4 * q], sb[4 * q + 1], sb[4 * q + 2], sb[4 * q + 3]);
            if (gs > best) { best = gs; gi = q; wb0 = sb[4 * q]; wb1 = sb[4 * q + 1]; wb2 = sb[4 * q + 2]; wb3 = sb[4 * q + 3]; ws0 = s[4 * q]; ws1 = s[4 * q + 1]; ws2 = s[4 * q + 2]; ws3 = s[4 * q + 3]; } }
        int i1 = 0; float m1 = wb0, sv1 = ws0;
        if (wb1 > m1) { m1 = wb1; i1 = 1; sv1 = ws1; } if (wb2 > m1) { m1 = wb2; i1 = 2; sv1 = ws2; } if (wb3 > m1) { m1 = wb3; i1 = 3; sv1 = ws3; }
        int i2 = -1; float m2 = -1e30f, sv2 = 0.f;
        if (i1 != 0 && wb0 > m2) { m2 = wb0; i2 = 0; sv2 = ws0; } if (i1 != 1 && wb1 > m2) { m2 = wb1; i2 = 1; sv2 = ws1; }
        if (i1 != 2 && wb2 > m2) { m2 = wb2; i2 = 2; sv2 = ws2; } if (i1 != 3 && wb3 > m2) { m2 = wb3; i2 = 3; sv2 = ws3; }
        const int e0 = 4 * gi + i1, e1 = 4 * gi + i2; const float wsum = sv1 + sv2; const float w0 = sv1 / wsum, w1 = sv2 / wsum;
        if (lane == 0) { const int lp0 = atomicAdd((int*)&lcnt[e0], 1), lp1 = atomicAdd((int*)&lcnt[e1], 1);
            LAS int* sp = sel + (nloc * 8 + wave) * 8; sp[0] = row; sp[1] = e0; sp[2] = e1; sp[3] = lp0; sp[4] = lp1; sp[5] = __builtin_bit_cast(int, w0); sp[6] = __builtin_bit_cast(int, w1); }
    }
    __syncthreads();
    if (tid < 16) lcnt[16 + tid] = (int)atomicAdd(&cnt[tid], (unsigned)lcnt[tid]);
    __syncthreads();
    for (int i = tid; i < nloc * 8; i += NTHREADS) { const LAS int* sp = sel + i * 8; const int row = sp[0], e0 = sp[1], e1 = sp[2];
        const int p0 = lcnt[16 + e0] + sp[3], p1 = lcnt[16 + e1] + sp[4];
        list[(size_t)e0 * T + p0] = row; list[(size_t)e1 * T + p1] = row;
        int* ti = tokinfo + (size_t)row * 8; ti[0] = e0; ti[1] = p0; ti[2] = sp[5]; ti[3] = e1; ti[4] = p1; ti[5] = sp[6]; }
    __syncthreads();
}

__device__ __forceinline__ void moe_tiles(int wv, const unsigned* cnt, LAS int* tb, LAS int* cn) {
    __syncthreads();
    if (otid(wv) == 0) { int s = 0; for (int e = 0; e < 16; ++e) { const int c = (int)cnt[e]; cn[e] = c; tb[e] = s; s += (c + 255) >> 8; } tb[16] = s; }
    __syncthreads();
}
__device__ __forceinline__ void phase_moe_up(LAS unsigned char* lds, int wv, int l) {
    const Args a = oargs();
    LAS int* tb = (LAS int*)(lds + LDS_TB); LAS int* cn = tb + 32; LAS int* toks = (LAS int*)(lds + LDS_TOK);
    unsigned char* ws = a.ws;
    moe_tiles(wv, (const unsigned*)(ws + WS_CTL) + CW_CNT + 64 * l, tb, cn);
    pg8::MoeOrder S{tb, toks, (int)gridDim.x, (int)blockIdx.x};
    { const int tid = otid(wv); const int* list = (const int*)(ws + WS_LIST); pg8::Unit u;
      for (int ui = 0; ui < 12 && S.next(ui, u); ++ui) { const int e = u.pn >> 2;
          for (int r = tid; r < 256; r += NTHREADS) { const int pos = (u.pm - tb[e]) * 256 + r; toks[ui * 256 + r] = pos < cn[e] ? list[(size_t)e * T + pos] : 0; } }
      __syncthreads(); }
    const pg8::Gemm g{(const bf16_t*)(ws + WS_H2), (const bf16_t*)(ws + WS_WGU) + (size_t)l * 16 * 1024 * 1024, 0, 0, D};
    pg8::gemm_phase<pg8::EpiGated<1>, pg8::MoeOrder, true, true, true>(lds, wv, g, S, pg8::EpiGated<1>{(bf16_t*)(ws + WS_ACT), DE, 3, nullptr});
}
__device__ __forceinline__ void phase_moe_down(LAS unsigned char* lds, int wv, int l) {
    const Args a = oargs();
    LAS int* tb = (LAS int*)(lds + LDS_TB); LAS int* cn = tb + 32; LAS int* toks = (LAS int*)(lds + LDS_TOK);
    unsigned char* ws = a.ws;
    moe_tiles(wv, (const unsigned*)(ws + WS_CTL) + CW_CNT + 64 * l, tb, cn);
    pg8::MoeOrder S{tb, toks, (int)gridDim.x, (int)blockIdx.x};
    const pg8::Gemm g{(const bf16_t*)(ws + WS_ACT), (const bf16_t*)(ws + WS_WDN) + (size_t)l * 16 * 1024 * 512, 0, 0, DE};
    pg8::gemm_phase<pg8::EpiBf16, pg8::MoeOrder, true, true, false>(lds, wv, g, S, pg8::EpiBf16{(bf16_t*)(ws + WS_YB), D, 3});
}
__device__ __forceinline__ void phase_combine(LAS unsigned char* lds, int wv, int l) {
    const Args a = oargs();
    LAS int* tb = (LAS int*)(lds + LDS_TB); LAS int* cn = tb + 32;
    const unsigned* cnt = (const unsigned*)(a.ws + WS_CTL) + CW_CNT + 64 * l;
    moe_tiles(wv, cnt, tb, cn);
    const int tid_ = otid(wv); const int lane = tid_ & 63, gw = blockIdx.x * 8 + (tid_ >> 6), NGW = gridDim.x * 8;
    float* X = a.out; const bf16_t* YB = (const bf16_t*)(a.ws + WS_YB); const int* tokinfo = (const int*)(a.ws + WS_TOKINFO);
    const float* mod = (const float*)(a.ws + WS_MOD);
    for (int row = gw; row < T; row += NGW) {
        const int b = row / SEQ; const int* ti = tokinfo + (size_t)row * 8;
        const int e0 = ti[0], p0 = ti[1], e1 = ti[3], p1 = ti[4]; const float w0 = __builtin_bit_cast(float, ti[2]), w1 = __builtin_bit_cast(float, ti[5]);
        const bf16_t* y0 = YB + (size_t)(tb[e0] * 256 + p0) * D; const bf16_t* y1 = YB + (size_t)(tb[e1] * 256 + p1) * D;
        const float* g2 = mod + ((size_t)l * 4 + b) * 6144 + 5 * 1024;
        f32x4 v[4]; row_load(X + (size_t)row * D, lane, v);
#pragma unroll
        for (int j = 0; j < 4; ++j) { const int c = 4 * lane + 256 * j; const u32x2 a0 = *(const u32x2*)(y0 + c), a1 = *(const u32x2*)(y1 + c); const f32x4 gv = *(const f32x4*)(g2 + c);
            f32x4 y; y.x = w0 * bflo(a0.x) + w1 * bflo(a1.x); y.y = w0 * bfhi(a0.x) + w1 * bfhi(a1.x); y.z = w0 * bflo(a0.y) + w1 * bflo(a1.y); y.w = w0 * bfhi(a0.y) + w1 * bfhi(a1.y);
            v[j] = v[j] + gv * y; }
        const float r = row_rstd(v);
        if (l == DEPTH - 1) {
            const float* fg = (const float*)a.in[27];
#pragma unroll
            for (int j = 0; j < 4; ++j) { const int c = 4 * lane + 256 * j; *(f32x4*)(X + (size_t)row * D + c) = v[j] * r * *(const f32x4*)(fg + c); }
        } else {
#pragma unroll
            for (int j = 0; j < 4; ++j) *(f32x4*)(X + (size_t)row * D + 4 * lane + 256 * j) = v[j];
            const float* mn = mod + ((size_t)(l + 1) * 4 + b) * 6144;
            row_modulate_store(v, r, (const float*)a.in[5] + (l + 1) * D, mn + 1024, mn, (bf16_t*)(a.ws + WS_HA) + (size_t)row * D, lane);
            if (l == 1) row_modulate_store(v, r, (const float*)a.in[14], nullptr, nullptr, (bf16_t*)(a.ws + WS_XKV) + (size_t)row * D, lane);
        }
    }
}

__device__ __forceinline__ void phase_mla_norm(int wv, int j) {
    const Args a = oargs();
    const int tid_ = otid(wv); const int lane = tid_ & 63, gw = blockIdx.x * 8 + (tid_ >> 6), NGW = gridDim.x * 8;
    const float* CQRAW = (const float*)(a.ws + WS_CQRAW); const float* CKVRAW = (const float*)(a.ws + WS_CKVRAW);
    bf16_t* CQ = (bf16_t*)(a.ws + WS_CQ); bf16_t* LAT = (bf16_t*)(a.ws + WS_LAT); bf16_t* KROPE = (bf16_t*)(a.ws + WS_KROPE);
    const float* qg = (const float*)a.in[19] + j * QR; const float* kg = (const float*)a.in[16]; const f32x2* rope = (const f32x2*)(a.ws + WS_ROPE);
    for (int row = gw; row < T; row += NGW) {
        { f32x2 v[3]; float s = 0.f;
#pragma unroll
          for (int q = 0; q < 3; ++q) { v[q] = *(const f32x2*)(CQRAW + (size_t)row * QR + 2 * lane + 128 * q); s += v[q].x * v[q].x + v[q].y * v[q].y; }
          const float r = 1.0f / sqrtf(wave_sum(s) * (1.0f / QR) + EPS);
#pragma unroll
          for (int q = 0; q < 3; ++q) { const int c = 2 * lane + 128 * q; const f32x2 gv = *(const f32x2*)(qg + c); *(unsigned*)(CQ + (size_t)row * QR + c) = pk2(v[q].x * r * gv.x, v[q].y * r * gv.y); } }
        if (j == 0) {
            const f32x4 v = *(const f32x4*)(CKVRAW + (size_t)row * 320 + 4 * lane);
            const float s = (v.x * v.x + v.y * v.y) + (v.z * v.z + v.w * v.w);
            const float r = 1.0f / sqrtf(wave_sum(s) * (1.0f / KVR) + EPS);
            const f32x4 gv = *(const f32x4*)(kg + 4 * lane);
            u32x2 o; o.x = pk2(v.x * r * gv.x, v.y * r * gv.y); o.y = pk2(v.z * r * gv.z, v.w * r * gv.w);
            *(u32x2*)(LAT + (size_t)row * KVR + 4 * lane) = o;
            if (lane < 32) { const float x1 = CKVRAW[(size_t)row * 320 + 256 + lane], x2 = CKVRAW[(size_t)row * 320 + 288 + lane]; const f32x2 cs = rope[(size_t)row * 32 + lane];
                KROPE[(size_t)row * 64 + lane] = (bf16_t)f2bf(x1 * cs.x - x2 * cs.y); KROPE[(size_t)row * 64 + 32 + lane] = (bf16_t)f2bf(x1 * cs.y + x2 * cs.x); }
        }
    }
}

namespace att {
typedef float f32x16 __attribute__((ext_vector_type(16)));
typedef short s16x4 __attribute__((ext_vector_type(4)));
constexpr int QB = 256, KVB = 64, KPB = 400  , SHM_V = KVB * 128 * 2, SHM_K = KVB * KPB;
constexpr int K_OFF = 2 * SHM_V, SCR_OFF = K_OFF + 2 * SHM_K;
constexpr float THR = 8.f;
__device__ __forceinline__ int v_st(int k, int c) { const int kk = (k & ~0xC) | ((k & 4) << 1) | ((k & 8) >> 1); return ((kk >> 3) * 4 + (c >> 5)) * 512 + ((kk & 7) * 32 + (c & 31)) * 2; }
__device__ __forceinline__ int v_rd_base(int lane) { return ((lane & 3) << 3) | (((lane >> 2) & 3) << 6) | (((lane >> 4) & 1) << 5) | (((lane >> 5) & 1) << 8); }
constexpr int v_rd_off(int d0, int ks, int half) { return d0 * 512 + ks * 4096 + half * 2048; }
__device__ __forceinline__ int crow(int r, int hi) { return (r & 3) + 8 * (r >> 2) + 4 * hi; }
__device__ __forceinline__ unsigned cvtpk(float lo, float hi) { unsigned r; asm volatile("v_cvt_pk_bf16_f32 %0, %1, %2" : "=v"(r) : "v"(lo), "v"(hi)); return r; }
#define ASBAR() __builtin_amdgcn_sched_barrier(0)
__device__ __forceinline__ void mask_tile(f32x16& p0, f32x16& p1, int dq) {
    const float NEG = -__builtin_inff();
#pragma unroll
    for (int r = 0; r < 16; ++r) { const int c = (r & 3) + 8 * (r >> 2); if (dq - c < 0) p0[r] = NEG; if (dq - c - 32 < 0) p1[r] = NEG; }
}
__device__ __forceinline__ void partialSM(f32x16& p0, f32x16& p1, float& m_reg, float& mn, float& alpha) {
    float pmax = p0[0];
#pragma unroll
    for (int r = 1; r < 16; ++r) pmax = fmaxf(pmax, p0[r]);
#pragma unroll
    for (int r = 0; r < 16; ++r) pmax = fmaxf(pmax, p1[r]);
    { auto rr = __builtin_amdgcn_permlane32_swap(__float_as_uint(pmax), __float_as_uint(pmax), false, false); pmax = fmaxf(__uint_as_float(rr[0]), __uint_as_float(rr[1])); }
    constexpr float C2 = 1.4426950408889634f * ATTN_SCALE;
    if (__builtin_expect(__all((pmax - m_reg) * ATTN_SCALE <= THR), 1)) { mn = m_reg; alpha = 1.f; }
    else { mn = fmaxf(m_reg, pmax); alpha = __builtin_amdgcn_exp2f((m_reg - mn) * C2); m_reg = mn; }
    const float mnL = -mn * C2;
#pragma unroll
    for (int r = 0; r < 16; ++r) p0[r] = fmaf(p0[r], C2, mnL);
#pragma unroll
    for (int r = 0; r < 16; ++r) p1[r] = fmaf(p1[r], C2, mnL);
#pragma unroll
    for (int r = 0; r < 16; ++r) p0[r] = __builtin_amdgcn_exp2f(p0[r]);
}
__device__ __forceinline__ void finishSM(f32x16& p0, f32x16& p1, float alpha, float& l_reg, bf16x8& pa0, bf16x8& pa1, bf16x8& pa2, bf16x8& pa3) {
#pragma unroll
    for (int r = 0; r < 16; ++r) p1[r] = __builtin_amdgcn_exp2f(p1[r]);
    float ps = 0;
#pragma unroll
    for (int r = 0; r < 16; ++r) ps += p0[r];
#pragma unroll
    for (int r = 0; r < 16; ++r) ps += p1[r];
    { auto rr = __builtin_amdgcn_permlane32_swap(__float_as_uint(ps), __float_as_uint(ps), false, false); ps = __uint_as_float(rr[0]) + __uint_as_float(rr[1]); }
    l_reg = l_reg * alpha + ps;
#define PK4(P, B_, OUT) do { unsigned a0 = cvtpk(P[B_+0], P[B_+1]), a1 = cvtpk(P[B_+2], P[B_+3]); unsigned b0 = cvtpk(P[B_+4], P[B_+5]), b1 = cvtpk(P[B_+6], P[B_+7]); \
        auto r0 = __builtin_amdgcn_permlane32_swap(a0, b0, false, false); auto r1 = __builtin_amdgcn_permlane32_swap(a1, b1, false, false); \
        u32x4 w = {r0[0], r1[0], r0[1], r1[1]}; OUT = *reinterpret_cast<bf16x8*>(&w); } while (0)
    PK4(p0, 0, pa0); PK4(p0, 8, pa1); PK4(p1, 0, pa2); PK4(p1, 8, pa3);
#undef PK4
}
template <int KB>
__device__ __forceinline__ void qkt(f32x16& p0, f32x16& p1, const LAS unsigned char* kb, const bf16x8 (&qr)[12]) {
    p0 = f32x16{}; p1 = f32x16{};
#pragma unroll
    for (int d0 = 0; d0 < 12; ++d0) {
        const bf16x8 b0 = *(const LAS bf16x8*)(kb + KB * SHM_K + 32 * d0);
        const bf16x8 b1 = *(const LAS bf16x8*)(kb + KB * SHM_K + 32 * KPB + 32 * d0);
        p0 = __builtin_amdgcn_mfma_f32_32x32x16_bf16(b0, qr[d0], p0, 0, 0, 0);
        p1 = __builtin_amdgcn_mfma_f32_32x32x16_bf16(b1, qr[d0], p1, 0, 0, 0); }
}
template <int VB>
__device__ __forceinline__ void pv_tile(f32x16 (&o)[4], unsigned vb0, bf16x8 pa0, bf16x8 pa1, bf16x8 pa2, bf16x8 pa3) {
#define TRRD(dst, off) asm volatile("ds_read_b64_tr_b16 %0, %1 offset:%2" : "=&v"(dst) : "v"(vb0), "i"(off) : "memory")
#define PV_D0(d0) do { s16x4 l0, l1, l2, l3, h0, h1, h2, h3; constexpr int b_ = VB * SHM_V + v_rd_off(d0, 0, 0); \
        TRRD(l0, b_); TRRD(h0, b_ + 2048); TRRD(l1, b_ + 4096); TRRD(h1, b_ + 6144); TRRD(l2, b_ + 8192); TRRD(h2, b_ + 10240); TRRD(l3, b_ + 12288); TRRD(h3, b_ + 14336); \
        asm volatile("s_waitcnt lgkmcnt(0)" ::: "memory"); ASBAR(); \
        o[d0] = __builtin_amdgcn_mfma_f32_32x32x16_bf16(pa0, (bf16x8){l0[0], l0[1], l0[2], l0[3], h0[0], h0[1], h0[2], h0[3]}, o[d0], 0, 0, 0); \
        o[d0] = __builtin_amdgcn_mfma_f32_32x32x16_bf16(pa1, (bf16x8){l1[0], l1[1], l1[2], l1[3], h1[0], h1[1], h1[2], h1[3]}, o[d0], 0, 0, 0); \
        o[d0] = __builtin_amdgcn_mfma_f32_32x32x16_bf16(pa2, (bf16x8){l2[0], l2[1], l2[2], l2[3], h2[0], h2[1], h2[2], h2[3]}, o[d0], 0, 0, 0); \
        o[d0] = __builtin_amdgcn_mfma_f32_32x32x16_bf16(pa3, (bf16x8){l3[0], l3[1], l3[2], l3[3], h3[0], h3[1], h3[2], h3[3]}, o[d0], 0, 0, 0); } while (0)
    PV_D0(0); PV_D0(1); PV_D0(2); PV_D0(3);
#undef PV_D0
#undef TRRD
}
}

__device__ __forceinline__ void phase_attn(LAS unsigned char* lds, int wv) {
    const Args a = oargs();
    using namespace att;
    const int tid = otid(wv), lane = tid & 63, wid = __builtin_amdgcn_readfirstlane(tid >> 6), r32 = lane & 31, hi = lane >> 5, G = gridDim.x;
    unsigned char* ws = a.ws;
    const bf16_t* Q = (const bf16_t*)(ws + WS_Q); const bf16_t* KV = (const bf16_t*)(ws + WS_KV); const bf16_t* KR = (const bf16_t*)(ws + WS_KROPE);
    bf16_t* AO = (bf16_t*)(ws + WS_AO); const f32x2* rope = (const f32x2*)(ws + WS_ROPE);
    const __amdgpu_buffer_rsrc_t rsKV = __builtin_amdgcn_make_buffer_rsrc((void*)KV, 0, T * 2048 * 2, 0x00020000);
    const __amdgpu_buffer_rsrc_t rsKR = __builtin_amdgcn_make_buffer_rsrc((void*)KR, 0, T * 64 * 2, 0x00020000);
    LAS unsigned char* K_lds = lds + K_OFF;
    LAS float* wsc = (LAS float*)(lds + SCR_OFF) + wid * 64; LAS float* li_l = wsc; LAS float* al_l = wsc + 32;
    const int sr = tid >> 4, sc = (tid & 15) * 8, kr = tid >> 3, kc = tid & 7;
    const int vst0 = v_st(sr, sc), vst1 = v_st(32 + sr, sc), kw0 = sr * KPB + sc * 2, kw1 = (32 + sr) * KPB + sc * 2, kw2 = kr * KPB + 256 + kc * 16;
    const unsigned vb0 = (unsigned)(size_t)lds + (unsigned)v_rd_base(lane);
    const LAS unsigned char* kbp = K_lds + r32 * KPB + hi * 16;
    constexpr int NQB = SEQ / QB, NPAIR = NQB / 2, NITEM = NB * NH * NPAIR;
    for (int it0 = blockIdx.x; it0 < NITEM; it0 += G) {
        int item = it0; if ((G & 7) == 0 && NITEM % G == 0) { const int base = (it0 / G) * G, c = it0 - base; item = base + (c & 7) * (G >> 3) + (c >> 3); }
        const int bh = item / NPAIR, pr = item % NPAIR, b = bh / NH, h = bh % NH;
        const size_t tb0 = (size_t)b * SEQ;
        for (int pass = 0; pass < 2; ++pass) {
            const int qb = pass == 0 ? (NQB - 1 - pr) : pr;
            const int P0 = qb * QB, NT = 4 * (qb + 1), qlo = P0 + wid * 32, qm = qlo + r32 - 4 * hi;
            bf16x8 qr[12];
            { const size_t row = tb0 + P0 + wid * 32 + r32; const bf16_t* qp = Q + row * 1536 + h * DQK + 8 * hi;
#pragma unroll
              for (int d0 = 0; d0 < 12; ++d0) qr[d0] = *(const bf16x8*)(qp + 16 * d0);
#pragma unroll
              for (int dd = 0; dd < 2; ++dd)
#pragma unroll
                  for (int j = 0; j < 8; ++j) { const f32x2 cs = rope[row * 32 + 16 * dd + 8 * hi + j];
                      const float x1 = bf2f((unsigned short)qr[8 + dd][j]), x2 = bf2f((unsigned short)qr[10 + dd][j]);
                      qr[8 + dd][j] = (short)f2bf(x1 * cs.x - x2 * cs.y); qr[10 + dd][j] = (short)f2bf(x1 * cs.y + x2 * cs.x); } }
            float m_reg = -1e30f, l_reg = 0.f; f32x16 o[4] = {};
            u32x4 st_v0, st_v1, st_k0, st_k1, st_k2;
            const unsigned voKV = (unsigned)(sr * 2048 + h * 256 + sc) * 2u, voKR = (unsigned)(kr * 64 + kc * 8) * 2u;
#define ALOAD(kb_) do { const unsigned t0_ = (unsigned)tb0 + (unsigned)(kb_); \
                st_v0 = __builtin_amdgcn_raw_buffer_load_b128(rsKV, voKV + 256u, t0_ * 4096u, 0); st_v1 = __builtin_amdgcn_raw_buffer_load_b128(rsKV, voKV + 256u, (t0_ + 32u) * 4096u, 0); \
                st_k0 = __builtin_amdgcn_raw_buffer_load_b128(rsKV, voKV, t0_ * 4096u, 0); st_k1 = __builtin_amdgcn_raw_buffer_load_b128(rsKV, voKV, (t0_ + 32u) * 4096u, 0); \
                st_k2 = __builtin_amdgcn_raw_buffer_load_b128(rsKR, voKR, t0_ * 128u, 0); } while (0)
#define AWRITE(bf) do { *(LAS u32x4*)(lds + (bf) * SHM_V + vst0) = st_v0; *(LAS u32x4*)(lds + (bf) * SHM_V + vst1) = st_v1; \
                *(LAS u32x4*)(K_lds + (bf) * SHM_K + kw0) = st_k0; *(LAS u32x4*)(K_lds + (bf) * SHM_K + kw1) = st_k1; *(LAS u32x4*)(K_lds + (bf) * SHM_K + kw2) = st_k2; } while (0)
#define RESC(a_) do { if (__any((a_) < 1.f)) { if (hi == 0) al_l[r32] = (a_); asm volatile("s_waitcnt lgkmcnt(0)" ::: "memory"); \
                _Pragma("unroll") for (int d_ = 0; d_ < 4; ++d_) _Pragma("unroll") for (int r = 0; r < 16; ++r) o[d_][r] *= al_l[crow(r, hi)]; } } while (0)
#define ASTEP(t, BF) do { f32x16 p0, p1; float mn, al; bf16x8 pa0, pa1, pa2, pa3; const int kb_ = (t) * KVB; \
                if ((t) + 1 < NT) ALOAD(kb_ + KVB); \
                ASBAR(); qkt<BF>(p0, p1, kbp, qr); \
                if (kb_ + KVB - 1 > qlo) mask_tile(p0, p1, qm - kb_); \
                partialSM(p0, p1, m_reg, mn, al); RESC(al); finishSM(p0, p1, al, l_reg, pa0, pa1, pa2, pa3); ASBAR(); \
                pv_tile<BF>(o, vb0, pa0, pa1, pa2, pa3); \
                if ((t) + 1 < NT) { asm volatile("s_waitcnt vmcnt(0)" ::: "memory"); AWRITE((BF) ^ 1); } \
                __syncthreads(); } while (0)
            __syncthreads();
            ALOAD(0); asm volatile("s_waitcnt vmcnt(0)" ::: "memory"); AWRITE(0);
            __syncthreads();
            for (int t = 0; t < NT; t += 2) { ASTEP(t, 0); ASTEP(t + 1, 1); }
            if (hi == 0) li_l[r32] = l_reg;
            asm volatile("s_waitcnt lgkmcnt(0)" ::: "memory");
            bf16_t* Ow = AO + (tb0 + P0 + wid * 32) * D + h * 128;
#pragma unroll
            for (int r = 0; r < 16; ++r) { const int orow = crow(r, hi); const float rl = __builtin_amdgcn_rcpf(li_l[orow]);
#pragma unroll
                for (int d0 = 0; d0 < 4; ++d0) { const float v = o[d0][r] * rl; const float vn = __shfl_xor(v, 1);
                    if ((r32 & 1) == 0) *(unsigned*)(Ow + (size_t)orow * D + d0 * 32 + r32) = cvtpk(v, vn); } }
#undef ALOAD
#undef AWRITE
#undef RESC
#undef ASTEP
        }
    }
    __syncthreads();
}

__device__ __forceinline__ void phase_c1(LAS unsigned char* lds, int wv, int l) {
    const Args a = oargs(); unsigned char* ws = a.ws;
    const pg8::Gemm g{(const bf16_t*)(ws + WS_HA), (const bf16_t*)(ws + WS_WIN) + (size_t)l * 2048 * 1024, T, 2048, D};
    pg8::StaticOrder S; S.init(T, 2048, (int)gridDim.x, (int)blockIdx.x);
    pg8::gemm_phase<pg8::EpiGated<0>, pg8::StaticOrder, true, true, false>(lds, wv, g, S, pg8::EpiGated<0>{(bf16_t*)(ws + WS_U), D, 0xffff, (const float*)a.in[8] + l * 2048});
}
__device__ __forceinline__ void phase_resid(LAS unsigned char* lds, int wv, int l, size_t a_off, size_t w_off) {
    const Args a = oargs(); unsigned char* ws = a.ws;
    const pg8::Gemm g{(const bf16_t*)(ws + a_off), (const bf16_t*)(ws + w_off), T, D, D};
    pg8::StaticOrder S; S.init(T, D, (int)gridDim.x, (int)blockIdx.x);
    pg8::gemm_phase<pg8::EpiResid, pg8::StaticOrder, true, true, false>(lds, wv, g, S, pg8::EpiResid{a.out, (const float*)(ws + WS_MOD) + (size_t)l * 4 * 6144 + 2048});
}
__device__ __forceinline__ void phase_a1(LAS unsigned char* lds, int wv, int j) {
    const Args a = oargs(); unsigned char* ws = a.ws;
    { const pg8::Gemm g{(const bf16_t*)(ws + WS_HA), (const bf16_t*)(ws + WS_WDQ) + (size_t)j * 512 * D, T, 512, D};
      pg8::StaticOrder S; S.init(T, 512, (int)gridDim.x, (int)blockIdx.x);
      pg8::gemm_phase<pg8::EpiF32, pg8::StaticOrder, true, true, false>(lds, wv, g, S, pg8::EpiF32{(float*)(ws + WS_CQRAW), QR, QR}); }
    if (j == 0) { const pg8::Gemm g{(const bf16_t*)(ws + WS_XKV), (const bf16_t*)(ws + WS_WDKV), T, 512, D};
      pg8::StaticOrder S; S.init(T, 512, (int)gridDim.x, (int)((blockIdx.x + gridDim.x / 2) % gridDim.x));
      pg8::gemm_phase<pg8::EpiF32, pg8::StaticOrder, true, true, false>(lds, wv, g, S, pg8::EpiF32{(float*)(ws + WS_CKVRAW), 320, 320}); }
}
__device__ __forceinline__ void phase_a2(LAS unsigned char* lds, int wv, int j) {
    const Args a = oargs(); unsigned char* ws = a.ws;
    { const pg8::Gemm g{(const bf16_t*)(ws + WS_CQ), (const bf16_t*)(ws + WS_WUQ) + (size_t)j * 1536 * QR, T, 1536, QR};
      pg8::StaticOrder S; S.init(T, 1536, (int)gridDim.x, (int)blockIdx.x);
      pg8::gemm_phase<pg8::EpiBf16, pg8::StaticOrder, true, true, false>(lds, wv, g, S, pg8::EpiBf16{(bf16_t*)(ws + WS_Q), 1536, 0xffff}); }
    if (j == 0) { const pg8::Gemm g{(const bf16_t*)(ws + WS_LAT), (const bf16_t*)(ws + WS_WUKV), T, 2048, KVR};
      pg8::StaticOrder S; S.init(T, 2048, (int)gridDim.x, (int)((blockIdx.x + gridDim.x / 2) % gridDim.x));
      pg8::gemm_phase<pg8::EpiBf16, pg8::StaticOrder, true, true, false>(lds, wv, g, S, pg8::EpiBf16{(bf16_t*)(ws + WS_KV), 2048, 0xffff}); }
}

constexpr int PH_PER_LAYER = 9, NPHASE = 2 + DEPTH * PH_PER_LAYER;
__global__ void __launch_bounds__(NTHREADS, 2) fwd(Args a) {
    extern __shared__ __attribute__((aligned(16))) unsigned char lds_raw[];
    LAS unsigned char* lds = (LAS unsigned char*)lds_raw;
    const int lo = a.ph_lo, hi = a.ph_hi;
    volatile LAS unsigned* misc = (volatile LAS unsigned*)(lds + LDS_MISC);
    const int wv = __builtin_amdgcn_readfirstlane((int)(threadIdx.x >> 6));
    if (threadIdx.x < 32) misc[threadIdx.x] = 0u;
    __syncthreads();
    if (hi - lo > 1) (void)xcd_barrier_post((unsigned*)(a.ws + WS_CTL) + CW_BAR, misc + 8);
#define IN(k) (lo <= (k) && (k) < hi)
#define SEAM(k) do { if ((k) + 1 < hi) { XcdBarrier bb_; bb_.bar = (unsigned*)(oargs().ws + WS_CTL) + CW_BAR; bb_.x = xb_xcc_id(); bb_.st = misc + 8; xcd_barrier(bb_, otid(wv) == 0); } } while (0)

    if (IN(0)) { phase_prologue(lds, wv); SEAM(0); }
    if (IN(1)) { phase_mod0(wv); SEAM(1); }
#pragma unroll 1
    for (int l = 0; l < DEPTH; ++l) {
        const int pb = 2 + PH_PER_LAYER * l;
        if (l < 2) {
            if (IN(pb + 0)) { phase_c1(lds, wv, l); SEAM(pb + 0); }
            if (IN(pb + 1)) { phase_conv(lds, wv, l); SEAM(pb + 1); }
            if (IN(pb + 2)) { phase_resid(lds, wv, l, WS_V2, WS_WOUT + (size_t)l * D * D * 2); SEAM(pb + 2); }
        } else {
            const int j = l - 2;
            if (IN(pb + 0)) { phase_a1(lds, wv, j); SEAM(pb + 0); }
            if (IN(pb + 1)) { phase_mla_norm(wv, j); SEAM(pb + 1); }
            if (IN(pb + 2)) { phase_a2(lds, wv, j); SEAM(pb + 2); }
            if (IN(pb + 3)) { phase_attn(lds, wv); SEAM(pb + 3); }
            if (IN(pb + 4)) { phase_resid(lds, wv, l, WS_AO, WS_WO + (size_t)j * D * D * 2); SEAM(pb + 4); }
        }
        if (IN(pb + 5)) { phase_route(lds, wv, l); SEAM(pb + 5); }
        if (IN(pb + 6)) { phase_moe_up(lds, wv, l); SEAM(pb + 6); }
        if (IN(pb + 7)) { phase_moe_down(lds, wv, l); SEAM(pb + 7); }
        if (IN(pb + 8)) { phase_combine(lds, wv, l); SEAM(pb + 8); }
    }
#undef IN
#undef SEAM
}

extern "C" void kernel_launch(void* const* d_in, const int* in_sizes, int n_in, void* d_out, int out_size, void* d_ws, size_t ws_size, hipStream_t stream) {
    static int grid = 0;
    if (grid == 0) {
        if (n_in != 28 || out_size != T * D || ws_size < WS_END) { fprintf(stderr, "kernel_launch: unexpected shapes (n_in %d out %d ws %zu)\n", n_in, out_size, ws_size); grid = -1; return; }
        int dev = 0, cus = 0, per_cu = 0;
        if (hipGetDevice(&dev) != hipSuccess || hipDeviceGetAttribute(&cus, hipDeviceAttributeMultiprocessorCount, dev) != hipSuccess) { grid = -1; return; }
        if (hipFuncSetAttribute((const void*)fwd, hipFuncAttributeMaxDynamicSharedMemorySize, LDS_BYTES) != hipSuccess) { fprintf(stderr, "kernel_launch: hipFuncSetAttribute failed\n"); grid = -1; return; }
        if (hipOccupancyMaxActiveBlocksPerMultiprocessor(&per_cu, (const void*)fwd, NTHREADS, LDS_BYTES) != hipSuccess || per_cu < 1) fprintf(stderr, "kernel_launch: occupancy query reports %d\n", per_cu);
        (void)hipGetLastError();
        grid = cus;
    }
    if (grid < 0) return;
    (void)hipMemsetAsync((char*)d_ws + WS_CTL, 0, CTL_BYTES, stream);
    Args a{};
    for (int i = 0; i < 28; ++i) a.in[i] = d_in[i];
    a.out = (float*)d_out; a.ws = (unsigned char*)d_ws;
#if MK_ONE_LAUNCH
    a.ph_lo = 0; a.ph_hi = NPHASE;
    hipLaunchKernelGGL(fwd, dim3(grid), dim3(NTHREADS), LDS_BYTES, stream, a);
#else
    for (int ph = 0; ph < NPHASE; ++ph) {
        if (ph >= 2) { const int l = (ph - 2) / PH_PER_LAYER, k = (ph - 2) % PH_PER_LAYER; if (l < 2 && (k == 3 || k == 4)) continue; }
        a.ph_lo = ph; a.ph_hi = ph + 1;
        hipLaunchKernelGGL(fwd, dim3(grid), dim3(NTHREADS), LDS_BYTES, stream, a);
    }
#endif
}
```

```cpp
#include <hip/hip_runtime.h>
#include <cstdio>
#include <cstdint>

#define LAS __attribute__((address_space(3)))
typedef unsigned short bf16_t;
typedef short bf16x8 __attribute__((ext_vector_type(8)));
typedef float f32x4 __attribute__((ext_vector_type(4)));
typedef float f32x2 __attribute__((ext_vector_type(2)));
typedef unsigned u32x4 __attribute__((ext_vector_type(4)));
typedef unsigned u32x2 __attribute__((ext_vector_type(2)));

#ifndef MK_ONE_LAUNCH
#define MK_ONE_LAUNCH 1
#endif

constexpr int NB = 4, SEQ = 4096, T = NB * SEQ, D = 1024, DEPTH = 4;
constexpr int CWID = 31, NH = 8, DQK = 192, QR = 384, KVR = 256;
constexpr int NE = 16, DE = 512;
constexpr float EPS = 1e-6f;
constexpr float ATTN_SCALE = 0.07216878364870322f;

constexpr size_t MiB = 1u << 20;
constexpr size_t WS_CTL = 0, CTL_BYTES = 1 * MiB;
constexpr size_t WS_MOD = 1 * MiB;
constexpr size_t WS_ROPE = 2 * MiB;
constexpr size_t WS_TOKINFO = 6 * MiB;
constexpr size_t WS_LIST = 7 * MiB;
constexpr size_t WS_WIN = 8 * MiB;
constexpr size_t WS_WOUT = 16 * MiB;
constexpr size_t WS_WDKV = 20 * MiB;
constexpr size_t WS_WUKV = 21 * MiB;
constexpr size_t WS_WDQ = 22 * MiB;
constexpr size_t WS_WUQ = 24 * MiB;
constexpr size_t WS_WO = 27 * MiB;
constexpr size_t WS_WGU = 32 * MiB;
constexpr size_t WS_WDN = 160 * MiB;
constexpr size_t WS_HA = 224 * MiB;
constexpr size_t WS_XKV = 256 * MiB;
constexpr size_t WS_U = 288 * MiB;
constexpr size_t WS_H2 = WS_U;
constexpr size_t WS_V2 = 320 * MiB;
constexpr size_t WS_AO = WS_V2;
constexpr size_t WS_YB = 352 * MiB;
constexpr size_t WS_CQRAW = 352 * MiB;
constexpr size_t WS_CKVRAW = 376 * MiB;
constexpr size_t WS_CQ = 396 * MiB;
constexpr size_t WS_LAT = 408 * MiB;
constexpr size_t WS_KROPE = 424 * MiB;
constexpr size_t WS_Q = 426 * MiB;
constexpr size_t WS_ACT = WS_Q;
constexpr size_t WS_KV = 474 * MiB;
constexpr size_t WS_END = 538 * MiB;
constexpr int NSLOT_MAX = 2 * T + NE * 256;

constexpr int CW_BAR = 4096;
constexpr int CW_CNT = 16384;

constexpr int LDS_BYTES = 147456;
constexpr int LDS_EXTRA = 131072;
constexpr int LDS_MISC = LDS_EXTRA + 320;
constexpr int LDS_TB = LDS_EXTRA + 512;
constexpr int LDS_TOK = LDS_EXTRA + 1024;
constexpr int NTHREADS = 512;

#define XB_TMO      128
#define XB_XCNT(j)  (256  + 64 * (j))
#define XB_XSUB(j)  (1280 + 64 * (j))
#define XB_XGEN(j)  (2304 + 64 * (j))
#define XB_TOP      3328
#define XB_TOPGEN   3392
#define XCD_BAR_WORDS 3456
#define XB_SPIN_CAP (1u << 18)

__device__ __forceinline__ unsigned xb_ld(unsigned* p)              { return __hip_atomic_load(p, __ATOMIC_RELAXED, __HIP_MEMORY_SCOPE_AGENT); }
__device__ __forceinline__ unsigned xb_add(unsigned* p, unsigned v) { return __hip_atomic_fetch_add(p, v, __ATOMIC_RELAXED, __HIP_MEMORY_SCOPE_AGENT); }
__device__ __forceinline__ unsigned xb_xcc_id() { return (unsigned)__builtin_amdgcn_s_getreg((3 << 11) | 20) & 0xFu; }
#define XB_SPIN(cond, bar) do { unsigned _sp = 0; while (cond) { __builtin_amdgcn_s_sleep(1); \
    if ((++_sp & 255u) == 0u) { if (xb_ld(&(bar)[XB_TMO])) break; if (_sp > XB_SPIN_CAP) { atomicAdd(&(bar)[XB_TMO], 1u); break; } } } } while (0)

struct XcdBarrier { unsigned* bar; unsigned x; volatile LAS unsigned* st; };

__device__ __forceinline__ XcdBarrier xcd_barrier_post(unsigned* bar, volatile LAS unsigned* st) {
    XcdBarrier b; b.bar = bar; b.x = xb_xcc_id(); b.st = st;
    if (threadIdx.x == 0) (void)xb_add(&bar[XB_XCNT(b.x)], 1u);
    return b;
}
__device__ __forceinline__ void xcd_barrier_complete(unsigned* bar, unsigned x, unsigned& nloc, unsigned& nx) {
    const unsigned G = gridDim.x * gridDim.y * gridDim.z;
    unsigned sum, cnt, mine, sp = 0u;
    for (;;) {
        sum = 0u; cnt = 0u; mine = 0u;
#pragma unroll
        for (unsigned j = 0; j < 16; ++j) { const unsigned c = xb_ld(&bar[XB_XCNT(j)]); sum += c; cnt += (c > 0u) ? 1u : 0u; mine = (j == x) ? c : mine; }
        if (sum == G) break;
        __builtin_amdgcn_s_sleep(1);
        if ((++sp & 255u) == 0u) { if (xb_ld(&bar[XB_TMO])) break; if (sp > XB_SPIN_CAP) { atomicAdd(&bar[XB_TMO], 1u); break; } }
    }
    nloc = mine > 0u ? mine : 1u; nx = cnt > 0u ? cnt : 1u;
}
__device__ __forceinline__ void xcd_barrier(const XcdBarrier& b, bool leader) {
    asm volatile("s_waitcnt vmcnt(0)" ::: "memory");
    __syncthreads();
    if (leader) {
        unsigned* bar = b.bar;
        __builtin_amdgcn_s_waitcnt(0);
        unsigned nloc = b.st[0], nx = b.st[1];
        if (nloc == 0u) { xcd_barrier_complete(bar, b.x, nloc, nx); b.st[0] = nloc; b.st[1] = nx; }
        const unsigned old = xb_add(&bar[XB_XSUB(b.x)], 1u);
        const unsigned gen = old / nloc;
        if (old + 1u == (gen + 1u) * nloc) {
            __builtin_amdgcn_fence(__ATOMIC_RELEASE, "agent");
            asm volatile("s_waitcnt vmcnt(0)" ::: "memory");
            const unsigned og = xb_add(&bar[XB_TOP], 1u);
            const unsigned tg = og / nx;
            if (og + 1u == (tg + 1u) * nx) xb_add(&bar[XB_TOPGEN], 1u);
            else XB_SPIN(xb_ld(&bar[XB_TOPGEN]) == tg, bar);
            __builtin_amdgcn_fence(__ATOMIC_ACQUIRE, "agent");
            xb_add(&bar[XB_XGEN(b.x)], 1u);
            asm volatile("s_waitcnt vmcnt(0)" ::: "memory");
        } else {
            XB_SPIN(xb_ld(&bar[XB_XGEN(b.x)]) == gen, bar);
            __builtin_amdgcn_fence(__ATOMIC_ACQUIRE, "agent");
            asm volatile("s_waitcnt vmcnt(0)" ::: "memory");
        }
    }
    __syncthreads();
}

__device__ __forceinline__ unsigned f2bf(float f) { unsigned u = __builtin_bit_cast(unsigned, f); return (u + 0x7fffu + ((u >> 16) & 1u)) >> 16; }
__device__ __forceinline__ unsigned pk2(float lo, float hi) { return f2bf(lo) | (f2bf(hi) << 16); }
__device__ __forceinline__ float bf2f(unsigned short b) { return __builtin_bit_cast(float, (unsigned)b << 16); }
__device__ __forceinline__ float bflo(unsigned w) { return __builtin_bit_cast(float, w << 16); }
__device__ __forceinline__ float bfhi(unsigned w) { return __builtin_bit_cast(float, w & 0xffff0000u); }
__device__ __forceinline__ void swap32(float v, float& a, float& b) { unsigned x = __builtin_bit_cast(unsigned, v), y = x; asm volatile("" : "+v"(y));
    auto rr = __builtin_amdgcn_permlane32_swap(x, y, false, false); unsigned a_ = rr[0], b_ = rr[1]; asm volatile("" : "+v"(a_), "+v"(b_)); a = __builtin_bit_cast(float, a_); b = __builtin_bit_cast(float, b_); }
__device__ __forceinline__ void swap16(float v, float& a, float& b) { unsigned x = __builtin_bit_cast(unsigned, v), y = x; asm volatile("" : "+v"(y));
    auto rr = __builtin_amdgcn_permlane16_swap(x, y, false, false); unsigned a_ = rr[0], b_ = rr[1]; asm volatile("" : "+v"(a_), "+v"(b_)); a = __builtin_bit_cast(float, a_); b = __builtin_bit_cast(float, b_); }
__device__ __forceinline__ float dpp_add(float v, int ctrl_sel) {
    int r;
    if (ctrl_sel == 0) r = __builtin_amdgcn_update_dpp(0, __builtin_bit_cast(int, v), 0xB1, 0xf, 0xf, true);
    else if (ctrl_sel == 1) r = __builtin_amdgcn_update_dpp(0, __builtin_bit_cast(int, v), 0x4E, 0xf, 0xf, true);
    else if (ctrl_sel == 2) r = __builtin_amdgcn_update_dpp(0, __builtin_bit_cast(int, v), 0x141, 0xf, 0xf, true);
    else r = __builtin_amdgcn_update_dpp(0, __builtin_bit_cast(int, v), 0x140, 0xf, 0xf, true);
    return v + __builtin_bit_cast(float, r);
}
__device__ __forceinline__ float wave_sum(float v) {
    v = dpp_add(v, 0); v = dpp_add(v, 1); v = dpp_add(v, 2); v = dpp_add(v, 3);
    float a, b; swap16(v, a, b); v = a + b; swap32(v, a, b); v = a + b;
    return v;
}
__device__ __forceinline__ float sigmoidf_(float x) { return 1.0f / (1.0f + __expf(-x)); }
__device__ __forceinline__ float siluf_(float x) { return x / (1.0f + __expf(-x)); }

struct Args { const void* in[28]; float* out; unsigned char* ws; int ph_lo, ph_hi; };
__device__ __forceinline__ int otid(int wv) { int t; asm volatile("v_mbcnt_lo_u32_b32 %0, -1, 0\n\tv_mbcnt_hi_u32_b32 %0, -1, %0" : "=v"(t)); return (wv << 6) + t; }
#define CAS __attribute__((address_space(4)))
__device__ __forceinline__ Args oargs() {
    const CAS Args* q = (const CAS Args*)__builtin_amdgcn_kernarg_segment_ptr(); asm volatile("" : "+s"(q));
    Args r;
#pragma unroll
    for (int i = 0; i < 28; ++i) r.in[i] = q->in[i];
    r.out = q->out; r.ws = q->ws; r.ph_lo = q->ph_lo; r.ph_hi = q->ph_hi; return r;
}
template <class P> __device__ __forceinline__ P* opq(P* p) { asm volatile("" : "+s"(p)); return p; }

namespace pg8 {
#define PG8_LAS __attribute__((address_space(3)))
constexpr int BM = 256, BK = 64, HALF = 128, HTB = HALF * BK * 2, STAGE_BYTES = 8 * HTB, NXCD = 8, WGM = 8;
__host__ __device__ __forceinline__ int lds_byte(int r, int c) { const int st = (r >> 4) * 2 + (c >> 5), rr = r & 15, cc = c & 31, ob = rr * 64 + cc * 2; return st * 1024 + (ob ^ (((ob >> 9) & 1) << 5)); }
__host__ __device__ __forceinline__ void stage_rc(int b, int& R, int& C) { const int st = b / 1024, sb = b % 1024, swz = sb ^ (((sb >> 9) & 1) << 5); R = (st >> 1) * 16 + swz / 64; C = (st & 1) * 32 + (swz % 64) / 2; }
__host__ __device__ __forceinline__ int perm32(int rho) { const int n = rho >> 4, i = rho & 15; return 8 * (i >> 2) + 4 * n + (i & 3); }
struct Unit { int pm, pn; };
struct Gemm { const bf16_t* A; const bf16_t* Bt; int M, N, K; };
struct StaticOrder {
    int nM, nN, nwg, G, c;
    __host__ __device__ void init(int M, int N, int G_, int c_) { nM = M / BM; nN = N / BM; nwg = nM * nN; G = G_; c = c_; }
    __host__ __device__ bool next(int i, Unit& u) const {
        const long L = (long)i * G + c; if (L >= nwg) return false;
        int wgid = (int)L; { const int q = nwg / NXCD, r = nwg % NXCD, xcd = wgid % NXCD, off = wgid / NXCD; wgid = (xcd < r ? xcd * (q + 1) : r * (q + 1) + (xcd - r) * q) + off; }
        const int nig = WGM * nN, gid = wgid / nig, fm = gid * WGM, gsz = (nM - fm) < WGM ? (nM - fm) : WGM;
        u.pm = fm + ((wgid % nig) % gsz); u.pn = (wgid % nig) / gsz; return true;
    }
    __device__ __forceinline__ const PG8_LAS int* tok(int) const { return nullptr; }
};
struct MoeOrder {
    const PG8_LAS int* tb; const PG8_LAS int* toks; int G, c;
    __device__ __forceinline__ bool next(int i, Unit& u) const {
        const int x = c & 7, idx = c >> 3, rt = i * (G >> 2) + (idx >> 2) * 8 + x;
        if (rt >= tb[16]) return false;
        int e = 0;
#pragma unroll
        for (int q = 1; q < 16; ++q) e += (rt >= tb[q]) ? 1 : 0;
        u.pm = rt; u.pn = e * 4 + (idx & 3); return true;
    }
    __device__ __forceinline__ const PG8_LAS int* tok(int ui) const { return toks + ui * 256; }
};

template <class Epi, class Sched, bool ALIGN_EPI = false, bool SP2 = false, bool GATHER = false>
__device__ __forceinline__ void gemm_phase(PG8_LAS unsigned char* lds, int wv, const Gemm g, const Sched& S, const Epi& E) {
    const int tid = otid(wv), wid = __builtin_amdgcn_readfirstlane(tid >> 6), lane = tid & 63, wr = wid >> 2, wc = wid & 3, fr = lane & 15, fq = lane >> 4;
    const int K = g.K, nt = K / BK;
    unsigned voffA[2], voffB[2];
#pragma unroll
    for (int i = 0; i < 2; ++i) { int R, C; stage_rc(tid * 16 + i * 8192, R, C); const int Rb = Epi::PERM ? ((R & ~31) + perm32(R & 31)) : R;
        voffA[i] = (unsigned)(R * K + C) * 2u; voffB[i] = (unsigned)(Rb * K + C) * 2u; }
    const size_t kstep = (size_t)(BK * 2);
    const size_t hstep = (size_t)HALF * K * 2;
    const size_t tstep = 2 * hstep;
    const unsigned ldsw = (unsigned)wid * 1024u;
    const int aoff = lds_byte(wr * 64 + fr, fq * 8), boff = lds_byte(wc * 32 + fr, fq * 8);
#define PG8_SA(b, h) (((b) * 2 + (h)) * HTB)
#define PG8_SB(b, h) ((4 + (b) * 2 + (h)) * HTB)
#define PG8_STAGE(bufoff, gbase, voff) do { _Pragma("unroll") for (int _i = 0; _i < 2; ++_i) \
        __builtin_amdgcn_global_load_lds((const unsigned*)((const char*)(gbase) + (voff)[_i]), (PG8_LAS unsigned*)(lds + (bufoff) + ldsw + _i * 8192), 16, 0, 0); } while (0)
#define PG8_STAGE_A(bufoff, gbase, hh, VO) do { if constexpr (GATHER) { PG8_STAGE(bufoff, gbase, VO[hh]); } else { PG8_STAGE(bufoff, (gbase) + (hh) * hstep, voffA); } } while (0)
#define PG8_LDA(dst, b, h) do { _Pragma("unroll") for (int m = 0; m < 4; ++m) _Pragma("unroll") for (int k = 0; k < 2; ++k) dst[m][k] = *(const PG8_LAS bf16x8*)(lds + PG8_SA(b, h) + aoff + m * 2048 + k * 1024); } while (0)
#define PG8_LDB(dst, b, h) do { _Pragma("unroll") for (int n = 0; n < 2; ++n) _Pragma("unroll") for (int k = 0; k < 2; ++k) dst[n][k] = *(const PG8_LAS bf16x8*)(lds + PG8_SB(b, h) + boff + n * 2048 + k * 1024); } while (0)
#define PG8_MMA(ai, bj, At, Bt) do { __builtin_amdgcn_s_setprio(1); _Pragma("unroll") for (int m = 0; m < 4; ++m) _Pragma("unroll") for (int n = 0; n < 2; ++n) _Pragma("unroll") for (int k = 0; k < 2; ++k) \
        acc[ai][bj][m][n] = __builtin_amdgcn_mfma_f32_16x16x32_bf16(Bt[n][k], At[m][k], acc[ai][bj][m][n], 0, 0, 0); __builtin_amdgcn_s_setprio(0); } while (0)
#define PG8_WAIT_V(n) asm volatile("s_waitcnt vmcnt(" #n ")" ::: "memory")
#define PG8_WAIT_L(n) asm volatile("s_waitcnt lgkmcnt(" #n ")" ::: "memory")
#define PG8_BAR __builtin_amdgcn_s_barrier()
#define PG8_SCHED __builtin_amdgcn_sched_barrier(0)
#define PG8_GOFF(dst, tk) do { _Pragma("unroll") for (int _i = 0; _i < 2; ++_i) { int _R, _C; stage_rc(tid * 16 + _i * 8192, _R, _C); _Pragma("unroll") for (int _h = 0; _h < 2; ++_h) dst[_h][_i] = (unsigned)((tk)[_h * 128 + _R] * K + _C) * 2u; } } while (0)
    Unit cur, nxt; int ui = 0;
    if (!S.next(0, cur)) return;
    f32x4 acc[2][2][4][2];
#pragma unroll
    for (int a = 0; a < 2; ++a)
#pragma unroll
        for (int b = 0; b < 2; ++b)
#pragma unroll
            for (int m = 0; m < 4; ++m)
#pragma unroll
                for (int n = 0; n < 2; ++n) acc[a][b][m][n] = (f32x4){0.f, 0.f, 0.f, 0.f};
    bf16x8 At[4][2], B0[2][2], B1[2][2];
    unsigned gA[2][2] = {{0u, 0u}, {0u, 0u}}, gAn[2][2] = {{0u, 0u}, {0u, 0u}}, gS[2][2] = {{0u, 0u}, {0u, 0u}};
    if constexpr (GATHER) { PG8_GOFF(gA, S.tok(0)); }
    const char* cA = GATHER ? (const char*)g.A : (const char*)g.A + (size_t)cur.pm * tstep; const char* cB = (const char*)g.Bt + (size_t)cur.pn * tstep;
    if constexpr (SP2) {
        PG8_STAGE(PG8_SB(0, 0), cB, voffB); PG8_STAGE(PG8_SB(0, 1), cB + hstep, voffB); PG8_STAGE_A(PG8_SA(0, 0), cA, 0, gA); PG8_STAGE_A(PG8_SA(0, 1), cA, 1, gA);
        if (wr == 1) PG8_BAR;
        PG8_WAIT_V(2); PG8_BAR;
        PG8_STAGE(PG8_SB(1, 0), cB + kstep, voffB); PG8_STAGE_A(PG8_SA(1, 0), cA + kstep, 0, gA); PG8_STAGE(PG8_SB(1, 1), cB + hstep + kstep, voffB);
        PG8_WAIT_V(6); PG8_BAR;
    } else {
        PG8_STAGE(PG8_SB(0, 0), cB, voffB); PG8_STAGE_A(PG8_SA(0, 0), cA, 0, gA); PG8_STAGE(PG8_SB(0, 1), cB + hstep, voffB); PG8_STAGE_A(PG8_SA(0, 1), cA, 1, gA);
        if (wr == 1) PG8_BAR;
        PG8_WAIT_V(4); PG8_BAR;
        PG8_STAGE(PG8_SB(1, 0), cB + kstep, voffB); PG8_STAGE_A(PG8_SA(1, 0), cA + kstep, 0, gA); PG8_STAGE(PG8_SB(1, 1), cB + hstep + kstep, voffB);
        PG8_WAIT_V(6); PG8_BAR;
    }
    for (;;) {
        const bool has_next = S.next(ui + 1, nxt);
        const char* nA = GATHER ? (const char*)g.A : (has_next ? (const char*)g.A + (size_t)nxt.pm * tstep : cA); const char* nB = has_next ? (const char*)g.Bt + (size_t)nxt.pn * tstep : cB;
        if constexpr (GATHER) { if (has_next) { PG8_GOFF(gAn, S.tok(ui + 1)); } else {
#pragma unroll
            for (int _h = 0; _h < 2; ++_h)
#pragma unroll
                for (int _i = 0; _i < 2; ++_i) gAn[_h][_i] = gA[_h][_i]; } }
        for (int t = 0; t < nt; t += 2) {
            const bool last = (t == nt - 2);
            const char* a1 = cA + (size_t)(t + 1) * kstep;
            const char* a2 = last ? nA : cA + (size_t)(t + 2) * kstep; const char* b2 = last ? nB : cB + (size_t)(t + 2) * kstep;
            const char* a3 = a2 + kstep; const char* b3 = b2 + kstep;
            if constexpr (GATHER) {
#pragma unroll
                for (int _h = 0; _h < 2; ++_h)
#pragma unroll
                    for (int _i = 0; _i < 2; ++_i) gS[_h][_i] = last ? gAn[_h][_i] : gA[_h][_i]; }
            if constexpr (SP2) {
            PG8_LDB(B0, 0, 0); PG8_LDB(B1, 0, 1); PG8_SCHED; PG8_LDA(At, 0, 0); PG8_STAGE_A(PG8_SA(1, 1), a1, 1, gA);
            PG8_WAIT_V(8); PG8_WAIT_L(0); PG8_BAR; PG8_MMA(0, 0, At, B0); PG8_MMA(0, 1, At, B1); PG8_BAR; PG8_SCHED;
            PG8_LDA(At, 0, 1); PG8_STAGE(PG8_SB(0, 0), b2, voffB); PG8_STAGE(PG8_SB(0, 1), b2 + hstep, voffB); PG8_STAGE_A(PG8_SA(0, 0), a2, 0, gS);
            PG8_WAIT_V(8); PG8_WAIT_L(0); PG8_BAR; PG8_MMA(1, 0, At, B0); PG8_MMA(1, 1, At, B1); PG8_BAR; PG8_SCHED;
            PG8_LDB(B0, 1, 0); PG8_LDB(B1, 1, 1); PG8_SCHED; PG8_LDA(At, 1, 0); PG8_STAGE_A(PG8_SA(0, 1), a2, 1, gS);
            PG8_WAIT_V(8); PG8_WAIT_L(0); PG8_BAR; PG8_MMA(0, 0, At, B0); PG8_MMA(0, 1, At, B1); PG8_BAR; PG8_SCHED;
            PG8_LDA(At, 1, 1); PG8_STAGE(PG8_SB(1, 0), b3, voffB); PG8_STAGE(PG8_SB(1, 1), b3 + hstep, voffB); PG8_STAGE_A(PG8_SA(1, 0), a3, 0, gS);
            PG8_WAIT_V(8); PG8_WAIT_L(0); PG8_BAR; PG8_MMA(1, 0, At, B0); PG8_MMA(1, 1, At, B1); PG8_BAR; PG8_SCHED;
            } else {
            PG8_LDB(B0, 0, 0); PG8_SCHED; PG8_LDA(At, 0, 0); PG8_STAGE_A(PG8_SA(1, 1), a1, 1, gA);
            PG8_WAIT_L(8); PG8_BAR; PG8_WAIT_L(0); PG8_MMA(0, 0, At, B0); PG8_BAR; PG8_SCHED;
            PG8_LDB(B1, 0, 1); PG8_STAGE(PG8_SB(0, 0), b2, voffB);
            PG8_BAR; PG8_WAIT_L(0); PG8_MMA(0, 1, At, B1); PG8_BAR;
            PG8_LDA(At, 0, 1); PG8_STAGE_A(PG8_SA(0, 0), a2, 0, gS);
            PG8_BAR; PG8_WAIT_L(0); PG8_MMA(1, 0, At, B0); PG8_BAR; PG8_SCHED;
            PG8_STAGE(PG8_SB(0, 1), b2 + hstep, voffB);
            PG8_WAIT_V(6); PG8_BAR; PG8_MMA(1, 1, At, B1); PG8_BAR;
            PG8_LDB(B0, 1, 0); PG8_SCHED; PG8_LDA(At, 1, 0); PG8_STAGE_A(PG8_SA(0, 1), a2, 1, gS);
            PG8_WAIT_L(8); PG8_BAR; PG8_WAIT_L(0); PG8_MMA(0, 0, At, B0); PG8_BAR; PG8_SCHED;
            PG8_LDB(B1, 1, 1); PG8_STAGE(PG8_SB(1, 0), b3, voffB);
            PG8_BAR; PG8_WAIT_L(0); PG8_MMA(0, 1, At, B1); PG8_BAR;
            PG8_LDA(At, 1, 1); PG8_STAGE_A(PG8_SA(1, 0), a3, 0, gS);
            PG8_BAR; PG8_WAIT_L(0); PG8_MMA(1, 0, At, B0); PG8_BAR; PG8_SCHED;
            PG8_STAGE(PG8_SB(1, 1), b3 + hstep, voffB);
            PG8_WAIT_V(6); PG8_BAR; PG8_MMA(1, 1, At, B1); PG8_BAR;
            }
        }
        if constexpr (ALIGN_EPI) { if (wr == 0) PG8_BAR; }
        E(acc, cur, wr, wc, fr, fq);
        if (!has_next) break;
#pragma unroll
        for (int a = 0; a < 2; ++a)
#pragma unroll
            for (int b = 0; b < 2; ++b)
#pragma unroll
                for (int m = 0; m < 4; ++m)
#pragma unroll
                    for (int n = 0; n < 2; ++n) acc[a][b][m][n] = (f32x4){0.f, 0.f, 0.f, 0.f};
        cur = nxt; cA = nA; cB = nB; ++ui;
        if constexpr (GATHER) {
#pragma unroll
            for (int _h = 0; _h < 2; ++_h)
#pragma unroll
                for (int _i = 0; _i < 2; ++_i) gA[_h][_i] = gAn[_h][_i]; }
        if constexpr (ALIGN_EPI) { if (wr == 1) PG8_BAR; }
    }
    PG8_WAIT_V(0);
    if constexpr (!ALIGN_EPI) { if (wr == 0) PG8_BAR; }
    PG8_BAR;
#undef PG8_SA
#undef PG8_SB
#undef PG8_STAGE
#undef PG8_STAGE_A
#undef PG8_LDA
#undef PG8_LDB
#undef PG8_MMA
#undef PG8_WAIT_V
#undef PG8_WAIT_L
#undef PG8_BAR
#undef PG8_SCHED
#undef PG8_GOFF
}
__device__ __forceinline__ unsigned cvt_pk_bf16(float lo, float hi) { unsigned r; asm volatile("v_cvt_pk_bf16_f32 %0, %1, %2" : "=v"(r) : "v"(lo), "v"(hi)); return r; }
struct EpiBf16 {
    static constexpr bool PERM = true;
    bf16_t* O; int ldc, pnmask;
    __device__ __forceinline__ void operator()(const f32x4 (&acc)[2][2][4][2], const Unit& u, int wr, int wc, int fr, int fq) const {
        const int row0 = u.pm * BM + wr * 64 + fr, col0 = (u.pn & pnmask) * BM + wc * 32 + 8 * fq;
#pragma unroll
        for (int ai = 0; ai < 2; ++ai)
#pragma unroll
            for (int m = 0; m < 4; ++m) { bf16_t* rowp = O + (size_t)(row0 + ai * HALF + m * 16) * ldc + col0;
#pragma unroll
                for (int bj = 0; bj < 2; ++bj) { const f32x4 v0 = acc[ai][bj][m][0], v1 = acc[ai][bj][m][1];
                    u32x4 w; w.x = cvt_pk_bf16(v0[0], v0[1]); w.y = cvt_pk_bf16(v0[2], v0[3]); w.z = cvt_pk_bf16(v1[0], v1[1]); w.w = cvt_pk_bf16(v1[2], v1[3]);
                    *(u32x4*)(rowp + bj * HALF) = w; } }
    }
};
template <int MODE  > struct EpiGated {
    static constexpr bool PERM = true;
    bf16_t* O; int ldc, pnmask; const float* bias;
    __device__ __forceinline__ void operator()(const f32x4 (&acc)[2][2][4][2], const Unit& u, int wr, int wc, int fr, int fq) const {
        const int row0 = u.pm * BM + wr * 64 + fr, ch0 = (u.pn & pnmask) * HALF + wc * 32 + 8 * fq;
        f32x4 ba[2], bg[2];
#pragma unroll
        for (int n = 0; n < 2; ++n) { ba[n] = (f32x4){0.f, 0.f, 0.f, 0.f}; bg[n] = ba[n]; if (MODE == 0) { ba[n] = *(const f32x4*)(bias + ch0 + 4 * n); bg[n] = *(const f32x4*)(bias + 1024 + ch0 + 4 * n); } }
#pragma unroll
        for (int ai = 0; ai < 2; ++ai)
#pragma unroll
            for (int m = 0; m < 4; ++m) { float r[8];
#pragma unroll
                for (int n = 0; n < 2; ++n) { const f32x4 x = acc[ai][0][m][n] + ba[n], y = acc[ai][1][m][n] + bg[n];
#pragma unroll
                    for (int q = 0; q < 4; ++q) r[4 * n + q] = (MODE == 0) ? x[q] * sigmoidf_(y[q]) : siluf_(x[q]) * y[q]; }
                u32x4 w; w.x = cvt_pk_bf16(r[0], r[1]); w.y = cvt_pk_bf16(r[2], r[3]); w.z = cvt_pk_bf16(r[4], r[5]); w.w = cvt_pk_bf16(r[6], r[7]);
                *(u32x4*)(O + (size_t)(row0 + ai * HALF + m * 16) * ldc + ch0) = w; }
    }
};
struct EpiResid {
    static constexpr bool PERM = false;
    float* X; const float* gate;
    __device__ __forceinline__ void operator()(const f32x4 (&acc)[2][2][4][2], const Unit& u, int wr, int wc, int fr, int fq) const {
        const int row0 = u.pm * BM + wr * 64 + fr, col0 = u.pn * BM + wc * 32 + 4 * fq; const float* gp = gate + (size_t)((u.pm * BM) / SEQ) * 6144 + col0;
#pragma unroll
        for (int bj = 0; bj < 2; ++bj)
#pragma unroll
            for (int n = 0; n < 2; ++n) { const f32x4 gv = *(const f32x4*)(gp + bj * HALF + n * 16);
#pragma unroll
                for (int ai = 0; ai < 2; ++ai)
#pragma unroll
                    for (int m = 0; m < 4; ++m) { float* p = X + (size_t)(row0 + ai * HALF + m * 16) * D + col0 + bj * HALF + n * 16; *(f32x4*)p = *(const f32x4*)p + gv * acc[ai][bj][m][n]; } }
    }
};
struct EpiF32 {
    static constexpr bool PERM = false;
    float* O; int ldc, ncols;
    __device__ __forceinline__ void operator()(const f32x4 (&acc)[2][2][4][2], const Unit& u, int wr, int wc, int fr, int fq) const {
        const int row0 = u.pm * BM + wr * 64 + fr, col0 = u.pn * BM + wc * 32 + 4 * fq;
#pragma unroll
        for (int bj = 0; bj < 2; ++bj)
#pragma unroll
            for (int n = 0; n < 2; ++n) { const int c = col0 + bj * HALF + n * 16;
                if (c < ncols) {
#pragma unroll
                    for (int ai = 0; ai < 2; ++ai)
#pragma unroll
                        for (int m = 0; m < 4; ++m) *(f32x4*)(O + (size_t)(row0 + ai * HALF + m * 16) * ldc + c) = acc[ai][bj][m][n]; } }
    }
};
}

__device__ __forceinline__ int pair_row(int ch, int half) { return (ch >> 7) * 256 + half * 128 + (ch & 127); }

template <int MODE>
__device__ __forceinline__ void cvt_item(const float* W, int K, int N, int ld, bf16_t* WT, int row_off_or_half, LAS float* scr, int item, int lane) {
    const int nblk = N / 32, kb = item / nblk, nb = item % nblk, k0 = 64 * kb, n0 = 32 * nb;
#pragma unroll 8
    for (int i = 0; i < 32; ++i) { const int kk = 2 * i + (lane >> 5); scr[kk * 33 + (lane & 31)] = W[(size_t)(k0 + kk) * ld + n0 + (lane & 31)]; }
    asm volatile("s_waitcnt lgkmcnt(0)" ::: "memory");
    const int c = lane & 7;
#pragma unroll
    for (int j = 0; j < 4; ++j) { const int n = (lane >> 3) + 8 * j; const LAS float* s = scr + (8 * c) * 33 + n;
        u32x4 o; o.x = pk2(s[0 * 33], s[1 * 33]); o.y = pk2(s[2 * 33], s[3 * 33]); o.z = pk2(s[4 * 33], s[5 * 33]); o.w = pk2(s[6 * 33], s[7 * 33]);
        const int drow = (MODE == 0) ? (row_off_or_half + n0 + n) : pair_row(n0 + n, row_off_or_half);
        *(u32x4*)(WT + (size_t)drow * K + k0 + 8 * c) = o; }
    asm volatile("s_waitcnt lgkmcnt(0)" ::: "memory");
}

__device__ __forceinline__ void phase_prologue(LAS unsigned char* lds, int wv) {
    const Args a = oargs();
    const int tid = otid(wv), lane = tid & 63, wave = tid >> 6, G = gridDim.x;
    unsigned char* ws = a.ws;
    {
        const float* c = (const float*)a.in[1]; const float* ada_w = (const float*)a.in[3]; const float* ada_b = (const float*)a.in[4];
        float* mod = (float*)(ws + WS_MOD);
        LAS float* cs = (LAS float*)lds;
        LAS float* red = cs + 4096;
        bool have = false;
        for (int it = blockIdx.x; it < 4 * 48; it += G) {
            if (!have) { for (int i = tid; i < 4096; i += NTHREADS) cs[i] = siluf_(c[i]); have = true; }
            __syncthreads();
            const int l = it / 48, n0 = (it % 48) * 128;
            const float* wp = ada_w + (size_t)l * D * 6144 + n0 + 2 * lane;
            float acc[4][2] = {{0.f, 0.f}, {0.f, 0.f}, {0.f, 0.f}, {0.f, 0.f}};
            const int kb = wave * 128;
#pragma unroll 4
            for (int k = 0; k < 128; ++k) {
                const f32x2 w = *(const f32x2*)(wp + (size_t)(kb + k) * 6144);
#pragma unroll
                for (int b = 0; b < 4; ++b) { const float cv = cs[b * 1024 + kb + k]; acc[b][0] += cv * w.x; acc[b][1] += cv * w.y; }
            }
#pragma unroll
            for (int b = 0; b < 4; ++b) { red[(wave * 4 + b) * 128 + 2 * lane] = acc[b][0]; red[(wave * 4 + b) * 128 + 2 * lane + 1] = acc[b][1]; }
            __syncthreads();
            { const int b = tid >> 7, col = tid & 127; float s = 0.f;
#pragma unroll
              for (int w = 0; w < 8; ++w) s += red[(w * 4 + b) * 128 + col];
              mod[((size_t)l * 4 + b) * 6144 + n0 + col] = s + ada_b[l * 6144 + n0 + col]; }
        }
        __syncthreads();
    }
    {
        const int* pos = (const int*)a.in[2]; f32x2* rt = (f32x2*)(ws + WS_ROPE);
        for (int idx = blockIdx.x * NTHREADS + tid; idx < T * 32; idx += G * NTHREADS) {
            const int t = idx >> 5, i = idx & 31;
            const float inv = exp2f(-(float)i * (13.287712379549449f / 32.0f));
            const float ang = (float)pos[t] * inv;
            const float kf = rintf(ang * 0.15915494309189535f);
            float r = fmaf(-kf, 6.28125f, ang); r = fmaf(-kf, 1.9353071795864769e-3f, r);
            rt[idx] = (f32x2){__cosf(r), __sinf(r)};
        }
    }
    {
        LAS float* scr = (LAS float*)(lds + wave * 16384);
        const int gw = blockIdx.x * 8 + wave, NGW = G * 8;
        const float* w_in = (const float*)a.in[7]; const float* w_out = (const float*)a.in[13]; const float* w_dkv = (const float*)a.in[15]; const float* w_ukv = (const float*)a.in[17];
        const float* w_dq = (const float*)a.in[18]; const float* w_uq = (const float*)a.in[20]; const float* w_o = (const float*)a.in[21];
        const float* wg = (const float*)a.in[24]; const float* wu = (const float*)a.in[25]; const float* wd = (const float*)a.in[26];
        constexpr int I_IN = 16 * 64, I_OUT = 16 * 32, I_DKV = 16 * 10, I_UKV = 4 * 64, I_DQ = 16 * 12, I_UQ = 6 * 48, I_O = 16 * 32;
        constexpr int I_G = 16 * 16, I_D = 8 * 32;
        constexpr int NSMALL = 2 * I_IN + 2 * I_OUT + I_DKV + I_UKV + 2 * I_DQ + 2 * I_UQ + 2 * I_O;
        constexpr int NEXP = 4 * 16 * (2 * I_G + I_D);
        for (int it = gw; it < NSMALL + NEXP; it += NGW) {
            int r = it;
            if (r < 2 * I_IN) { const int l = r / I_IN; r %= I_IN; const int half = r / 512;
                cvt_item<1>(w_in + (size_t)l * D * 2048 + half * 1024, D, 1024, 2048, (bf16_t*)(ws + WS_WIN) + (size_t)l * 2048 * 1024, half, scr, r % 512, lane); continue; }
            r -= 2 * I_IN;
            if (r < 2 * I_OUT) { const int l = r / I_OUT; cvt_item<0>(w_out + (size_t)l * D * D, D, D, D, (bf16_t*)(ws + WS_WOUT) + (size_t)l * D * D, 0, scr, r % I_OUT, lane); continue; }
            r -= 2 * I_OUT;
            if (r < I_DKV) { cvt_item<0>(w_dkv, D, 320, 320, (bf16_t*)(ws + WS_WDKV), 0, scr, r, lane); continue; }
            r -= I_DKV;
            if (r < I_UKV) { cvt_item<0>(w_ukv, KVR, 2048, 2048, (bf16_t*)(ws + WS_WUKV), 0, scr, r, lane); continue; }
            r -= I_UKV;
            if (r < 2 * I_DQ) { const int j = r / I_DQ; cvt_item<0>(w_dq + (size_t)j * D * QR, D, QR, QR, (bf16_t*)(ws + WS_WDQ) + (size_t)j * 512 * D, 0, scr, r % I_DQ, lane); continue; }
            r -= 2 * I_DQ;
            if (r < 2 * I_UQ) { const int j = r / I_UQ; cvt_item<0>(w_uq + (size_t)j * QR * 1536, QR, 1536, 1536, (bf16_t*)(ws + WS_WUQ) + (size_t)j * 1536 * QR, 0, scr, r % I_UQ, lane); continue; }
            r -= 2 * I_UQ;
            if (r < 2 * I_O) { const int j = r / I_O; cvt_item<0>(w_o + (size_t)j * D * D, D, D, D, (bf16_t*)(ws + WS_WO) + (size_t)j * D * D, 0, scr, r % I_O, lane); continue; }
            r -= 2 * I_O;
            { const int per = 2 * I_G + I_D; const int le = r / per; r %= per;
              bf16_t* gu = (bf16_t*)(ws + WS_WGU) + (size_t)le * 1024 * 1024; bf16_t* dn = (bf16_t*)(ws + WS_WDN) + (size_t)le * 1024 * 512;
              if (r < I_G) cvt_item<1>(wg + (size_t)le * D * DE, D, DE, DE, gu, 0, scr, r, lane);
              else if (r < 2 * I_G) cvt_item<1>(wu + (size_t)le * D * DE, D, DE, DE, gu, 1, scr, r - I_G, lane);
              else cvt_item<0>(wd + (size_t)le * DE * D, DE, D, D, dn, 0, scr, r - 2 * I_G, lane); }
        }
        { const int gt = blockIdx.x * NTHREADS + tid, NT_ = G * NTHREADS; const u32x4 z = (u32x4){0u, 0u, 0u, 0u};
          u32x4* z0 = (u32x4*)((bf16_t*)(ws + WS_WDKV) + 320 * 1024); for (int i = gt; i < 192 * 1024 * 2 / 16; i += NT_) z0[i] = z;
          for (int j = 0; j < 2; ++j) { u32x4* z1 = (u32x4*)((bf16_t*)(ws + WS_WDQ) + (size_t)j * 512 * 1024 + 384 * 1024); for (int i = gt; i < 128 * 1024 * 2 / 16; i += NT_) z1[i] = z; } }
    }
}

__device__ __forceinline__ void row_load(const float* p, int lane, f32x4 (&v)[4]) {
#pragma unroll
    for (int j = 0; j < 4; ++j) v[j] = *(const f32x4*)(p + 4 * lane + 256 * j);
}
__device__ __forceinline__ float row_rstd(const f32x4 (&v)[4]) {
    float s = 0.f;
#pragma unroll
    for (int j = 0; j < 4; ++j) s += (v[j].x * v[j].x + v[j].y * v[j].y) + (v[j].z * v[j].z + v[j].w * v[j].w);
    return 1.0f / sqrtf(wave_sum(s) * (1.0f / D) + EPS);
}
__device__ __forceinline__ void row_modulate_store(const f32x4 (&v)[4], float r, const float* g, const float* sc, const float* sh, bf16_t* orow, int lane, f32x4 (*hout)[4] = nullptr) {
#pragma unroll
    for (int j = 0; j < 4; ++j) {
        const int c = 4 * lane + 256 * j;
        const f32x4 gv = *(const f32x4*)(g + c);
        f32x4 h = v[j] * r * gv;
        if (sc) { const f32x4 s1 = *(const f32x4*)(sc + c), s0 = *(const f32x4*)(sh + c); h = h * (s1 + 1.0f) + s0; }
        if (hout) (*hout)[j] = h;
        u32x2 o; o.x = pk2(h.x, h.y); o.y = pk2(h.z, h.w);
        *(u32x2*)(orow + c) = o;
    }
}

__device__ __forceinline__ void phase_mod0(int wv) {
    const Args a = oargs();
    const int tid_ = otid(wv); const int lane = tid_ & 63, gw = blockIdx.x * 8 + (tid_ >> 6), NGW = gridDim.x * 8;
    const float* x = (const float*)a.in[0]; const float* g = (const float*)a.in[5]; const float* mod = (const float*)(a.ws + WS_MOD);
    bf16_t* HA = (bf16_t*)(a.ws + WS_HA);
    for (int row = gw; row < T; row += NGW) {
        f32x4 v[4]; row_load(x + (size_t)row * D, lane, v);
#pragma unroll
        for (int j = 0; j < 4; ++j) *(f32x4*)(a.out + (size_t)row * D + 4 * lane + 256 * j) = v[j];
        const float r = row_rstd(v); const int b = row / SEQ;
        row_modulate_store(v, r, g, mod + (size_t)b * 6144 + 1024, mod + (size_t)b * 6144, HA + (size_t)row * D, lane);
    }
}

__device__ __forceinline__ void phase_conv(LAS unsigned char* lds, int wv, int l) {
    const Args a = oargs();
    const int tid = otid(wv), lane = tid & 63, wave = tid >> 6;
    const bf16_t* U = (const bf16_t*)(a.ws + WS_U); bf16_t* V2 = (bf16_t*)(a.ws + WS_V2);
    const float* w_dw = (const float*)a.in[9] + (size_t)l * CWID * D; const float* b_dw = (const float*)a.in[10] + l * D;
    const float* ln_g = (const float*)a.in[11] + l * D; const float* ln_b = (const float*)a.in[12] + l * D;
    constexpr int RC = 16, NR = RC + CWID - 1;
    LAS unsigned* ub = (LAS unsigned*)lds;
    LAS float* red = (LAS float*)(lds + NR * 2048);
    const int c = 2 * tid;
    float w0[CWID], w1[CWID];
#pragma unroll
    for (int j = 0; j < CWID; ++j) { const f32x2 w = *(const f32x2*)(w_dw + (size_t)j * D + c); w0[j] = w.x; w1[j] = w.y; }
    const f32x2 bd = *(const f32x2*)(b_dw + c), lg = *(const f32x2*)(ln_g + c), lb = *(const f32x2*)(ln_b + c);
    for (int it = blockIdx.x; it < T / RC; it += gridDim.x) {
        const int b = it / (SEQ / RC), t0 = (it % (SEQ / RC)) * RC;
        __syncthreads();
        for (int i = tid; i < NR * 128; i += NTHREADS) { const int rr = i >> 7, ch = i & 127; const int t = t0 - (CWID - 1) + rr;
            u32x4 val = (u32x4){0u, 0u, 0u, 0u};
            if (t >= 0) val = *(const u32x4*)(U + ((size_t)b * SEQ + t) * D + ch * 8);
            *(LAS u32x4*)(ub + rr * 512 + ch * 4) = val; }
        __syncthreads();
        float o0[RC], o1[RC];
#pragma unroll
        for (int t = 0; t < RC; ++t) { float s0 = bd.x, s1 = bd.y;
#pragma unroll
            for (int j = 0; j < CWID; ++j) { const unsigned w = ub[(t + j) * 512 + tid]; s0 += bflo(w) * w0[j]; s1 += bfhi(w) * w1[j]; }
            o0[t] = s0; o1[t] = s1; }
#pragma unroll
        for (int t = 0; t < RC; ++t) { const float s = wave_sum(o0[t] + o1[t]); const float q = wave_sum(o0[t] * o0[t] + o1[t] * o1[t]);
            if (lane == 0) { red[(wave * RC + t) * 2] = s; red[(wave * RC + t) * 2 + 1] = q; } }
        __syncthreads();
#pragma unroll
        for (int t = 0; t < RC; ++t) { float s = 0.f, q = 0.f;
#pragma unroll
            for (int w = 0; w < 8; ++w) { s += red[(w * RC + t) * 2]; q += red[(w * RC + t) * 2 + 1]; }
            const float mean = s * (1.0f / D); const float var = fmaxf(q * (1.0f / D) - mean * mean, 0.f); const float rstd = 1.0f / sqrtf(var + EPS);
            const float y0 = (o0[t] - mean) * rstd * lg.x + lb.x, y1 = (o1[t] - mean) * rstd * lg.y + lb.y;
            *(unsigned*)(V2 + ((size_t)b * SEQ + t0 + t) * D + c) = pk2(siluf_(y0), siluf_(y1)); }
    }
}

__device__ __forceinline__ float top2sum4(float a, float b, float c, float d) {
    return fmaxf(fmaxf(fmaxf(a + b, a + c), fmaxf(a + d, b + c)), fmaxf(b + d, c + d));
}
__device__ __forceinline__ void phase_route(LAS unsigned char* lds, int wv, int l) {
    const Args a = oargs();
    const int tid = otid(wv), lane = tid & 63, wave = tid >> 6, G = gridDim.x;
    const float* X = a.out; bf16_t* H2 = (bf16_t*)(a.ws + WS_H2);
    const float* g = (const float*)a.in[6] + l * D; const float* mod = (const float*)(a.ws + WS_MOD) + (size_t)l * 4 * 6144;
    const float* rw_g = (const float*)a.in[22]; const float* rb = (const float*)a.in[23];
    unsigned* cnt = (unsigned*)(a.ws + WS_CTL) + CW_CNT + 64 * l;
    int* list = (int*)(a.ws + WS_LIST); int* tokinfo = (int*)(a.ws + WS_TOKINFO);
    LAS float* rw = (LAS float*)lds;
    LAS int* lcnt = (LAS int*)(lds + 65536);
    LAS int* sel = (LAS int*)(lds + 65536 + 256);
    for (int i = tid; i < 1024 * 16 / 4; i += NTHREADS) { const f32x4 w = *(const f32x4*)(rw_g + 4 * i); const int c = i >> 2, e0 = (i & 3) * 4; rw[(e0 + 0) * 1024 + c] = w.x; rw[(e0 + 1) * 1024 + c] = w.y; rw[(e0 + 2) * 1024 + c] = w.z; rw[(e0 + 3) * 1024 + c] = w.w; }
    if (tid < 32) lcnt[tid] = 0;
    __syncthreads();
    float rbv[16];
#pragma unroll
    for (int e = 0; e < 16; ++e) rbv[e] = rb[e];
    int nloc = 0;
    for (int base = blockIdx.x * 8; base < T; base += G * 8, ++nloc) {
        const int row = base + wave; const int b = row / SEQ;
        f32x4 v[4]; row_load(X + (size_t)row * D, lane, v);
        const float r = row_rstd(v);
        f32x4 h[4];
        row_modulate_store(v, r, g, mod + (size_t)b * 6144 + 4 * 1024, mod + (size_t)b * 6144 + 3 * 1024, H2 + (size_t)row * D, lane, &h);
        float lg[16];
#pragma unroll
        for (int e = 0; e < 16; ++e) lg[e] = 0.f;
#pragma unroll
        for (int j = 0; j < 4; ++j)
#pragma unroll
            for (int e = 0; e < 16; ++e) { const f32x4 w = *(const LAS f32x4*)(rw + e * 1024 + 4 * lane + 256 * j);
                lg[e] += (h[j].x * w.x + h[j].y * w.y) + (h[j].z * w.z + h[j].w * w.w); }
        float s[16], sb[16];
#pragma unroll
        for (int e = 0; e < 16; ++e) { s[e] = 1.0f / (1.0f + expf(-wave_sum(lg[e]))); sb[e] = s[e] + rbv[e]; }
        float best = -1e30f; int gi = 0; float wb0 = 0, wb1 = 0, wb2 = 0, wb3 = 0, ws0 = 0, ws1 = 0, ws2 = 0, ws3 = 0;
#pragma unroll
        for (int q = 0; q < 4; ++q) { const float gs = top2sum4(sb[4 * q], sb[4 * q + 1], sb[4 * q + 2], sb[4 * q + 3]);
            if (gs > best) { best = gs; gi = q; wb0 = sb[4 * q]; wb1 = sb[4 * q + 1]; wb2 = sb[4 * q + 2]; wb3 = sb[4 * q + 3]; ws0 = s[4 * q]; ws1 = s[4 * q + 1]; ws2 = s[4 * q + 2]; ws3 = s[4 * q + 3]; } }
        int i1 = 0; float m1 = wb0, sv1 = ws0;
        if (wb1 > m1) { m1 = wb1; i1 = 1; sv1 = ws1; } if (wb2 > m1) { m1 = wb2; i1 = 2; sv1 = ws2; } if (wb3 > m1) { m1 = wb3; i1 = 3; sv1 = ws3; }
        int i2 = -1; float m2 = -1e30f, sv2 = 0.f;
        if (i1 != 0 && wb0 > m2) { m2 = wb0; i2 = 0; sv2 = ws0; } if (i1 != 1 && wb1 > m2) { m2 = wb1; i2 = 1; sv2 = ws1; }
        if (i1 != 2 && wb2 > m2) { m2 = wb2; i2 = 2; sv2 = ws2; } if (i1 != 3 && wb3 > m2) { m2 = wb3; i2 = 3; sv2 = ws3; }
        const int e0 = 4 * gi + i1, e1 = 4 * gi + i2; const float wsum = sv1 + sv2; const float w0 = sv1 / wsum, w1 = sv2 / wsum;
        if (lane == 0) { const int lp0 = atomicAdd((int*)&lcnt[e0], 1), lp1 = atomicAdd((int*)&lcnt[e1], 1);
            LAS int* sp = sel + (nloc * 8 + wave) * 8; sp[0] = row; sp[1] = e0; sp[2] = e1; sp[3] = lp0; sp[4] = lp1; sp[5] = __builtin_bit_cast(int, w0); sp[6] = __builtin_bit_cast(int, w1); }
    }
    __syncthreads();
    if (tid < 16) lcnt[16 + tid] = (int)atomicAdd(&cnt[tid], (unsigned)lcnt[tid]);
    __syncthreads();
    for (int i = tid; i < nloc * 8; i += NTHREADS) { const LAS int* sp = sel + i * 8; const int row = sp[0], e0 = sp[1], e1 = sp[2];
        const int p0 = lcnt[16 + e0] + sp[3], p1 = lcnt[16 + e1] + sp[4];
        list[(size_t)e0 * T + p0] = row; list[(size_t)e1 * T + p1] = row;
        int* ti = tokinfo + (size_t)row * 8; ti[0] = e0; ti[1] = p0; ti[2] = sp[5]; ti[3] = e1; ti[4] = p1; ti[5] = sp[6]; }
    __syncthreads();
}

__device__ __forceinline__ void moe_tiles(int wv, const unsigned* cnt, LAS int* tb, LAS int* cn) {
    __syncthreads();
    if (otid(wv) == 0) { int s = 0; for (int e = 0; e < 16; ++e) { const int c = (int)cnt[e]; cn[e] = c; tb[e] = s; s += (c + 255) >> 8; } tb[16] = s; }
    __syncthreads();
}
__device__ __forceinline__ void phase_moe_up(LAS unsigned char* lds, int wv, int l) {
    const Args a = oargs();
    LAS int* tb = (LAS int*)(lds + LDS_TB); LAS int* cn = tb + 32; LAS int* toks = (LAS int*)(lds + LDS_TOK);
    unsigned char* ws = a.ws;
    moe_tiles(wv, (const unsigned*)(ws + WS_CTL) + CW_CNT + 64 * l, tb, cn);
    pg8::MoeOrder S{tb, toks, (int)gridDim.x, (int)blockIdx.x};
    { const int tid = otid(wv); const int* list = (const int*)(ws + WS_LIST); pg8::Unit u;
      for (int ui = 0; ui < 12 && S.next(ui, u); ++ui) { const int e = u.pn >> 2;
          for (int r = tid; r < 256; r += NTHREADS) { const int pos = (u.pm - tb[e]) * 256 + r; toks[ui * 256 + r] = pos < cn[e] ? list[(size_t)e * T + pos] : 0; } }
      __syncthreads(); }
    const pg8::Gemm g{(const bf16_t*)(ws + WS_H2), (const bf16_t*)(ws + WS_WGU) + (size_t)l * 16 * 1024 * 1024, 0, 0, D};
    pg8::gemm_phase<pg8::EpiGated<1>, pg8::MoeOrder, true, true, true>(lds, wv, g, S, pg8::EpiGated<1>{(bf16_t*)(ws + WS_ACT), DE, 3, nullptr});
}
__device__ __forceinline__ void phase_moe_down(LAS unsigned char* lds, int wv, int l) {
    const Args a = oargs();
    LAS int* tb = (LAS int*)(lds + LDS_TB); LAS int* cn = tb + 32; LAS int* toks = (LAS int*)(lds + LDS_TOK);
    unsigned char* ws = a.ws;
    moe_tiles(wv, (const unsigned*)(ws + WS_CTL) + CW_CNT + 64 * l, tb, cn);
    pg8::MoeOrder S{tb, toks, (int)gridDim.x, (int)blockIdx.x};
    const pg8::Gemm g{(const bf16_t*)(ws + WS_ACT), (const bf16_t*)(ws + WS_WDN) + (size_t)l * 16 * 1024 * 512, 0, 0, DE};
    pg8::gemm_phase<pg8::EpiBf16, pg8::MoeOrder, true, true, false>(lds, wv, g, S, pg8::EpiBf16{(bf16_t*)(ws + WS_YB), D, 3});
}
__device__ __forceinline__ void phase_combine(LAS unsigned char* lds, int wv, int l) {
    const Args a = oargs();
    LAS int* tb = (LAS int*)(lds + LDS_TB); LAS int* cn = tb + 32;
    const unsigned* cnt = (const unsigned*)(a.ws + WS_CTL) + CW_CNT + 64 * l;
    moe_tiles(wv, cnt, tb, cn);
    const int tid_ = otid(wv); const int lane = tid_ & 63, gw = blockIdx.x * 8 + (tid_ >> 6), NGW = gridDim.x * 8;
    float* X = a.out; const bf16_t* YB = (const bf16_t*)(a.ws + WS_YB); const int* tokinfo = (const int*)(a.ws + WS_TOKINFO);
    const float* mod = (const float*)(a.ws + WS_MOD);
    for (int row = gw; row < T; row += NGW) {
        const int b = row / SEQ; const int* ti = tokinfo + (size_t)row * 8;
        const int e0 = ti[0], p0 = ti[1], e1 = ti[3], p1 = ti[4]; const float w0 = __builtin_bit_cast(float, ti[2]), w1 = __builtin_bit_cast(float, ti[5]);
        const bf16_t* y0 = YB + (size_t)(tb[e0] * 256 + p0) * D; const bf16_t* y1 = YB + (size_t)(tb[e1] * 256 + p1) * D;
        const float* g2 = mod + ((size_t)l * 4 + b) * 6144 + 5 * 1024;
        f32x4 v[4]; row_load(X + (size_t)row * D, lane, v);
#pragma unroll
        for (int j = 0; j < 4; ++j) { const int c = 4 * lane + 256 * j; const u32x2 a0 = *(const u32x2*)(y0 + c), a1 = *(const u32x2*)(y1 + c); const f32x4 gv = *(const f32x4*)(g2 + c);
            f32x4 y; y.x = w0 * bflo(a0.x) + w1 * bflo(a1.x); y.y = w0 * bfhi(a0.x) + w1 * bfhi(a1.x); y.z = w0 * bflo(a0.y) + w1 * bflo(a1.y); y.w = w0 * bfhi(a0.y) + w1 * bfhi(a1.y);
            v[j] = v[j] + gv * y; }
        const float r = row_rstd(v);
        if (l == DEPTH - 1) {
            const float* fg = (const float*)a.in[27];
#pragma unroll
            for (int j = 0; j < 4; ++j) { const int c = 4 * lane + 256 * j; *(f32x4*)(X + (size_t)row * D + c) = v[j] * r * *(const f32x4*)(fg + c); }
        } else {
#pragma unroll
            for (int j = 0; j < 4; ++j) *(f32x4*)(X + (size_t)row * D + 4 * lane + 256 * j) = v[j];
            const float* mn = mod + ((size_t)(l + 1) * 4 + b) * 6144;
            row_modulate_store(v, r, (const float*)a.in[5] + (l + 1) * D, mn + 1024, mn, (bf16_t*)(a.ws + WS_HA) + (size_t)row * D, lane);
            if (l == 1) row_modulate_store(v, r, (const float*)a.in[14], nullptr, nullptr, (bf16_t*)(a.ws + WS_XKV) + (size_t)row * D, lane);
        }
    }
}

__device__ __forceinline__ void phase_mla_norm(int wv, int j) {
    const Args a = oargs();
    const int tid_ = otid(wv); const int lane = tid_ & 63, gw = blockIdx.x * 8 + (tid_ >> 6), NGW = gridDim.x * 8;
    const float* CQRAW = (const float*)(a.ws + WS_CQRAW); const float* CKVRAW = (const float*)(a.ws + WS_CKVRAW);
    bf16_t* CQ = (bf16_t*)(a.ws + WS_CQ); bf16_t* LAT = (bf16_t*)(a.ws + WS_LAT); bf16_t* KROPE = (bf16_t*)(a.ws + WS_KROPE);
    const float* qg = (const float*)a.in[19] + j * QR; const float* kg = (const float*)a.in[16]; const f32x2* rope = (const f32x2*)(a.ws + WS_ROPE);
    for (int row = gw; row < T; row += NGW) {
        { f32x2 v[3]; float s = 0.f;
#pragma unroll
          for (int q = 0; q < 3; ++q) { v[q] = *(const f32x2*)(CQRAW + (size_t)row * QR + 2 * lane + 128 * q); s += v[q].x * v[q].x + v[q].y * v[q].y; }
          const float r = 1.0f / sqrtf(wave_sum(s) * (1.0f / QR) + EPS);
#pragma unroll
          for (int q = 0; q < 3; ++q) { const int c = 2 * lane + 128 * q; const f32x2 gv = *(const f32x2*)(qg + c); *(unsigned*)(CQ + (size_t)row * QR + c) = pk2(v[q].x * r * gv.x, v[q].y * r * gv.y); } }
        if (j == 0) {
            const f32x4 v = *(const f32x4*)(CKVRAW + (size_t)row * 320 + 4 * lane);
            const float s = (v.x * v.x + v.y * v.y) + (v.z * v.z + v.w * v.w);
            const float r = 1.0f / sqrtf(wave_sum(s) * (1.0f / KVR) + EPS);
            const f32x4 gv = *(const f32x4*)(kg + 4 * lane);
            u32x2 o; o.x = pk2(v.x * r * gv.x, v.y * r * gv.y); o.y = pk2(v.z * r * gv.z, v.w * r * gv.w);
            *(u32x2*)(LAT + (size_t)row * KVR + 4 * lane) = o;
            if (lane < 32) { const float x1 = CKVRAW[(size_t)row * 320 + 256 + lane], x2 = CKVRAW[(size_t)row * 320 + 288 + lane]; const f32x2 cs = rope[(size_t)row * 32 + lane];
                KROPE[(size_t)row * 64 + lane] = (bf16_t)f2bf(x1 * cs.x - x2 * cs.y); KROPE[(size_t)row * 64 + 32 + lane] = (bf16_t)f2bf(x1 * cs.y + x2 * cs.x); }
        }
    }
}

namespace att {
typedef float f32x16 __attribute__((ext_vector_type(16)));
typedef short s16x4 __attribute__((ext_vector_type(4)));
constexpr int QB = 256, KVB = 64, KPB = 400  , SHM_V = KVB * 128 * 2, SHM_K = KVB * KPB;
constexpr int K_OFF = 2 * SHM_V, SCR_OFF = K_OFF + 2 * SHM_K;
constexpr float THR = 8.f;
__device__ __forceinline__ int v_st(int k, int c) { const int kk = (k & ~0xC) | ((k & 4) << 1) | ((k & 8) >> 1); return ((kk >> 3) * 4 + (c >> 5)) * 512 + ((kk & 7) * 32 + (c & 31)) * 2; }
__device__ __forceinline__ int v_rd_base(int lane) { return ((lane & 3) << 3) | (((lane >> 2) & 3) << 6) | (((lane >> 4) & 1) << 5) | (((lane >> 5) & 1) << 8); }
constexpr int v_rd_off(int d0, int ks, int half) { return d0 * 512 + ks * 4096 + half * 2048; }
__device__ __forceinline__ int crow(int r, int hi) { return (r & 3) + 8 * (r >> 2) + 4 * hi; }
__device__ __forceinline__ unsigned cvtpk(float lo, float hi) { unsigned r; asm volatile("v_cvt_pk_bf16_f32 %0, %1, %2" : "=v"(r) : "v"(lo), "v"(hi)); return r; }
#define ASBAR() __builtin_amdgcn_sched_barrier(0)
__device__ __forceinline__ void mask_tile(f32x16& p0, f32x16& p1, int dq) {
    const float NEG = -__builtin_inff();
#pragma unroll
    for (int r = 0; r < 16; ++r) { const int c = (r & 3) + 8 * (r >> 2); if (dq - c < 0) p0[r] = NEG; if (dq - c - 32 < 0) p1[r] = NEG; }
}
__device__ __forceinline__ void partialSM(f32x16& p0, f32x16& p1, float& m_reg, float& mn, float& alpha) {
    float pmax = p0[0];
#pragma unroll
    for (int r = 1; r < 16; ++r) pmax = fmaxf(pmax, p0[r]);
#pragma unroll
    for (int r = 0; r < 16; ++r) pmax = fmaxf(pmax, p1[r]);
    { float a_, b_; swap32(pmax, a_, b_); pmax = fmaxf(a_, b_); }
    constexpr float C2 = 1.4426950408889634f * ATTN_SCALE;
    if (__builtin_expect(__all((pmax - m_reg) * ATTN_SCALE <= THR), 1)) { mn = m_reg; alpha = 1.f; }
    else { mn = fmaxf(m_reg, pmax); alpha = __builtin_amdgcn_exp2f((m_reg - mn) * C2); m_reg = mn; }
    const float mnL = -mn * C2;
#pragma unroll
    for (int r = 0; r < 16; ++r) p0[r] = fmaf(p0[r], C2, mnL);
#pragma unroll
    for (int r = 0; r < 16; ++r) p1[r] = fmaf(p1[r], C2, mnL);
#pragma unroll
    for (int r = 0; r < 16; ++r) p0[r] = __builtin_amdgcn_exp2f(p0[r]);
}
__device__ __forceinline__ void finishSM(f32x16& p0, f32x16& p1, float alpha, float& l_reg, bf16x8& pa0, bf16x8& pa1, bf16x8& pa2, bf16x8& pa3) {
#pragma unroll
    for (int r = 0; r < 16; ++r) p1[r] = __builtin_amdgcn_exp2f(p1[r]);
    float ps = 0;
#pragma unroll
    for (int r = 0; r < 16; ++r) ps += p0[r];
#pragma unroll
    for (int r = 0; r < 16; ++r) ps += p1[r];
    { float a_, b_; swap32(ps, a_, b_); ps = a_ + b_; }
    l_reg = l_reg * alpha + ps;
#define PK4(P, B_, OUT) do { unsigned a0 = cvtpk(P[B_+0], P[B_+1]), a1 = cvtpk(P[B_+2], P[B_+3]); unsigned b0 = cvtpk(P[B_+4], P[B_+5]), b1 = cvtpk(P[B_+6], P[B_+7]); \
        auto r0 = __builtin_amdgcn_permlane32_swap(a0, b0, false, false); auto r1 = __builtin_amdgcn_permlane32_swap(a1, b1, false, false); \
        u32x4 w = {r0[0], r1[0], r0[1], r1[1]}; OUT = *reinterpret_cast<bf16x8*>(&w); } while (0)
    PK4(p0, 0, pa0); PK4(p0, 8, pa1); PK4(p1, 0, pa2); PK4(p1, 8, pa3);
#undef PK4
}
template <int KB>
__device__ __forceinline__ void qkt(f32x16& p0, f32x16& p1, const LAS unsigned char* kb, const bf16x8 (&qr)[12]) {
    p0 = f32x16{}; p1 = f32x16{};
#pragma unroll
    for (int d0 = 0; d0 < 12; ++d0) {
        const bf16x8 b0 = *(const LAS bf16x8*)(kb + KB * SHM_K + 32 * d0);
        const bf16x8 b1 = *(const LAS bf16x8*)(kb + KB * SHM_K + 32 * KPB + 32 * d0);
        p0 = __builtin_amdgcn_mfma_f32_32x32x16_bf16(b0, qr[d0], p0, 0, 0, 0);
        p1 = __builtin_amdgcn_mfma_f32_32x32x16_bf16(b1, qr[d0], p1, 0, 0, 0); }
}
template <int VB>
__device__ __forceinline__ void pv_tile(f32x16 (&o)[4], unsigned vb0, bf16x8 pa0, bf16x8 pa1, bf16x8 pa2, bf16x8 pa3) {
#define TRRD(dst, off) asm volatile("ds_read_b64_tr_b16 %0, %1 offset:%2" : "=&v"(dst) : "v"(vb0), "i"(off) : "memory")
#define PV_D0(d0) do { s16x4 l0, l1, l2, l3, h0, h1, h2, h3; constexpr int b_ = VB * SHM_V + v_rd_off(d0, 0, 0); \
        TRRD(l0, b_); TRRD(h0, b_ + 2048); TRRD(l1, b_ + 4096); TRRD(h1, b_ + 6144); TRRD(l2, b_ + 8192); TRRD(h2, b_ + 10240); TRRD(l3, b_ + 12288); TRRD(h3, b_ + 14336); \
        asm volatile("s_waitcnt lgkmcnt(0)" ::: "memory"); ASBAR(); \
        o[d0] = __builtin_amdgcn_mfma_f32_32x32x16_bf16(pa0, (bf16x8){l0[0], l0[1], l0[2], l0[3], h0[0], h0[1], h0[2], h0[3]}, o[d0], 0, 0, 0); \
        o[d0] = __builtin_amdgcn_mfma_f32_32x32x16_bf16(pa1, (bf16x8){l1[0], l1[1], l1[2], l1[3], h1[0], h1[1], h1[2], h1[3]}, o[d0], 0, 0, 0); \
        o[d0] = __builtin_amdgcn_mfma_f32_32x32x16_bf16(pa2, (bf16x8){l2[0], l2[1], l2[2], l2[3], h2[0], h2[1], h2[2], h2[3]}, o[d0], 0, 0, 0); \
        o[d0] = __builtin_amdgcn_mfma_f32_32x32x16_bf16(pa3, (bf16x8){l3[0], l3[1], l3[2], l3[3], h3[0], h3[1], h3[2], h3[3]}, o[d0], 0, 0, 0); } while (0)
    PV_D0(0); PV_D0(1); PV_D0(2); PV_D0(3);
#undef PV_D0
#undef TRRD
}
}

__device__ __forceinline__ void phase_attn(LAS unsigned char* lds, int wv) {
    const Args a = oargs();
    using namespace att;
    const int tid = otid(wv), lane = tid & 63, wid = __builtin_amdgcn_readfirstlane(tid >> 6), r32 = lane & 31, hi = lane >> 5, G = gridDim.x;
    unsigned char* ws = a.ws;
    const bf16_t* Q = (const bf16_t*)(ws + WS_Q); const bf16_t* KV = (const bf16_t*)(ws + WS_KV); const bf16_t* KR = (const bf16_t*)(ws + WS_KROPE);
    bf16_t* AO = (bf16_t*)(ws + WS_AO); const f32x2* rope = (const f32x2*)(ws + WS_ROPE);
    const __amdgpu_buffer_rsrc_t rsKV = __builtin_amdgcn_make_buffer_rsrc((void*)KV, 0, T * 2048 * 2, 0x00020000);
    const __amdgpu_buffer_rsrc_t rsKR = __builtin_amdgcn_make_buffer_rsrc((void*)KR, 0, T * 64 * 2, 0x00020000);
    LAS unsigned char* K_lds = lds + K_OFF;
    LAS float* wsc = (LAS float*)(lds + SCR_OFF) + wid * 64; LAS float* li_l = wsc; LAS float* al_l = wsc + 32;
    const int sr = tid >> 4, sc = (tid & 15) * 8, kr = tid >> 3, kc = tid & 7;
    const int vst0 = v_st(sr, sc), vst1 = v_st(32 + sr, sc), kw0 = sr * KPB + sc * 2, kw1 = (32 + sr) * KPB + sc * 2, kw2 = kr * KPB + 256 + kc * 16;
    const unsigned vb0 = (unsigned)(size_t)lds + (unsigned)v_rd_base(lane);
    const LAS unsigned char* kbp = K_lds + r32 * KPB + hi * 16;
    constexpr int NQB = SEQ / QB, NPAIR = NQB / 2, NITEM = NB * NH * NPAIR;
    for (int it0 = blockIdx.x; it0 < NITEM; it0 += G) {
        int item = it0; if ((G & 7) == 0 && NITEM % G == 0) { const int base = (it0 / G) * G, c = it0 - base; item = base + (c & 7) * (G >> 3) + (c >> 3); }
        const int bh = item / NPAIR, pr = item % NPAIR, b = bh / NH, h = bh % NH;
        const size_t tb0 = (size_t)b * SEQ;
        for (int pass = 0; pass < 2; ++pass) {
            const int qb = pass == 0 ? (NQB - 1 - pr) : pr;
            const int P0 = qb * QB, NT = 4 * (qb + 1), qlo = P0 + wid * 32, qm = qlo + r32 - 4 * hi;
            bf16x8 qr[12];
            { const size_t row = tb0 + P0 + wid * 32 + r32; const bf16_t* qp = Q + row * 1536 + h * DQK + 8 * hi;
#pragma unroll
              for (int d0 = 0; d0 < 12; ++d0) qr[d0] = *(const bf16x8*)(qp + 16 * d0);
#pragma unroll
              for (int dd = 0; dd < 2; ++dd) { ASBAR();
#pragma unroll
                  for (int j4 = 0; j4 < 2; ++j4) { const f32x4 ca = *(const f32x4*)(rope + row * 32 + 16 * dd + 8 * hi + 4 * j4), cb = *(const f32x4*)(rope + row * 32 + 16 * dd + 8 * hi + 4 * j4 + 2);
                      const float cc[4] = {ca.x, ca.z, cb.x, cb.z}, ss[4] = {ca.y, ca.w, cb.y, cb.w};
#pragma unroll
                      for (int jj = 0; jj < 4; ++jj) { const int j = 4 * j4 + jj; const float x1 = bf2f((unsigned short)qr[8 + dd][j]), x2 = bf2f((unsigned short)qr[10 + dd][j]);
                          qr[8 + dd][j] = (short)f2bf(x1 * cc[jj] - x2 * ss[jj]); qr[10 + dd][j] = (short)f2bf(x1 * ss[jj] + x2 * cc[jj]); } } }
              ASBAR(); }
            float m_reg = -1e30f, l_reg = 0.f; f32x16 o[4] = {};
            u32x4 st_v0, st_v1, st_k0, st_k1, st_k2;
            const unsigned voKV = (unsigned)(sr * 2048 + h * 256 + sc) * 2u, voKR = (unsigned)(kr * 64 + kc * 8) * 2u;
#define ALOAD(kb_) do { const unsigned t0_ = (unsigned)tb0 + (unsigned)(kb_); \
                st_v0 = __builtin_amdgcn_raw_buffer_load_b128(rsKV, voKV + 256u, t0_ * 4096u, 0); st_v1 = __builtin_amdgcn_raw_buffer_load_b128(rsKV, voKV + 256u, (t0_ + 32u) * 4096u, 0); \
                st_k0 = __builtin_amdgcn_raw_buffer_load_b128(rsKV, voKV, t0_ * 4096u, 0); st_k1 = __builtin_amdgcn_raw_buffer_load_b128(rsKV, voKV, (t0_ + 32u) * 4096u, 0); \
                st_k2 = __builtin_amdgcn_raw_buffer_load_b128(rsKR, voKR, t0_ * 128u, 0); } while (0)
#define AWRITE(bf) do { *(LAS u32x4*)(lds + (bf) * SHM_V + vst0) = st_v0; *(LAS u32x4*)(lds + (bf) * SHM_V + vst1) = st_v1; \
                *(LAS u32x4*)(K_lds + (bf) * SHM_K + kw0) = st_k0; *(LAS u32x4*)(K_lds + (bf) * SHM_K + kw1) = st_k1; *(LAS u32x4*)(K_lds + (bf) * SHM_K + kw2) = st_k2; } while (0)
#define RESC(a_) do { if (__any((a_) < 1.f)) { if (hi == 0) al_l[r32] = (a_); asm volatile("s_waitcnt lgkmcnt(0)" ::: "memory"); \
                _Pragma("unroll") for (int d_ = 0; d_ < 4; ++d_) _Pragma("unroll") for (int r = 0; r < 16; ++r) o[d_][r] *= al_l[crow(r, hi)]; } } while (0)
#define ASTEP(t, BF) do { f32x16 p0, p1; float mn, al; bf16x8 pa0, pa1, pa2, pa3; const int kb_ = (t) * KVB; \
                if ((t) + 1 < NT) ALOAD(kb_ + KVB); \
                ASBAR(); qkt<BF>(p0, p1, kbp, qr); \
                if (kb_ + KVB - 1 > qlo) mask_tile(p0, p1, qm - kb_); \
                partialSM(p0, p1, m_reg, mn, al); RESC(al); finishSM(p0, p1, al, l_reg, pa0, pa1, pa2, pa3); ASBAR(); \
                pv_tile<BF>(o, vb0, pa0, pa1, pa2, pa3); \
                if ((t) + 1 < NT) { asm volatile("s_waitcnt vmcnt(0)" ::: "memory"); AWRITE((BF) ^ 1); } \
                __syncthreads(); } while (0)
            __syncthreads();
            ALOAD(0); asm volatile("s_waitcnt vmcnt(0)" ::: "memory"); AWRITE(0);
            __syncthreads();
            for (int t = 0; t < NT; t += 2) { ASTEP(t, 0); ASTEP(t + 1, 1); }
            if (hi == 0) li_l[r32] = l_reg;
            asm volatile("s_waitcnt lgkmcnt(0)" ::: "memory");
            int r32e = r32, hie = hi; asm volatile("" : "+v"(r32e), "+v"(hie));
            bf16_t* Ow = AO + (tb0 + P0 + wid * 32) * D + h * 128 + r32e;
#pragma unroll
            for (int r = 0; r < 16; ++r) { const int orow = (r & 3) + 8 * (r >> 2) + 4 * hie; const float rl = __builtin_amdgcn_rcpf(li_l[orow]);
#pragma unroll
                for (int d0 = 0; d0 < 4; ++d0) { const float v = o[d0][r] * rl; const float vn = __shfl_xor(v, 1);
                    if ((r32e & 1) == 0) *(unsigned*)(Ow + (size_t)orow * D + d0 * 32) = cvtpk(v, vn); } }
#undef ALOAD
#undef AWRITE
#undef RESC
#undef ASTEP
        }
    }
    __syncthreads();
}

__device__ __forceinline__ void phase_c1(LAS unsigned char* lds, int wv, int l) {
    const Args a = oargs(); unsigned char* ws = a.ws;
    const pg8::Gemm g{(const bf16_t*)(ws + WS_HA), (const bf16_t*)(ws + WS_WIN) + (size_t)l * 2048 * 1024, T, 2048, D};
    pg8::StaticOrder S; S.init(T, 2048, (int)gridDim.x, (int)blockIdx.x);
    pg8::gemm_phase<pg8::EpiGated<0>, pg8::StaticOrder, true, true, false>(lds, wv, g, S, pg8::EpiGated<0>{(bf16_t*)(ws + WS_U), D, 0xffff, (const float*)a.in[8] + l * 2048});
}
__device__ __forceinline__ void phase_resid(LAS unsigned char* lds, int wv, int l, size_t a_off, size_t w_off) {
    const Args a = oargs(); unsigned char* ws = a.ws;
    const pg8::Gemm g{(const bf16_t*)(ws + a_off), (const bf16_t*)(ws + w_off), T, D, D};
    pg8::StaticOrder S; S.init(T, D, (int)gridDim.x, (int)blockIdx.x);
    pg8::gemm_phase<pg8::EpiResid, pg8::StaticOrder, true, true, false>(lds, wv, g, S, pg8::EpiResid{a.out, (const float*)(ws + WS_MOD) + (size_t)l * 4 * 6144 + 2048});
}
__device__ __forceinline__ void phase_a1(LAS unsigned char* lds, int wv, int j) {
    const Args a = oargs(); unsigned char* ws = a.ws;
    { const pg8::Gemm g{(const bf16_t*)(ws + WS_HA), (const bf16_t*)(ws + WS_WDQ) + (size_t)j * 512 * D, T, 512, D};
      pg8::StaticOrder S; S.init(T, 512, (int)gridDim.x, (int)blockIdx.x);
      pg8::gemm_phase<pg8::EpiF32, pg8::StaticOrder, true, true, false>(lds, wv, g, S, pg8::EpiF32{(float*)(ws + WS_CQRAW), QR, QR}); }
    if (j == 0) { const pg8::Gemm g{(const bf16_t*)(ws + WS_XKV), (const bf16_t*)(ws + WS_WDKV), T, 512, D};
      pg8::StaticOrder S; S.init(T, 512, (int)gridDim.x, (int)((blockIdx.x + gridDim.x / 2) % gridDim.x));
      pg8::gemm_phase<pg8::EpiF32, pg8::StaticOrder, true, true, false>(lds, wv, g, S, pg8::EpiF32{(float*)(ws + WS_CKVRAW), 320, 320}); }
}
__device__ __forceinline__ void phase_a2(LAS unsigned char* lds, int wv, int j) {
    const Args a = oargs(); unsigned char* ws = a.ws;
    { const pg8::Gemm g{(const bf16_t*)(ws + WS_CQ), (const bf16_t*)(ws + WS_WUQ) + (size_t)j * 1536 * QR, T, 1536, QR};
      pg8::StaticOrder S; S.init(T, 1536, (int)gridDim.x, (int)blockIdx.x);
      pg8::gemm_phase<pg8::EpiBf16, pg8::StaticOrder, true, true, false>(lds, wv, g, S, pg8::EpiBf16{(bf16_t*)(ws + WS_Q), 1536, 0xffff}); }
    if (j == 0) { const pg8::Gemm g{(const bf16_t*)(ws + WS_LAT), (const bf16_t*)(ws + WS_WUKV), T, 2048, KVR};
      pg8::StaticOrder S; S.init(T, 2048, (int)gridDim.x, (int)((blockIdx.x + gridDim.x / 2) % gridDim.x));
      pg8::gemm_phase<pg8::EpiBf16, pg8::StaticOrder, true, true, false>(lds, wv, g, S, pg8::EpiBf16{(bf16_t*)(ws + WS_KV), 2048, 0xffff}); }
}

constexpr int PH_PER_LAYER = 9, NPHASE = 2 + DEPTH * PH_PER_LAYER;
__global__ void __launch_bounds__(NTHREADS, 2) fwd(Args a) {
    extern __shared__ __attribute__((aligned(16))) unsigned char lds_raw[];
    LAS unsigned char* lds = (LAS unsigned char*)lds_raw;
    const int lo = a.ph_lo, hi = a.ph_hi;
    volatile LAS unsigned* misc = (volatile LAS unsigned*)(lds + LDS_MISC);
    const int wv = __builtin_amdgcn_readfirstlane((int)(threadIdx.x >> 6));
    if (threadIdx.x < 32) misc[threadIdx.x] = 0u;
    __syncthreads();
    if (hi - lo > 1) (void)xcd_barrier_post((unsigned*)(a.ws + WS_CTL) + CW_BAR, misc + 8);
#define IN(k) (lo <= (k) && (k) < hi)
#define SEAM(k) do { if ((k) + 1 < hi) { XcdBarrier bb_; bb_.bar = (unsigned*)(oargs().ws + WS_CTL) + CW_BAR; bb_.x = xb_xcc_id(); bb_.st = misc + 8; xcd_barrier(bb_, otid(wv) == 0); } } while (0)

    if (IN(0)) { phase_prologue(lds, wv); SEAM(0); }
    if (IN(1)) { phase_mod0(wv); SEAM(1); }
#pragma unroll 1
    for (int l = 0; l < DEPTH; ++l) {
        const int pb = 2 + PH_PER_LAYER * l;
        if (l < 2) {
            if (IN(pb + 0)) { phase_c1(lds, wv, l); SEAM(pb + 0); }
            if (IN(pb + 1)) { phase_conv(lds, wv, l); SEAM(pb + 1); }
            if (IN(pb + 2)) { phase_resid(lds, wv, l, WS_V2, WS_WOUT + (size_t)l * D * D * 2); SEAM(pb + 2); }
        } else {
            const int j = l - 2;
            if (IN(pb + 0)) { phase_a1(lds, wv, j); SEAM(pb + 0); }
            if (IN(pb + 1)) { phase_mla_norm(wv, j); SEAM(pb + 1); }
            if (IN(pb + 2)) { phase_a2(lds, wv, j); SEAM(pb + 2); }
            if (IN(pb + 3)) { phase_attn(lds, wv); SEAM(pb + 3); }
            if (IN(pb + 4)) { phase_resid(lds, wv, l, WS_AO, WS_WO + (size_t)j * D * D * 2); SEAM(pb + 4); }
        }
        if (IN(pb + 5)) { phase_route(lds, wv, l); SEAM(pb + 5); }
        if (IN(pb + 6)) { phase_moe_up(lds, wv, l); SEAM(pb + 6); }
        if (IN(pb + 7)) { phase_moe_down(lds, wv, l); SEAM(pb + 7); }
        if (IN(pb + 8)) { phase_combine(lds, wv, l); SEAM(pb + 8); }
    }
#undef IN
#undef SEAM
}

extern "C" void kernel_launch(void* const* d_in, const int* in_sizes, int n_in, void* d_out, int out_size, void* d_ws, size_t ws_size, hipStream_t stream) {
    static int grid = 0;
    if (grid == 0) {
        if (n_in != 28 || out_size != T * D || ws_size < WS_END) { fprintf(stderr, "kernel_launch: unexpected shapes (n_in %d out %d ws %zu)\n", n_in, out_size, ws_size); grid = -1; return; }
        int dev = 0, cus = 0, per_cu = 0;
        if (hipGetDevice(&dev) != hipSuccess || hipDeviceGetAttribute(&cus, hipDeviceAttributeMultiprocessorCount, dev) != hipSuccess) { grid = -1; return; }
        if (hipFuncSetAttribute((const void*)fwd, hipFuncAttributeMaxDynamicSharedMemorySize, LDS_BYTES) != hipSuccess) { fprintf(stderr, "kernel_launch: hipFuncSetAttribute failed\n"); grid = -1; return; }
        if (hipOccupancyMaxActiveBlocksPerMultiprocessor(&per_cu, (const void*)fwd, NTHREADS, LDS_BYTES) != hipSuccess || per_cu < 1) fprintf(stderr, "kernel_launch: occupancy query reports %d\n", per_cu);
        (void)hipGetLastError();
        grid = cus;
    }
    if (grid < 0) return;
    (void)hipMemsetAsync((char*)d_ws + WS_CTL, 0, CTL_BYTES, stream);
    Args a{};
    for (int i = 0; i < 28; ++i) a.in[i] = d_in[i];
    a.out = (float*)d_out; a.ws = (unsigned char*)d_ws;
#if MK_ONE_LAUNCH
    a.ph_lo = 0; a.ph_hi = NPHASE;
    hipLaunchKernelGGL(fwd, dim3(grid), dim3(NTHREADS), LDS_BYTES, stream, a);
#else
    for (int ph = 0; ph < NPHASE; ++ph) {
        if (ph >= 2) { const int l = (ph - 2) / PH_PER_LAYER, k = (ph - 2) % PH_PER_LAYER; if (l < 2 && (k == 3 || k == 4)) continue; }
        a.ph_lo = ph; a.ph_hi = ph + 1;
        hipLaunchKernelGGL(fwd, dim3(grid), dim3(NTHREADS), LDS_BYTES, stream, a);
    }
#endif
}
```

```cpp
#include <hip/hip_runtime.h>
#include <cstdio>
#include <cstdint>

#define LAS __attribute__((address_space(3)))
typedef unsigned short bf16_t;
typedef short bf16x8 __attribute__((ext_vector_type(8)));
typedef float f32x4 __attribute__((ext_vector_type(4)));
typedef float f32x2 __attribute__((ext_vector_type(2)));
typedef unsigned u32x4 __attribute__((ext_vector_type(4)));
typedef unsigned u32x2 __attribute__((ext_vector_type(2)));

#ifndef MK_ONE_LAUNCH
#define MK_ONE_LAUNCH 1
#endif

constexpr int NB = 4, SEQ = 4096, T = NB * SEQ, D = 1024, DEPTH = 4;
constexpr int CWID = 31, NH = 8, DQK = 192, QR = 384, KVR = 256;
constexpr int NE = 16, DE = 512;
constexpr float EPS = 1e-6f;
constexpr float ATTN_SCALE = 0.07216878364870322f;

constexpr size_t MiB = 1u << 20;
constexpr size_t WS_CTL = 0, CTL_BYTES = 1 * MiB;
constexpr size_t WS_MOD = 1 * MiB;
constexpr size_t WS_ROPE = 2 * MiB;
constexpr size_t WS_TOKINFO = 6 * MiB;
constexpr size_t WS_LIST = 7 * MiB;
constexpr size_t WS_WIN = 8 * MiB;
constexpr size_t WS_WOUT = 16 * MiB;
constexpr size_t WS_WDKV = 20 * MiB;
constexpr size_t WS_WUKV = 21 * MiB;
constexpr size_t WS_WDQ = 22 * MiB;
constexpr size_t WS_WUQ = 24 * MiB;
constexpr size_t WS_WO = 27 * MiB;
constexpr size_t WS_WGU = 32 * MiB;
constexpr size_t WS_WDN = 160 * MiB;
constexpr size_t WS_HA = 224 * MiB;
constexpr size_t WS_XKV = 256 * MiB;
constexpr size_t WS_U = 288 * MiB;
constexpr size_t WS_H2 = WS_U;
constexpr size_t WS_V2 = 320 * MiB;
constexpr size_t WS_AO = WS_V2;
constexpr size_t WS_YB = 352 * MiB;
constexpr size_t WS_CQRAW = 352 * MiB;
constexpr size_t WS_CKVRAW = 376 * MiB;
constexpr size_t WS_CQ = 396 * MiB;
constexpr size_t WS_LAT = 408 * MiB;
constexpr size_t WS_KROPE = 424 * MiB;
constexpr size_t WS_Q = 426 * MiB;
constexpr size_t WS_ACT = WS_Q;
constexpr size_t WS_KV = 474 * MiB;
constexpr size_t WS_END = 538 * MiB;
constexpr int NSLOT_MAX = 2 * T + NE * 256;

constexpr int CW_BAR = 4096;
constexpr int CW_CNT = 16384;

constexpr int LDS_BYTES = 147456;
constexpr int LDS_EXTRA = 131072;
constexpr int LDS_MISC = LDS_EXTRA + 320;
constexpr int LDS_TB = LDS_EXTRA + 512;
constexpr int LDS_TOK = LDS_EXTRA + 1024;
constexpr int NTHREADS = 512;

#define XB_TMO      128
#define XB_XCNT(j)  (256  + 64 * (j))
#define XB_XSUB(j)  (1280 + 64 * (j))
#define XB_XGEN(j)  (2304 + 64 * (j))
#define XB_TOP      3328
#define XB_TOPGEN   3392
#define XCD_BAR_WORDS 3456
#define XB_SPIN_CAP (1u << 18)

__device__ __forceinline__ unsigned xb_ld(unsigned* p)              { return __hip_atomic_load(p, __ATOMIC_RELAXED, __HIP_MEMORY_SCOPE_AGENT); }
__device__ __forceinline__ unsigned xb_add(unsigned* p, unsigned v) { return __hip_atomic_fetch_add(p, v, __ATOMIC_RELAXED, __HIP_MEMORY_SCOPE_AGENT); }
__device__ __forceinline__ unsigned xb_xcc_id() { return (unsigned)__builtin_amdgcn_s_getreg((3 << 11) | 20) & 0xFu; }
#define XB_SPIN(cond, bar) do { unsigned _sp = 0; while (cond) { __builtin_amdgcn_s_sleep(1); \
    if ((++_sp & 255u) == 0u) { if (xb_ld(&(bar)[XB_TMO])) break; if (_sp > XB_SPIN_CAP) { atomicAdd(&(bar)[XB_TMO], 1u); break; } } } } while (0)

struct XcdBarrier { unsigned* bar; unsigned x; volatile LAS unsigned* st; };

__device__ __forceinline__ XcdBarrier xcd_barrier_post(unsigned* bar, volatile LAS unsigned* st) {
    XcdBarrier b; b.bar = bar; b.x = xb_xcc_id(); b.st = st;
    if (threadIdx.x == 0) (void)xb_add(&bar[XB_XCNT(b.x)], 1u);
    return b;
}
__device__ __forceinline__ void xcd_barrier_complete(unsigned* bar, unsigned x, unsigned& nloc, unsigned& nx) {
    const unsigned G = gridDim.x * gridDim.y * gridDim.z;
    unsigned sum, cnt, mine, sp = 0u;
    for (;;) {
        sum = 0u; cnt = 0u; mine = 0u;
#pragma unroll
        for (unsigned j = 0; j < 16; ++j) { const unsigned c = xb_ld(&bar[XB_XCNT(j)]); sum += c; cnt += (c > 0u) ? 1u : 0u; mine = (j == x) ? c : mine; }
        if (sum == G) break;
        __builtin_amdgcn_s_sleep(1);
        if ((++sp & 255u) == 0u) { if (xb_ld(&bar[XB_TMO])) break; if (sp > XB_SPIN_CAP) { atomicAdd(&bar[XB_TMO], 1u); break; } }
    }
    nloc = mine > 0u ? mine : 1u; nx = cnt > 0u ? cnt : 1u;
}
__device__ __forceinline__ void xcd_barrier(const XcdBarrier& b, bool leader) {
    asm volatile("s_waitcnt vmcnt(0)" ::: "memory");
    __syncthreads();
    if (leader) {
        unsigned* bar = b.bar;
        __builtin_amdgcn_s_waitcnt(0);
        unsigned nloc = b.st[0], nx = b.st[1];
        if (nloc == 0u) { xcd_barrier_complete(bar, b.x, nloc, nx); b.st[0] = nloc; b.st[1] = nx; }
        const unsigned old = xb_add(&bar[XB_XSUB(b.x)], 1u);
        const unsigned gen = old / nloc;
        if (old + 1u == (gen + 1u) * nloc) {
            __builtin_amdgcn_fence(__ATOMIC_RELEASE, "agent");
            asm volatile("s_waitcnt vmcnt(0)" ::: "memory");
            const unsigned og = xb_add(&bar[XB_TOP], 1u);
            const unsigned tg = og / nx;
            if (og + 1u == (tg + 1u) * nx) xb_add(&bar[XB_TOPGEN], 1u);
            else XB_SPIN(xb_ld(&bar[XB_TOPGEN]) == tg, bar);
            __builtin_amdgcn_fence(__ATOMIC_ACQUIRE, "agent");
            xb_add(&bar[XB_XGEN(b.x)], 1u);
            asm volatile("s_waitcnt vmcnt(0)" ::: "memory");
        } else {
            XB_SPIN(xb_ld(&bar[XB_XGEN(b.x)]) == gen, bar);
            __builtin_amdgcn_fence(__ATOMIC_ACQUIRE, "agent");
            asm volatile("s_waitcnt vmcnt(0)" ::: "memory");
        }
    }
    __syncthreads();
}

__device__ __forceinline__ unsigned f2bf(float f) { unsigned u = __builtin_bit_cast(unsigned, f); return (u + 0x7fffu + ((u >> 16) & 1u)) >> 16; }
__device__ __forceinline__ unsigned pk2(float lo, float hi) { unsigned r; asm("v_cvt_pk_bf16_f32 %0, %1, %2" : "=v"(r) : "v"(lo), "v"(hi)); return r; }
__device__ __forceinline__ float bf2f(unsigned short b) { return __builtin_bit_cast(float, (unsigned)b << 16); }
__device__ __forceinline__ float bflo(unsigned w) { return __builtin_bit_cast(float, w << 16); }
__device__ __forceinline__ float bfhi(unsigned w) { return __builtin_bit_cast(float, w & 0xffff0000u); }
__device__ __forceinline__ void swap32(float v, float& a, float& b) { unsigned x = __builtin_bit_cast(unsigned, v), y = x; asm volatile("" : "+v"(y));
    auto rr = __builtin_amdgcn_permlane32_swap(x, y, false, false); unsigned a_ = rr[0], b_ = rr[1]; asm volatile("" : "+v"(a_), "+v"(b_)); a = __builtin_bit_cast(float, a_); b = __builtin_bit_cast(float, b_); }
__device__ __forceinline__ void swap16(float v, float& a, float& b) { unsigned x = __builtin_bit_cast(unsigned, v), y = x; asm volatile("" : "+v"(y));
    auto rr = __builtin_amdgcn_permlane16_swap(x, y, false, false); unsigned a_ = rr[0], b_ = rr[1]; asm volatile("" : "+v"(a_), "+v"(b_)); a = __builtin_bit_cast(float, a_); b = __builtin_bit_cast(float, b_); }
__device__ __forceinline__ void swap32x(float d, float s_, float& a, float& b) { unsigned x = __builtin_bit_cast(unsigned, d), y = __builtin_bit_cast(unsigned, s_);
    auto rr = __builtin_amdgcn_permlane32_swap(x, y, false, false); unsigned a_ = rr[0], b_ = rr[1]; asm volatile("" : "+v"(a_), "+v"(b_)); a = __builtin_bit_cast(float, a_); b = __builtin_bit_cast(float, b_); }
__device__ __forceinline__ void swap16x(float d, float s_, float& a, float& b) { unsigned x = __builtin_bit_cast(unsigned, d), y = __builtin_bit_cast(unsigned, s_);
    auto rr = __builtin_amdgcn_permlane16_swap(x, y, false, false); unsigned a_ = rr[0], b_ = rr[1]; asm volatile("" : "+v"(a_), "+v"(b_)); a = __builtin_bit_cast(float, a_); b = __builtin_bit_cast(float, b_); }
__device__ __forceinline__ float row16_sum(float v);
__device__ __forceinline__ float dpp_add(float v, int ctrl_sel) {
    int r;
    if (ctrl_sel == 0) r = __builtin_amdgcn_update_dpp(0, __builtin_bit_cast(int, v), 0xB1, 0xf, 0xf, true);
    else if (ctrl_sel == 1) r = __builtin_amdgcn_update_dpp(0, __builtin_bit_cast(int, v), 0x4E, 0xf, 0xf, true);
    else if (ctrl_sel == 2) r = __builtin_amdgcn_update_dpp(0, __builtin_bit_cast(int, v), 0x141, 0xf, 0xf, true);
    else r = __builtin_amdgcn_update_dpp(0, __builtin_bit_cast(int, v), 0x140, 0xf, 0xf, true);
    return v + __builtin_bit_cast(float, r);
}
__device__ __forceinline__ float row16_sum(float v) { v = dpp_add(v, 0); v = dpp_add(v, 1); v = dpp_add(v, 2); v = dpp_add(v, 3); return v; }
__device__ __forceinline__ float wave_sum(float v) {
    v = dpp_add(v, 0); v = dpp_add(v, 1); v = dpp_add(v, 2); v = dpp_add(v, 3);
    float a, b; swap16(v, a, b); v = a + b; swap32(v, a, b); v = a + b;
    return v;
}
__device__ __forceinline__ float sigmoidf_(float x) { return 1.0f / (1.0f + __expf(-x)); }
__device__ __forceinline__ float siluf_(float x) { return x / (1.0f + __expf(-x)); }

struct Args { const void* in[28]; float* out; unsigned char* ws; int ph_lo, ph_hi; };
__device__ __forceinline__ int otid(int wv) { int t; asm volatile("v_mbcnt_lo_u32_b32 %0, -1, 0\n\tv_mbcnt_hi_u32_b32 %0, -1, %0" : "=v"(t)); return (wv << 6) + t; }
#define CAS __attribute__((address_space(4)))
__device__ __forceinline__ Args oargs() {
    const CAS Args* q = (const CAS Args*)__builtin_amdgcn_kernarg_segment_ptr(); asm volatile("" : "+s"(q));
    Args r;
#pragma unroll
    for (int i = 0; i < 28; ++i) r.in[i] = q->in[i];
    r.out = q->out; r.ws = q->ws; r.ph_lo = q->ph_lo; r.ph_hi = q->ph_hi; return r;
}
template <class P> __device__ __forceinline__ P* opq(P* p) { asm volatile("" : "+s"(p)); return p; }

namespace pg8 {
#define PG8_LAS __attribute__((address_space(3)))
constexpr int BM = 256, BK = 64, HALF = 128, HTB = HALF * BK * 2, STAGE_BYTES = 8 * HTB, NXCD = 8, WGM = 8;
__host__ __device__ __forceinline__ int lds_byte(int r, int c) { const int st = (r >> 4) * 2 + (c >> 5), rr = r & 15, cc = c & 31, ob = rr * 64 + cc * 2; return st * 1024 + (ob ^ (((ob >> 9) & 1) << 5)); }
__host__ __device__ __forceinline__ void stage_rc(int b, int& R, int& C) { const int st = b / 1024, sb = b % 1024, swz = sb ^ (((sb >> 9) & 1) << 5); R = (st >> 1) * 16 + swz / 64; C = (st & 1) * 32 + (swz % 64) / 2; }
__host__ __device__ __forceinline__ int perm32(int rho) { const int n = rho >> 4, i = rho & 15; return 8 * (i >> 2) + 4 * n + (i & 3); }
struct Unit { int pm, pn; };
struct Gemm { const bf16_t* A; const bf16_t* Bt; int M, N, K; };
struct StaticOrder {
    int nM, nN, nwg, G, c;
    __host__ __device__ void init(int M, int N, int G_, int c_) { nM = M / BM; nN = N / BM; nwg = nM * nN; G = G_; c = c_; }
    __host__ __device__ bool next(int i, Unit& u) const {
        const long L = (long)i * G + c; if (L >= nwg) return false;
        int wgid = (int)L; { const int q = nwg / NXCD, r = nwg % NXCD, xcd = wgid % NXCD, off = wgid / NXCD; wgid = (xcd < r ? xcd * (q + 1) : r * (q + 1) + (xcd - r) * q) + off; }
        const int nig = WGM * nN, gid = wgid / nig, fm = gid * WGM, gsz = (nM - fm) < WGM ? (nM - fm) : WGM;
        u.pm = fm + ((wgid % nig) % gsz); u.pn = (wgid % nig) / gsz; return true;
    }
    __device__ __forceinline__ const PG8_LAS int* tok(int) const { return nullptr; }
};
struct MoeOrder {
    const PG8_LAS int* ul; const PG8_LAS int* toks;
    __device__ __forceinline__ bool next(int i, Unit& u) const {
        if (i >= __builtin_amdgcn_readfirstlane(ul[0])) return false;
        u.pm = __builtin_amdgcn_readfirstlane(ul[2 + 2 * i]); u.pn = __builtin_amdgcn_readfirstlane(ul[3 + 2 * i]); return true;
    }
    __device__ __forceinline__ const PG8_LAS int* tok(int ui) const { return toks + ui * 256; }
};
__device__ __forceinline__ void moe_unit_list(int wv, const PG8_LAS int* tb, PG8_LAS int* ul) {
    if (otid(wv) == 0) { const int G = gridDim.x, c = blockIdx.x, x = c & 7, idx = c >> 3; int n = 0;
        for (int i = 0; i < 12; ++i) { const int rt = i * (G >> 2) + (idx >> 2) * 8 + x; if (rt >= tb[16]) break;
            int e = 0; for (int q = 1; q < 16; ++q) e += (rt >= tb[q]) ? 1 : 0;
            ul[2 + 2 * n] = rt; ul[3 + 2 * n] = e * 4 + (idx & 3); ++n; }
        ul[0] = n; }
    __syncthreads();
}

template <class Epi, class Sched, bool ALIGN_EPI = false, bool SP2 = false, bool GATHER = false>
__device__ __forceinline__ void gemm_phase(PG8_LAS unsigned char* lds, int wv, const Gemm g, const Sched& S, const Epi& E) {
    const int tid = otid(wv), wid = __builtin_amdgcn_readfirstlane(tid >> 6), lane = tid & 63, wr = wid >> 2, wc = wid & 3, fr = lane & 15, fq = lane >> 4;
    int K_ = g.K; asm volatile("" : "+s"(K_));
    const int K = K_, nt = K / BK;
    unsigned voffA[2], voffB[2];
#pragma unroll
    for (int i = 0; i < 2; ++i) { int R, C; stage_rc(tid * 16 + i * 8192, R, C); const int Rb = Epi::PERM ? ((R & ~31) + perm32(R & 31)) : R;
        voffA[i] = (unsigned)(R * K + C) * 2u; voffB[i] = (unsigned)(Rb * K + C) * 2u; }
    const size_t kstep = (size_t)(BK * 2);
    const size_t hstep = (size_t)HALF * K * 2;
    const size_t tstep = 2 * hstep;
    const unsigned ldsw = (unsigned)wid * 1024u;
    const int aoff = lds_byte(wr * 64 + fr, fq * 8), boff = lds_byte(wc * 32 + fr, fq * 8);
#define PG8_SA(b, h) (((b) * 2 + (h)) * HTB)
#define PG8_SB(b, h) ((4 + (b) * 2 + (h)) * HTB)
#define PG8_STAGE(bufoff, gbase, voff) do { _Pragma("unroll") for (int _i = 0; _i < 2; ++_i) \
        __builtin_amdgcn_global_load_lds((const unsigned*)((const char*)(gbase) + (voff)[_i]), (PG8_LAS unsigned*)(lds + (bufoff) + ldsw + _i * 8192), 16, 0, 0); } while (0)
#define PG8_STAGE_A(bufoff, gbase, hh, VO) do { if constexpr (GATHER) { PG8_STAGE(bufoff, gbase, VO[hh]); } else { PG8_STAGE(bufoff, (gbase) + (hh) * hstep, voffA); } } while (0)
#define PG8_LDA(dst, b, h) do { _Pragma("unroll") for (int m = 0; m < 4; ++m) _Pragma("unroll") for (int k = 0; k < 2; ++k) dst[m][k] = *(const PG8_LAS bf16x8*)(lds + PG8_SA(b, h) + aoff + m * 2048 + k * 1024); } while (0)
#define PG8_LDB(dst, b, h) do { _Pragma("unroll") for (int n = 0; n < 2; ++n) _Pragma("unroll") for (int k = 0; k < 2; ++k) dst[n][k] = *(const PG8_LAS bf16x8*)(lds + PG8_SB(b, h) + boff + n * 2048 + k * 1024); } while (0)
#define PG8_MMA(ai, bj, At, Bt) do { __builtin_amdgcn_s_setprio(1); _Pragma("unroll") for (int m = 0; m < 4; ++m) _Pragma("unroll") for (int n = 0; n < 2; ++n) _Pragma("unroll") for (int k = 0; k < 2; ++k) \
        acc[ai][bj][m][n] = __builtin_amdgcn_mfma_f32_16x16x32_bf16(Bt[n][k], At[m][k], acc[ai][bj][m][n], 0, 0, 0); __builtin_amdgcn_s_setprio(0); } while (0)
#define PG8_WAIT_V(n) asm volatile("s_waitcnt vmcnt(" #n ")" ::: "memory")
#define PG8_WAIT_L(n) asm volatile("s_waitcnt lgkmcnt(" #n ")" ::: "memory")
#define PG8_BAR __builtin_amdgcn_s_barrier()
#define PG8_SCHED __builtin_amdgcn_sched_barrier(0)
#define PG8_GOFF(dst, tk) do { _Pragma("unroll") for (int _i = 0; _i < 2; ++_i) { int _R, _C; stage_rc(tid * 16 + _i * 8192, _R, _C); _Pragma("unroll") for (int _h = 0; _h < 2; ++_h) dst[_h][_i] = (unsigned)((tk)[_h * 128 + _R] * K + _C) * 2u; } } while (0)
    Unit cur, nxt; int ui = 0;
    if (!S.next(0, cur)) return;
    f32x4 acc[2][2][4][2];
#pragma unroll
    for (int a = 0; a < 2; ++a)
#pragma unroll
        for (int b = 0; b < 2; ++b)
#pragma unroll
            for (int m = 0; m < 4; ++m)
#pragma unroll
                for (int n = 0; n < 2; ++n) acc[a][b][m][n] = (f32x4){0.f, 0.f, 0.f, 0.f};
    bf16x8 At[4][2], B0[2][2], B1[2][2];
    unsigned gA[2][2] = {{0u, 0u}, {0u, 0u}}, gAn[2][2] = {{0u, 0u}, {0u, 0u}}, gS[2][2] = {{0u, 0u}, {0u, 0u}};
    if constexpr (GATHER) { PG8_GOFF(gA, S.tok(0)); }
    const char* cA = GATHER ? (const char*)g.A : (const char*)g.A + (size_t)cur.pm * tstep; const char* cB = (const char*)g.Bt + (size_t)cur.pn * tstep;
    if constexpr (SP2) {
        PG8_STAGE(PG8_SB(0, 0), cB, voffB); PG8_STAGE(PG8_SB(0, 1), cB + hstep, voffB); PG8_STAGE_A(PG8_SA(0, 0), cA, 0, gA); PG8_STAGE_A(PG8_SA(0, 1), cA, 1, gA);
        if (wr == 1) PG8_BAR;
        PG8_WAIT_V(2); PG8_BAR;
        PG8_STAGE(PG8_SB(1, 0), cB + kstep, voffB); PG8_STAGE_A(PG8_SA(1, 0), cA + kstep, 0, gA); PG8_STAGE(PG8_SB(1, 1), cB + hstep + kstep, voffB);
        PG8_WAIT_V(6); PG8_BAR;
    } else {
        PG8_STAGE(PG8_SB(0, 0), cB, voffB); PG8_STAGE_A(PG8_SA(0, 0), cA, 0, gA); PG8_STAGE(PG8_SB(0, 1), cB + hstep, voffB); PG8_STAGE_A(PG8_SA(0, 1), cA, 1, gA);
        if (wr == 1) PG8_BAR;
        PG8_WAIT_V(4); PG8_BAR;
        PG8_STAGE(PG8_SB(1, 0), cB + kstep, voffB); PG8_STAGE_A(PG8_SA(1, 0), cA + kstep, 0, gA); PG8_STAGE(PG8_SB(1, 1), cB + hstep + kstep, voffB);
        PG8_WAIT_V(6); PG8_BAR;
    }
    for (;;) {
        const bool has_next = S.next(ui + 1, nxt);
        const char* nA = GATHER ? (const char*)g.A : (has_next ? (const char*)g.A + (size_t)nxt.pm * tstep : cA); const char* nB = has_next ? (const char*)g.Bt + (size_t)nxt.pn * tstep : cB;
        if constexpr (GATHER) { if (has_next) { PG8_GOFF(gAn, S.tok(ui + 1)); } else {
#pragma unroll
            for (int _h = 0; _h < 2; ++_h)
#pragma unroll
                for (int _i = 0; _i < 2; ++_i) gAn[_h][_i] = gA[_h][_i]; } }
        for (int t = 0; t < nt; t += 2) {
            const bool last = (t == nt - 2);
            const char* a1 = cA + (size_t)(t + 1) * kstep;
            const char* a2 = last ? nA : cA + (size_t)(t + 2) * kstep; const char* b2 = last ? nB : cB + (size_t)(t + 2) * kstep;
            const char* a3 = a2 + kstep; const char* b3 = b2 + kstep;
            if constexpr (GATHER) {
#pragma unroll
                for (int _h = 0; _h < 2; ++_h)
#pragma unroll
                    for (int _i = 0; _i < 2; ++_i) gS[_h][_i] = last ? gAn[_h][_i] : gA[_h][_i]; }
            if constexpr (SP2) {
            PG8_LDB(B0, 0, 0); PG8_LDB(B1, 0, 1); PG8_SCHED; PG8_LDA(At, 0, 0); PG8_STAGE_A(PG8_SA(1, 1), a1, 1, gA);
            PG8_WAIT_V(8); PG8_WAIT_L(0); PG8_BAR; PG8_MMA(0, 0, At, B0); PG8_MMA(0, 1, At, B1); PG8_BAR; PG8_SCHED;
            PG8_LDA(At, 0, 1); PG8_STAGE(PG8_SB(0, 0), b2, voffB); PG8_STAGE(PG8_SB(0, 1), b2 + hstep, voffB); PG8_STAGE_A(PG8_SA(0, 0), a2, 0, gS);
            PG8_WAIT_V(8); PG8_WAIT_L(0); PG8_BAR; PG8_MMA(1, 0, At, B0); PG8_MMA(1, 1, At, B1); PG8_BAR; PG8_SCHED;
            PG8_LDB(B0, 1, 0); PG8_LDB(B1, 1, 1); PG8_SCHED; PG8_LDA(At, 1, 0); PG8_STAGE_A(PG8_SA(0, 1), a2, 1, gS);
            PG8_WAIT_V(8); PG8_WAIT_L(0); PG8_BAR; PG8_MMA(0, 0, At, B0); PG8_MMA(0, 1, At, B1); PG8_BAR; PG8_SCHED;
            PG8_LDA(At, 1, 1); PG8_STAGE(PG8_SB(1, 0), b3, voffB); PG8_STAGE(PG8_SB(1, 1), b3 + hstep, voffB); PG8_STAGE_A(PG8_SA(1, 0), a3, 0, gS);
            PG8_WAIT_V(8); PG8_WAIT_L(0); PG8_BAR; PG8_MMA(1, 0, At, B0); PG8_MMA(1, 1, At, B1); PG8_BAR; PG8_SCHED;
            } else {
            PG8_LDB(B0, 0, 0); PG8_SCHED; PG8_LDA(At, 0, 0); PG8_STAGE_A(PG8_SA(1, 1), a1, 1, gA);
            PG8_WAIT_L(8); PG8_BAR; PG8_WAIT_L(0); PG8_MMA(0, 0, At, B0); PG8_BAR; PG8_SCHED;
            PG8_LDB(B1, 0, 1); PG8_STAGE(PG8_SB(0, 0), b2, voffB);
            PG8_BAR; PG8_WAIT_L(0); PG8_MMA(0, 1, At, B1); PG8_BAR;
            PG8_LDA(At, 0, 1); PG8_STAGE_A(PG8_SA(0, 0), a2, 0, gS);
            PG8_BAR; PG8_WAIT_L(0); PG8_MMA(1, 0, At, B0); PG8_BAR; PG8_SCHED;
            PG8_STAGE(PG8_SB(0, 1), b2 + hstep, voffB);
            PG8_WAIT_V(6); PG8_BAR; PG8_MMA(1, 1, At, B1); PG8_BAR;
            PG8_LDB(B0, 1, 0); PG8_SCHED; PG8_LDA(At, 1, 0); PG8_STAGE_A(PG8_SA(0, 1), a2, 1, gS);
            PG8_WAIT_L(8); PG8_BAR; PG8_WAIT_L(0); PG8_MMA(0, 0, At, B0); PG8_BAR; PG8_SCHED;
            PG8_LDB(B1, 1, 1); PG8_STAGE(PG8_SB(1, 0), b3, voffB);
            PG8_BAR; PG8_WAIT_L(0); PG8_MMA(0, 1, At, B1); PG8_BAR;
            PG8_LDA(At, 1, 1); PG8_STAGE_A(PG8_SA(1, 0), a3, 0, gS);
            PG8_BAR; PG8_WAIT_L(0); PG8_MMA(1, 0, At, B0); PG8_BAR; PG8_SCHED;
            PG8_STAGE(PG8_SB(1, 1), b3 + hstep, voffB);
            PG8_WAIT_V(6); PG8_BAR; PG8_MMA(1, 1, At, B1); PG8_BAR;
            }
        }
        if constexpr (ALIGN_EPI) { if (wr == 0) PG8_BAR; }
        E(acc, cur, wr, wc, fr, fq);
        if (!has_next) break;
#pragma unroll
        for (int a = 0; a < 2; ++a)
#pragma unroll
            for (int b = 0; b < 2; ++b)
#pragma unroll
                for (int m = 0; m < 4; ++m)
#pragma unroll
                    for (int n = 0; n < 2; ++n) acc[a][b][m][n] = (f32x4){0.f, 0.f, 0.f, 0.f};
        cur = nxt; cA = nA; cB = nB; ++ui;
        if constexpr (GATHER) {
#pragma unroll
            for (int _h = 0; _h < 2; ++_h)
#pragma unroll
                for (int _i = 0; _i < 2; ++_i) gA[_h][_i] = gAn[_h][_i]; }
        if constexpr (ALIGN_EPI) { if (wr == 1) PG8_BAR; }
    }
    PG8_WAIT_V(0);
    if constexpr (!ALIGN_EPI) { if (wr == 0) PG8_BAR; }
    PG8_BAR;
#undef PG8_SA
#undef PG8_SB
#undef PG8_STAGE
#undef PG8_STAGE_A
#undef PG8_LDA
#undef PG8_LDB
#undef PG8_MMA
#undef PG8_WAIT_V
#undef PG8_WAIT_L
#undef PG8_BAR
#undef PG8_SCHED
#undef PG8_GOFF
}
__device__ __forceinline__ unsigned cvt_pk_bf16(float lo, float hi) { unsigned r; asm volatile("v_cvt_pk_bf16_f32 %0, %1, %2" : "=v"(r) : "v"(lo), "v"(hi)); return r; }
struct EpiBf16 {
    static constexpr bool PERM = true;
    bf16_t* O; int ldc, pnmask;
    __device__ __forceinline__ void operator()(const f32x4 (&acc)[2][2][4][2], const Unit& u, int wr, int wc, int fr, int fq) const {
        const int row0 = u.pm * BM + wr * 64 + fr, col0 = (u.pn & pnmask) * BM + wc * 32 + 8 * fq;
#pragma unroll
        for (int ai = 0; ai < 2; ++ai)
#pragma unroll
            for (int m = 0; m < 4; ++m) { bf16_t* rowp = O + (size_t)(row0 + ai * HALF + m * 16) * ldc + col0;
#pragma unroll
                for (int bj = 0; bj < 2; ++bj) { const f32x4 v0 = acc[ai][bj][m][0], v1 = acc[ai][bj][m][1];
                    u32x4 w; w.x = cvt_pk_bf16(v0[0], v0[1]); w.y = cvt_pk_bf16(v0[2], v0[3]); w.z = cvt_pk_bf16(v1[0], v1[1]); w.w = cvt_pk_bf16(v1[2], v1[3]);
                    *(u32x4*)(rowp + bj * HALF) = w; } }
    }
};
template <int MODE  > struct EpiGated {
    static constexpr bool PERM = true;
    bf16_t* O; int ldc, pnmask; const float* bias;
    __device__ __forceinline__ void operator()(const f32x4 (&acc)[2][2][4][2], const Unit& u, int wr, int wc, int fr, int fq) const {
        const int row0 = u.pm * BM + wr * 64 + fr, ch0 = (u.pn & pnmask) * HALF + wc * 32 + 8 * fq;
        f32x4 ba[2], bg[2];
#pragma unroll
        for (int n = 0; n < 2; ++n) { ba[n] = (f32x4){0.f, 0.f, 0.f, 0.f}; bg[n] = ba[n]; if (MODE == 0) { ba[n] = *(const f32x4*)(bias + ch0 + 4 * n); bg[n] = *(const f32x4*)(bias + 1024 + ch0 + 4 * n); } }
#pragma unroll
        for (int ai = 0; ai < 2; ++ai)
#pragma unroll
            for (int m = 0; m < 4; ++m) { float r[8];
#pragma unroll
                for (int n = 0; n < 2; ++n) { const f32x4 x = acc[ai][0][m][n] + ba[n], y = acc[ai][1][m][n] + bg[n];
#pragma unroll
                    for (int q = 0; q < 4; ++q) r[4 * n + q] = (MODE == 0) ? x[q] * sigmoidf_(y[q]) : siluf_(x[q]) * y[q]; }
                u32x4 w; w.x = cvt_pk_bf16(r[0], r[1]); w.y = cvt_pk_bf16(r[2], r[3]); w.z = cvt_pk_bf16(r[4], r[5]); w.w = cvt_pk_bf16(r[6], r[7]);
                *(u32x4*)(O + (size_t)(row0 + ai * HALF + m * 16) * ldc + ch0) = w; }
    }
};
struct EpiResid {
    static constexpr bool PERM = false;
    float* X; const float* gate;
    __device__ __forceinline__ void operator()(const f32x4 (&acc)[2][2][4][2], const Unit& u, int wr, int wc, int fr, int fq) const {
        const int row0 = u.pm * BM + wr * 64 + fr, col0 = u.pn * BM + wc * 32 + 4 * fq; const float* gp = gate + (size_t)((u.pm * BM) / SEQ) * 6144 + col0;
#pragma unroll
        for (int bj = 0; bj < 2; ++bj)
#pragma unroll
            for (int n = 0; n < 2; ++n) { const f32x4 gv = *(const f32x4*)(gp + bj * HALF + n * 16);
#pragma unroll
                for (int ai = 0; ai < 2; ++ai)
#pragma unroll
                    for (int m = 0; m < 4; ++m) { float* p = X + (size_t)(row0 + ai * HALF + m * 16) * D + col0 + bj * HALF + n * 16; *(f32x4*)p = *(const f32x4*)p + gv * acc[ai][bj][m][n]; } }
    }
};
struct EpiF32 {
    static constexpr bool PERM = false;
    float* O; int ldc, ncols;
    __device__ __forceinline__ void operator()(const f32x4 (&acc)[2][2][4][2], const Unit& u, int wr, int wc, int fr, int fq) const {
        const int row0 = u.pm * BM + wr * 64 + fr, col0 = u.pn * BM + wc * 32 + 4 * fq;
#pragma unroll
        for (int bj = 0; bj < 2; ++bj)
#pragma unroll
            for (int n = 0; n < 2; ++n) { const int c = col0 + bj * HALF + n * 16;
                if (c < ncols) {
#pragma unroll
                    for (int ai = 0; ai < 2; ++ai)
#pragma unroll
                        for (int m = 0; m < 4; ++m) *(f32x4*)(O + (size_t)(row0 + ai * HALF + m * 16) * ldc + c) = acc[ai][bj][m][n]; } }
    }
};
}

__device__ __forceinline__ int pair_row(int ch, int half) { return (ch >> 7) * 256 + half * 128 + (ch & 127); }

template <int MODE>
__device__ __forceinline__ void cvt_item(const float* W, int K, int N, int ld, bf16_t* WT, int row_off_or_half, LAS float* scr, int item, int lane) {
    const int nblk = N / 32, kb = item / nblk, nb = item % nblk, k0 = 64 * kb, n0 = 32 * nb;
#pragma unroll 8
    for (int i = 0; i < 32; ++i) { const int kk = 2 * i + (lane >> 5); scr[kk * 33 + (lane & 31)] = W[(size_t)(k0 + kk) * ld + n0 + (lane & 31)]; }
    asm volatile("s_waitcnt lgkmcnt(0)" ::: "memory");
    const int c = lane & 7;
#pragma unroll
    for (int j = 0; j < 4; ++j) { const int n = (lane >> 3) + 8 * j; const LAS float* s = scr + (8 * c) * 33 + n;
        u32x4 o; o.x = pk2(s[0 * 33], s[1 * 33]); o.y = pk2(s[2 * 33], s[3 * 33]); o.z = pk2(s[4 * 33], s[5 * 33]); o.w = pk2(s[6 * 33], s[7 * 33]);
        const int drow = (MODE == 0) ? (row_off_or_half + n0 + n) : pair_row(n0 + n, row_off_or_half);
        *(u32x4*)(WT + (size_t)drow * K + k0 + 8 * c) = o; }
    asm volatile("s_waitcnt lgkmcnt(0)" ::: "memory");
}

__device__ __forceinline__ void phase_prologue(LAS unsigned char* lds, int wv) {
    const Args a = oargs();
    const int tid = otid(wv), lane = tid & 63, wave = tid >> 6, G = gridDim.x;
    unsigned char* ws = a.ws;
    {
        const float* c = (const float*)a.in[1]; const float* ada_w = (const float*)a.in[3]; const float* ada_b = (const float*)a.in[4];
        float* mod = (float*)(ws + WS_MOD);
        LAS float* cs = (LAS float*)lds;
        LAS float* red = cs + 4096;
        bool have = false;
        for (int it = blockIdx.x; it < 4 * 48; it += G) {
            if (!have) { for (int i = tid; i < 4096; i += NTHREADS) cs[i] = siluf_(c[i]); have = true; }
            __syncthreads();
            const int l = it / 48, n0 = (it % 48) * 128;
            const float* wp = ada_w + (size_t)l * D * 6144 + n0 + 2 * lane;
            float acc[4][2] = {{0.f, 0.f}, {0.f, 0.f}, {0.f, 0.f}, {0.f, 0.f}};
            const int kb = wave * 128;
#pragma unroll 4
            for (int k = 0; k < 128; ++k) {
                const f32x2 w = *(const f32x2*)(wp + (size_t)(kb + k) * 6144);
#pragma unroll
                for (int b = 0; b < 4; ++b) { const float cv = cs[b * 1024 + kb + k]; acc[b][0] += cv * w.x; acc[b][1] += cv * w.y; }
            }
#pragma unroll
            for (int b = 0; b < 4; ++b) { red[(wave * 4 + b) * 128 + 2 * lane] = acc[b][0]; red[(wave * 4 + b) * 128 + 2 * lane + 1] = acc[b][1]; }
            __syncthreads();
            { const int b = tid >> 7, col = tid & 127; float s = 0.f;
#pragma unroll
              for (int w = 0; w < 8; ++w) s += red[(w * 4 + b) * 128 + col];
              mod[((size_t)l * 4 + b) * 6144 + n0 + col] = s + ada_b[l * 6144 + n0 + col]; }
        }
        __syncthreads();
    }
    {
        const int* pos = (const int*)a.in[2]; f32x2* rt = (f32x2*)(ws + WS_ROPE);
        for (int idx = blockIdx.x * NTHREADS + tid; idx < T * 32; idx += G * NTHREADS) {
            const int t = idx >> 5, i = idx & 31;
            const float inv = exp2f(-(float)i * (13.287712379549449f / 32.0f));
            const float ang = (float)pos[t] * inv;
            const float kf = rintf(ang * 0.15915494309189535f);
            float r = fmaf(-kf, 6.28125f, ang); r = fmaf(-kf, 1.9353071795864769e-3f, r);
            rt[idx] = (f32x2){__cosf(r), __sinf(r)};
        }
    }
    {
        LAS float* scr = (LAS float*)(lds + wave * 16384);
        const int gw = blockIdx.x * 8 + wave, NGW = G * 8;
        const float* w_in = (const float*)a.in[7]; const float* w_out = (const float*)a.in[13]; const float* w_dkv = (const float*)a.in[15]; const float* w_ukv = (const float*)a.in[17];
        const float* w_dq = (const float*)a.in[18]; const float* w_uq = (const float*)a.in[20]; const float* w_o = (const float*)a.in[21];
        const float* wg = (const float*)a.in[24]; const float* wu = (const float*)a.in[25]; const float* wd = (const float*)a.in[26];
        constexpr int I_IN = 16 * 64, I_OUT = 16 * 32, I_DKV = 16 * 10, I_UKV = 4 * 64, I_DQ = 16 * 12, I_UQ = 6 * 48, I_O = 16 * 32;
        constexpr int I_G = 16 * 16, I_D = 8 * 32;
        constexpr int NSMALL = 2 * I_IN + 2 * I_OUT + I_DKV + I_UKV + 2 * I_DQ + 2 * I_UQ + 2 * I_O;
        constexpr int NEXP = 4 * 16 * (2 * I_G + I_D);
        for (int it = gw; it < NSMALL + NEXP; it += NGW) {
            int r = it;
            if (r < 2 * I_IN) { const int l = r / I_IN; r %= I_IN; const int half = r / 512;
                cvt_item<1>(w_in + (size_t)l * D * 2048 + half * 1024, D, 1024, 2048, (bf16_t*)(ws + WS_WIN) + (size_t)l * 2048 * 1024, half, scr, r % 512, lane); continue; }
            r -= 2 * I_IN;
            if (r < 2 * I_OUT) { const int l = r / I_OUT; cvt_item<0>(w_out + (size_t)l * D * D, D, D, D, (bf16_t*)(ws + WS_WOUT) + (size_t)l * D * D, 0, scr, r % I_OUT, lane); continue; }
            r -= 2 * I_OUT;
            if (r < I_DKV) { cvt_item<0>(w_dkv, D, 320, 320, (bf16_t*)(ws + WS_WDKV), 0, scr, r, lane); continue; }
            r -= I_DKV;
            if (r < I_UKV) { cvt_item<0>(w_ukv, KVR, 2048, 2048, (bf16_t*)(ws + WS_WUKV), 0, scr, r, lane); continue; }
            r -= I_UKV;
            if (r < 2 * I_DQ) { const int j = r / I_DQ; cvt_item<0>(w_dq + (size_t)j * D * QR, D, QR, QR, (bf16_t*)(ws + WS_WDQ) + (size_t)j * 512 * D, 0, scr, r % I_DQ, lane); continue; }
            r -= 2 * I_DQ;
            if (r < 2 * I_UQ) { const int j = r / I_UQ; cvt_item<0>(w_uq + (size_t)j * QR * 1536, QR, 1536, 1536, (bf16_t*)(ws + WS_WUQ) + (size_t)j * 1536 * QR, 0, scr, r % I_UQ, lane); continue; }
            r -= 2 * I_UQ;
            if (r < 2 * I_O) { const int j = r / I_O; cvt_item<0>(w_o + (size_t)j * D * D, D, D, D, (bf16_t*)(ws + WS_WO) + (size_t)j * D * D, 0, scr, r % I_O, lane); continue; }
            r -= 2 * I_O;
            { const int per = 2 * I_G + I_D; const int le = r / per; r %= per;
              bf16_t* gu = (bf16_t*)(ws + WS_WGU) + (size_t)le * 1024 * 1024; bf16_t* dn = (bf16_t*)(ws + WS_WDN) + (size_t)le * 1024 * 512;
              if (r < I_G) cvt_item<1>(wg + (size_t)le * D * DE, D, DE, DE, gu, 0, scr, r, lane);
              else if (r < 2 * I_G) cvt_item<1>(wu + (size_t)le * D * DE, D, DE, DE, gu, 1, scr, r - I_G, lane);
              else cvt_item<0>(wd + (size_t)le * DE * D, DE, D, D, dn, 0, scr, r - 2 * I_G, lane); }
        }
        { const int gt = blockIdx.x * NTHREADS + tid, NT_ = G * NTHREADS; const u32x4 z = (u32x4){0u, 0u, 0u, 0u};
          u32x4* z0 = (u32x4*)((bf16_t*)(ws + WS_WDKV) + 320 * 1024); for (int i = gt; i < 192 * 1024 * 2 / 16; i += NT_) z0[i] = z;
          for (int j = 0; j < 2; ++j) { u32x4* z1 = (u32x4*)((bf16_t*)(ws + WS_WDQ) + (size_t)j * 512 * 1024 + 384 * 1024); for (int i = gt; i < 128 * 1024 * 2 / 16; i += NT_) z1[i] = z; } }
    }
}

__device__ __forceinline__ void row_load(const float* p, int lane, f32x4 (&v)[4]) {
#pragma unroll
    for (int j = 0; j < 4; ++j) v[j] = *(const f32x4*)(p + 4 * lane + 256 * j);
}
__device__ __forceinline__ float row_rstd(const f32x4 (&v)[4]) {
    float s = 0.f;
#pragma unroll
    for (int j = 0; j < 4; ++j) s += (v[j].x * v[j].x + v[j].y * v[j].y) + (v[j].z * v[j].z + v[j].w * v[j].w);
    return 1.0f / sqrtf(wave_sum(s) * (1.0f / D) + EPS);
}
__device__ __forceinline__ void row_modulate_store(const f32x4 (&v)[4], float r, const float* g, const float* sc, const float* sh, bf16_t* orow, int lane, f32x4 (*hout)[4] = nullptr) {
#pragma unroll
    for (int j = 0; j < 4; ++j) {
        const int c = 4 * lane + 256 * j;
        const f32x4 gv = *(const f32x4*)(g + c);
        f32x4 h = v[j] * r * gv;
        if (sc) { const f32x4 s1 = *(const f32x4*)(sc + c), s0 = *(const f32x4*)(sh + c); h = h * (s1 + 1.0f) + s0; }
        if (hout) (*hout)[j] = h;
        u32x2 o; o.x = pk2(h.x, h.y); o.y = pk2(h.z, h.w);
        *(u32x2*)(orow + c) = o;
    }
}

__device__ __forceinline__ void phase_mod0(int wv) {
    const Args a = oargs();
    const int tid_ = otid(wv); const int lane = tid_ & 63, gw = blockIdx.x * 8 + (tid_ >> 6), NGW = gridDim.x * 8;
    const float* x = (const float*)a.in[0]; const float* g = (const float*)a.in[5]; const float* mod = (const float*)(a.ws + WS_MOD);
    bf16_t* HA = (bf16_t*)(a.ws + WS_HA);
    for (int row = gw; row < T; row += NGW) {
        f32x4 v[4]; row_load(x + (size_t)row * D, lane, v);
#pragma unroll
        for (int j = 0; j < 4; ++j) *(f32x4*)(a.out + (size_t)row * D + 4 * lane + 256 * j) = v[j];
        const float r = row_rstd(v); const int b = row / SEQ;
        row_modulate_store(v, r, g, mod + (size_t)b * 6144 + 1024, mod + (size_t)b * 6144, HA + (size_t)row * D, lane);
    }
}

__device__ __forceinline__ void phase_conv(LAS unsigned char* lds, int wv, int l) {
    const Args a = oargs();
    const int tid = otid(wv), lane = tid & 63, wave = tid >> 6;
    const bf16_t* U = (const bf16_t*)(a.ws + WS_U); bf16_t* V2 = (bf16_t*)(a.ws + WS_V2);
    const float* w_dw = (const float*)a.in[9] + (size_t)l * CWID * D; const float* b_dw = (const float*)a.in[10] + l * D;
    const float* ln_g = (const float*)a.in[11] + l * D; const float* ln_b = (const float*)a.in[12] + l * D;
    constexpr int RC = 16, NR = RC + CWID - 1;
    LAS unsigned* ub = (LAS unsigned*)lds;
    LAS float* red = (LAS float*)(lds + NR * 2048);
    const int c = 2 * tid;
    float w0[CWID], w1[CWID];
#pragma unroll
    for (int j = 0; j < CWID; ++j) { const f32x2 w = *(const f32x2*)(w_dw + (size_t)j * D + c); w0[j] = w.x; w1[j] = w.y; }
    const f32x2 bd = *(const f32x2*)(b_dw + c), lg = *(const f32x2*)(ln_g + c), lb = *(const f32x2*)(ln_b + c);
    for (int it = blockIdx.x; it < T / RC; it += gridDim.x) {
        const int b = it / (SEQ / RC), t0 = (it % (SEQ / RC)) * RC;
        __syncthreads();
        for (int i = tid; i < NR * 128; i += NTHREADS) { const int rr = i >> 7, ch = i & 127; const int t = t0 - (CWID - 1) + rr;
            u32x4 val = (u32x4){0u, 0u, 0u, 0u};
            if (t >= 0) val = *(const u32x4*)(U + ((size_t)b * SEQ + t) * D + ch * 8);
            *(LAS u32x4*)(ub + rr * 512 + ch * 4) = val; }
        __syncthreads();
        float o0[RC], o1[RC];
#pragma unroll
        for (int t = 0; t < RC; ++t) { float s0 = bd.x, s1 = bd.y;
#pragma unroll
            for (int j = 0; j < CWID; ++j) { const unsigned w = ub[(t + j) * 512 + tid]; s0 += bflo(w) * w0[j]; s1 += bfhi(w) * w1[j]; }
            o0[t] = s0; o1[t] = s1; }
#pragma unroll
        for (int t = 0; t < RC; ++t) { const float s = wave_sum(o0[t] + o1[t]); const float q = wave_sum(o0[t] * o0[t] + o1[t] * o1[t]);
            if (lane == 0) { red[(wave * RC + t) * 2] = s; red[(wave * RC + t) * 2 + 1] = q; } }
        __syncthreads();
#pragma unroll
        for (int t = 0; t < RC; ++t) { float s = 0.f, q = 0.f;
#pragma unroll
            for (int w = 0; w < 8; ++w) { s += red[(w * RC + t) * 2]; q += red[(w * RC + t) * 2 + 1]; }
            const float mean = s * (1.0f / D); const float var = fmaxf(q * (1.0f / D) - mean * mean, 0.f); const float rstd = 1.0f / sqrtf(var + EPS);
            const float y0 = (o0[t] - mean) * rstd * lg.x + lb.x, y1 = (o1[t] - mean) * rstd * lg.y + lb.y;
            *(unsigned*)(V2 + ((size_t)b * SEQ + t0 + t) * D + c) = pk2(siluf_(y0), siluf_(y1)); }
    }
}

__device__ __forceinline__ float top2sum4(float a, float b, float c, float d) {
    return fmaxf(fmaxf(fmaxf(a + b, a + c), fmaxf(a + d, b + c)), fmaxf(b + d, c + d));
}
__device__ __forceinline__ void phase_route(LAS unsigned char* lds, int wv, int l) {
    const Args a = oargs();
    const int tid = otid(wv), lane = tid & 63, wave = tid >> 6, fr = lane & 15, fq = lane >> 4, G = gridDim.x;
    const float* X = a.out; bf16_t* H2 = (bf16_t*)(a.ws + WS_H2);
    const float* g = (const float*)a.in[6] + l * D; const float* mod = (const float*)(a.ws + WS_MOD) + (size_t)l * 4 * 6144;
    const float* rw_g = (const float*)a.in[22]; const float* rb = (const float*)a.in[23];
    unsigned* cnt = (unsigned*)(a.ws + WS_CTL) + CW_CNT + 64 * l;
    int* list = (int*)(a.ws + WS_LIST); int* tokinfo = (int*)(a.ws + WS_TOKINFO);
    LAS unsigned char* Bhi = lds; LAS unsigned char* Blo = lds + 32768;
    LAS float* gam = (LAS float*)(lds + 65536); LAS float* shv = (LAS float*)(lds + 69632);
    LAS float* lgs = (LAS float*)(lds + 73728) + wave * 256;
    LAS float* sbs = (LAS float*)(lds + 81920) + wave * 512;
    LAS int* lcnt = (LAS int*)(lds + 98304);
    LAS int* sel = (LAS int*)(lds + 98560);
    const int RB = T / G, row0 = blockIdx.x * RB, b = row0 / SEQ;
    for (int c = tid; c < 2048; c += NTHREADS) { const int ks = c >> 6, ln = c & 63, e = ln & 15, q = ln >> 4; float w[8]; unsigned hi[4], lo[4];
#pragma unroll
        for (int j = 0; j < 8; ++j) w[j] = rw_g[(size_t)(32 * ks + 8 * q + j) * 16 + e];
#pragma unroll
        for (int j = 0; j < 4; ++j) { hi[j] = pk2(w[2 * j], w[2 * j + 1]); lo[j] = pk2(w[2 * j] - bflo(hi[j]), w[2 * j + 1] - bfhi(hi[j])); }
        *(LAS u32x4*)(Bhi + c * 16) = (u32x4){hi[0], hi[1], hi[2], hi[3]}; *(LAS u32x4*)(Blo + c * 16) = (u32x4){lo[0], lo[1], lo[2], lo[3]}; }
    for (int c = tid; c < 1024; c += NTHREADS) { gam[c] = g[c] * (1.0f + mod[(size_t)b * 6144 + 4 * 1024 + c]); shv[c] = mod[(size_t)b * 6144 + 3 * 1024 + c]; }
    if (tid < 32) lcnt[tid] = 0;
    __syncthreads();
    if (wave < RB / 16) {
        const int row = row0 + 16 * wave + fr; const float* xr = X + (size_t)row * D + 8 * fq;
        float ssq = 0.f;
#pragma unroll 8
        for (int ks = 0; ks < 32; ++ks) { const f32x4 x0 = *(const f32x4*)(xr + 32 * ks), x1 = *(const f32x4*)(xr + 32 * ks + 4);
            ssq += (x0.x * x0.x + x0.y * x0.y) + (x0.z * x0.z + x0.w * x0.w) + (x1.x * x1.x + x1.y * x1.y) + (x1.z * x1.z + x1.w * x1.w); }
        { float a_, b_; swap16(ssq, a_, b_); ssq = a_ + b_; swap32(ssq, a_, b_); ssq = a_ + b_; }
        const float r = 1.0f / sqrtf(ssq * (1.0f / D) + EPS);
        f32x4 acc = {0.f, 0.f, 0.f, 0.f};
        bf16_t* hrow = H2 + (size_t)row * D + 8 * fq;
#pragma unroll 4
        for (int ks = 0; ks < 32; ++ks) {
            const f32x4 x0 = *(const f32x4*)(xr + 32 * ks), x1 = *(const f32x4*)(xr + 32 * ks + 4);
            const f32x4 g0 = *(const LAS f32x4*)(gam + 32 * ks + 8 * fq), g1 = *(const LAS f32x4*)(gam + 32 * ks + 8 * fq + 4);
            const f32x4 s0 = *(const LAS f32x4*)(shv + 32 * ks + 8 * fq), s1 = *(const LAS f32x4*)(shv + 32 * ks + 8 * fq + 4);
            const f32x4 h0 = x0 * r * g0 + s0, h1 = x1 * r * g1 + s1;
            u32x4 hi; hi.x = pk2(h0.x, h0.y); hi.y = pk2(h0.z, h0.w); hi.z = pk2(h1.x, h1.y); hi.w = pk2(h1.z, h1.w);
            *(u32x4*)(hrow + 32 * ks) = hi;
            u32x4 lo; lo.x = pk2(h0.x - bflo(hi.x), h0.y - bfhi(hi.x)); lo.y = pk2(h0.z - bflo(hi.y), h0.w - bfhi(hi.y));
            lo.z = pk2(h1.x - bflo(hi.z), h1.y - bfhi(hi.z)); lo.w = pk2(h1.z - bflo(hi.w), h1.w - bfhi(hi.w));
            const bf16x8 bh = *(const LAS bf16x8*)(Bhi + (ks * 64 + lane) * 16), bl = *(const LAS bf16x8*)(Blo + (ks * 64 + lane) * 16);
            const bf16x8 ah = __builtin_bit_cast(bf16x8, hi), al = __builtin_bit_cast(bf16x8, lo);
            acc = __builtin_amdgcn_mfma_f32_16x16x32_bf16(ah, bh, acc, 0, 0, 0);
            acc = __builtin_amdgcn_mfma_f32_16x16x32_bf16(ah, bl, acc, 0, 0, 0);
            acc = __builtin_amdgcn_mfma_f32_16x16x32_bf16(al, bh, acc, 0, 0, 0);
        }
#pragma unroll
        for (int rg = 0; rg < 4; ++rg) lgs[(4 * fq + rg) * 16 + fr] = acc[rg];
        asm volatile("s_waitcnt lgkmcnt(0)" ::: "memory");
        const int rl = lane >> 2, gq = lane & 3;
        const f32x4 t4 = *(const LAS f32x4*)(lgs + rl * 16 + 4 * gq); const f32x4 rb4 = *(const f32x4*)(rb + 4 * gq);
        f32x4 s4, sb4;
#pragma unroll
        for (int e = 0; e < 4; ++e) { s4[e] = __builtin_amdgcn_rcpf(1.0f + __builtin_amdgcn_exp2f(-1.4426950408889634f * t4[e])); sb4[e] = s4[e] + rb4[e]; }
        const float gs = top2sum4(sb4[0], sb4[1], sb4[2], sb4[3]);
        *(LAS f32x4*)(sbs + (rl * 4 + gq) * 8) = s4; *(LAS f32x4*)(sbs + (rl * 4 + gq) * 8 + 4) = sb4;
#define QB(x, c_) __builtin_bit_cast(float, __builtin_amdgcn_update_dpp(0, __builtin_bit_cast(int, (x)), (c_), 0xf, 0xf, true))
        const float q0 = QB(gs, 0x00), q1 = QB(gs, 0x55), q2 = QB(gs, 0xAA), q3 = QB(gs, 0xFF);
#undef QB
        float best = q0; int gi = 0;
        { const bool u = q1 > best; best = u ? q1 : best; gi = u ? 1 : gi; } { const bool u = q2 > best; best = u ? q2 : best; gi = u ? 2 : gi; } { const bool u = q3 > best; best = u ? q3 : best; gi = u ? 3 : gi; }
        asm volatile("s_waitcnt lgkmcnt(0)" ::: "memory");
        const f32x4 ws = *(const LAS f32x4*)(sbs + (rl * 4 + gi) * 8), wb = *(const LAS f32x4*)(sbs + (rl * 4 + gi) * 8 + 4);
        int i1 = 0; float m1 = wb[0], sv1 = ws[0];
        { const bool c1 = wb[1] > m1; m1 = c1 ? wb[1] : m1; i1 = c1 ? 1 : i1; sv1 = c1 ? ws[1] : sv1; }
        { const bool c2 = wb[2] > m1; m1 = c2 ? wb[2] : m1; i1 = c2 ? 2 : i1; sv1 = c2 ? ws[2] : sv1; }
        { const bool c3 = wb[3] > m1; m1 = c3 ? wb[3] : m1; i1 = c3 ? 3 : i1; sv1 = c3 ? ws[3] : sv1; }
        int i2 = -1; float m2 = -1e30f, sv2 = 0.f;
        { const bool c0 = (i1 != 0) && (wb[0] > m2); m2 = c0 ? wb[0] : m2; i2 = c0 ? 0 : i2; sv2 = c0 ? ws[0] : sv2; }
        { const bool c1 = (i1 != 1) && (wb[1] > m2); m2 = c1 ? wb[1] : m2; i2 = c1 ? 1 : i2; sv2 = c1 ? ws[1] : sv2; }
        { const bool c2 = (i1 != 2) && (wb[2] > m2); m2 = c2 ? wb[2] : m2; i2 = c2 ? 2 : i2; sv2 = c2 ? ws[2] : sv2; }
        { const bool c3 = (i1 != 3) && (wb[3] > m2); m2 = c3 ? wb[3] : m2; i2 = c3 ? 3 : i2; sv2 = c3 ? ws[3] : sv2; }
        const int e0 = 4 * gi + i1, e1 = 4 * gi + i2; const float rws = __builtin_amdgcn_rcpf(sv1 + sv2); const float w0 = sv1 * rws, w1 = sv2 * rws;
        if (gq == 0) { const int lp0 = atomicAdd((int*)&lcnt[e0], 1), lp1 = atomicAdd((int*)&lcnt[e1], 1);
            LAS int* sp = sel + (wave * 16 + rl) * 8; sp[0] = row0 + 16 * wave + rl; sp[1] = e0; sp[2] = e1; sp[3] = lp0; sp[4] = lp1; sp[5] = __builtin_bit_cast(int, w0); sp[6] = __builtin_bit_cast(int, w1); }
    }
    __syncthreads();
    if (tid < 16) lcnt[16 + tid] = (int)atomicAdd(&cnt[tid], (unsigned)lcnt[tid]);
    __syncthreads();
    for (int i = tid; i < RB; i += NTHREADS) { const LAS int* sp = sel + i * 8; const int row = sp[0], e0 = sp[1], e1 = sp[2];
        const int p0 = lcnt[16 + e0] + sp[3], p1 = lcnt[16 + e1] + sp[4];
        list[(size_t)e0 * T + p0] = row; list[(size_t)e1 * T + p1] = row;
        int* ti = tokinfo + (size_t)row * 8; ti[0] = e0; ti[1] = p0; ti[2] = sp[5]; ti[3] = e1; ti[4] = p1; ti[5] = sp[6]; }
    __syncthreads();
}

__device__ __forceinline__ void moe_tiles(int wv, const unsigned* cnt, LAS int* tb, LAS int* cn) {
    __syncthreads();
    if (otid(wv) == 0) { int s = 0; for (int e = 0; e < 16; ++e) { const int c = (int)cnt[e]; cn[e] = c; tb[e] = s; s += (c + 255) >> 8; } tb[16] = s; }
    __syncthreads();
}
__device__ __forceinline__ void phase_moe_up(LAS unsigned char* lds, int wv, int l) {
    const Args a = oargs();
    LAS int* tb = (LAS int*)(lds + LDS_TB); LAS int* cn = tb + 32; LAS int* toks = (LAS int*)(lds + LDS_TOK);
    unsigned char* ws = a.ws;
    moe_tiles(wv, (const unsigned*)(ws + WS_CTL) + CW_CNT + 64 * l, tb, cn);
    LAS int* ul = (LAS int*)(lds + LDS_TB + 256);
    pg8::moe_unit_list(wv, tb, ul);
    pg8::MoeOrder S{ul, toks};
    { const int tid = otid(wv); const int* list = (const int*)(ws + WS_LIST); pg8::Unit u;
      for (int ui = 0; ui < 12 && S.next(ui, u); ++ui) { const int e = u.pn >> 2;
          for (int r = tid; r < 256; r += NTHREADS) { const int pos = (u.pm - tb[e]) * 256 + r; toks[ui * 256 + r] = pos < cn[e] ? list[(size_t)e * T + pos] : 0; } }
      __syncthreads(); }
    const pg8::Gemm g{(const bf16_t*)(ws + WS_H2), (const bf16_t*)(ws + WS_WGU) + (size_t)l * 16 * 1024 * 1024, 0, 0, D};
    pg8::gemm_phase<pg8::EpiGated<1>, pg8::MoeOrder, true, true, true>(lds, wv, g, S, pg8::EpiGated<1>{(bf16_t*)(ws + WS_ACT), DE, 3, nullptr});
}
__device__ __forceinline__ void phase_moe_down(LAS unsigned char* lds, int wv, int l) {
    const Args a = oargs();
    LAS int* tb = (LAS int*)(lds + LDS_TB); LAS int* cn = tb + 32; LAS int* toks = (LAS int*)(lds + LDS_TOK);
    unsigned char* ws = a.ws;
    moe_tiles(wv, (const unsigned*)(ws + WS_CTL) + CW_CNT + 64 * l, tb, cn);
    LAS int* ul = (LAS int*)(lds + LDS_TB + 256);
    pg8::moe_unit_list(wv, tb, ul);
    pg8::MoeOrder S{ul, toks};
    const pg8::Gemm g{(const bf16_t*)(ws + WS_ACT), (const bf16_t*)(ws + WS_WDN) + (size_t)l * 16 * 1024 * 512, 0, 0, DE};
    pg8::gemm_phase<pg8::EpiBf16, pg8::MoeOrder, true, true, false>(lds, wv, g, S, pg8::EpiBf16{(bf16_t*)(ws + WS_YB), D, 3});
}
__device__ __forceinline__ void phase_combine(LAS unsigned char* lds, int wv, int l) {
    const Args a = oargs();
    LAS int* tb = (LAS int*)(lds + LDS_TB); LAS int* cn = tb + 32;
    const unsigned* cnt = (const unsigned*)(a.ws + WS_CTL) + CW_CNT + 64 * l;
    moe_tiles(wv, cnt, tb, cn);
    const int tid_ = otid(wv); const int lane = tid_ & 63, gw = blockIdx.x * 8 + (tid_ >> 6), NGW = gridDim.x * 8;
    float* X = a.out; const bf16_t* YB = (const bf16_t*)(a.ws + WS_YB); const int* tokinfo = (const int*)(a.ws + WS_TOKINFO);
    const float* mod = (const float*)(a.ws + WS_MOD);
    for (int row0 = gw; row0 < T; row0 += 2 * NGW) {
        int e0[2], p0[2], e1[2], p1[2]; float w0[2], w1[2]; f32x4 v[2][4]; u32x2 ya[2][4], yc[2][4];
#pragma unroll
        for (int q = 0; q < 2; ++q) { const int row = row0 + q * NGW; const int* ti = tokinfo + (size_t)row * 8;
            e0[q] = ti[0]; p0[q] = ti[1]; e1[q] = ti[3]; p1[q] = ti[4]; w0[q] = __builtin_bit_cast(float, ti[2]); w1[q] = __builtin_bit_cast(float, ti[5]); }
#pragma unroll
        for (int q = 0; q < 2; ++q) { const int row = row0 + q * NGW;
            const bf16_t* y0 = YB + (size_t)(tb[e0[q]] * 256 + p0[q]) * D; const bf16_t* y1 = YB + (size_t)(tb[e1[q]] * 256 + p1[q]) * D;
            row_load(X + (size_t)row * D, lane, v[q]);
#pragma unroll
            for (int j = 0; j < 4; ++j) { ya[q][j] = *(const u32x2*)(y0 + 4 * lane + 256 * j); yc[q][j] = *(const u32x2*)(y1 + 4 * lane + 256 * j); } }
#pragma unroll
        for (int q = 0; q < 2; ++q) { const int row = row0 + q * NGW; const int b = row / SEQ;
            const float* g2 = mod + ((size_t)l * 4 + b) * 6144 + 5 * 1024;
#pragma unroll
            for (int j = 0; j < 4; ++j) { const int c = 4 * lane + 256 * j; const u32x2 a0 = ya[q][j], a1 = yc[q][j]; const f32x4 gv = *(const f32x4*)(g2 + c);
                f32x4 y; y.x = w0[q] * bflo(a0.x) + w1[q] * bflo(a1.x); y.y = w0[q] * bfhi(a0.x) + w1[q] * bfhi(a1.x); y.z = w0[q] * bflo(a0.y) + w1[q] * bflo(a1.y); y.w = w0[q] * bfhi(a0.y) + w1[q] * bfhi(a1.y);
                v[q][j] = v[q][j] + gv * y; }
            const float r = row_rstd(v[q]);
            if (l == DEPTH - 1) {
                const float* fg = (const float*)a.in[27];
#pragma unroll
                for (int j = 0; j < 4; ++j) { const int c = 4 * lane + 256 * j; *(f32x4*)(X + (size_t)row * D + c) = v[q][j] * r * *(const f32x4*)(fg + c); }
            } else {
#pragma unroll
                for (int j = 0; j < 4; ++j) *(f32x4*)(X + (size_t)row * D + 4 * lane + 256 * j) = v[q][j];
                const float* mn = mod + ((size_t)(l + 1) * 4 + b) * 6144;
                row_modulate_store(v[q], r, (const float*)a.in[5] + (l + 1) * D, mn + 1024, mn, (bf16_t*)(a.ws + WS_HA) + (size_t)row * D, lane);
                if (l == 1) row_modulate_store(v[q], r, (const float*)a.in[14], nullptr, nullptr, (bf16_t*)(a.ws + WS_XKV) + (size_t)row * D, lane);
            } }
    }
}

__device__ __forceinline__ void phase_mla_norm(int wv, int j) {
    const Args a = oargs();
    const int tid_ = otid(wv); const int lane = tid_ & 63, gw = blockIdx.x * 8 + (tid_ >> 6), NGW = gridDim.x * 8;
    const float* CQRAW = (const float*)(a.ws + WS_CQRAW); const float* CKVRAW = (const float*)(a.ws + WS_CKVRAW);
    bf16_t* CQ = (bf16_t*)(a.ws + WS_CQ); bf16_t* LAT = (bf16_t*)(a.ws + WS_LAT); bf16_t* KROPE = (bf16_t*)(a.ws + WS_KROPE);
    const float* qg = (const float*)a.in[19] + j * QR; const float* kg = (const float*)a.in[16]; const f32x2* rope = (const f32x2*)(a.ws + WS_ROPE);
    for (int row = gw; row < T; row += NGW) {
        { f32x2 v[3]; float s = 0.f;
#pragma unroll
          for (int q = 0; q < 3; ++q) { v[q] = *(const f32x2*)(CQRAW + (size_t)row * QR + 2 * lane + 128 * q); s += v[q].x * v[q].x + v[q].y * v[q].y; }
          const float r = 1.0f / sqrtf(wave_sum(s) * (1.0f / QR) + EPS);
#pragma unroll
          for (int q = 0; q < 3; ++q) { const int c = 2 * lane + 128 * q; const f32x2 gv = *(const f32x2*)(qg + c); *(unsigned*)(CQ + (size_t)row * QR + c) = pk2(v[q].x * r * gv.x, v[q].y * r * gv.y); } }
        if (j == 0) {
            const f32x4 v = *(const f32x4*)(CKVRAW + (size_t)row * 320 + 4 * lane);
            const float s = (v.x * v.x + v.y * v.y) + (v.z * v.z + v.w * v.w);
            const float r = 1.0f / sqrtf(wave_sum(s) * (1.0f / KVR) + EPS);
            const f32x4 gv = *(const f32x4*)(kg + 4 * lane);
            u32x2 o; o.x = pk2(v.x * r * gv.x, v.y * r * gv.y); o.y = pk2(v.z * r * gv.z, v.w * r * gv.w);
            *(u32x2*)(LAT + (size_t)row * KVR + 4 * lane) = o;
            if (lane < 32) { const float x1 = CKVRAW[(size_t)row * 320 + 256 + lane], x2 = CKVRAW[(size_t)row * 320 + 288 + lane]; const f32x2 cs = rope[(size_t)row * 32 + lane];
                KROPE[(size_t)row * 64 + lane] = (bf16_t)f2bf(x1 * cs.x - x2 * cs.y); KROPE[(size_t)row * 64 + 32 + lane] = (bf16_t)f2bf(x1 * cs.y + x2 * cs.x); }
        }
    }
}

namespace att {
typedef float f32x16 __attribute__((ext_vector_type(16)));
typedef short s16x4 __attribute__((ext_vector_type(4)));
constexpr int QB = 256, KVB = 64, KPB = 400  , SHM_V = KVB * 128 * 2, SHM_K = KVB * KPB;
constexpr int K_OFF = 2 * SHM_V, SCR_OFF = K_OFF + 2 * SHM_K;
constexpr float THR = 8.f;
__device__ __forceinline__ int v_st(int k, int c) { const int kk = (k & ~0xC) | ((k & 4) << 1) | ((k & 8) >> 1); return ((kk >> 3) * 4 + (c >> 5)) * 512 + ((kk & 7) * 32 + (c & 31)) * 2; }
__device__ __forceinline__ int v_rd_base(int lane) { return ((lane & 3) << 3) | (((lane >> 2) & 3) << 6) | (((lane >> 4) & 1) << 5) | (((lane >> 5) & 1) << 8); }
constexpr int v_rd_off(int d0, int ks, int half) { return d0 * 512 + ks * 4096 + half * 2048; }
__device__ __forceinline__ int crow(int r, int hi) { return (r & 3) + 8 * (r >> 2) + 4 * hi; }
__device__ __forceinline__ unsigned cvtpk(float lo, float hi) { unsigned r; asm volatile("v_cvt_pk_bf16_f32 %0, %1, %2" : "=v"(r) : "v"(lo), "v"(hi)); return r; }
#define ASBAR() __builtin_amdgcn_sched_barrier(0)
__device__ __forceinline__ void mask_tile(f32x16& p0, f32x16& p1, int dq) {
    const float NEG = -__builtin_inff();
#pragma unroll
    for (int r = 0; r < 16; ++r) { const int c = (r & 3) + 8 * (r >> 2); if (dq - c < 0) p0[r] = NEG; if (dq - c - 32 < 0) p1[r] = NEG; }
}
__device__ __forceinline__ void partialSM(f32x16& p0, f32x16& p1, float& m_reg, float& mn, float& alpha) {
    float pmax = p0[0];
#pragma unroll
    for (int r = 1; r < 16; ++r) pmax = fmaxf(pmax, p0[r]);
#pragma unroll
    for (int r = 0; r < 16; ++r) pmax = fmaxf(pmax, p1[r]);
    { float a_, b_; swap32(pmax, a_, b_); pmax = fmaxf(a_, b_); }
    constexpr float C2 = 1.4426950408889634f * ATTN_SCALE;
    if (__builtin_expect(__all((pmax - m_reg) * ATTN_SCALE <= THR), 1)) { mn = m_reg; alpha = 1.f; }
    else { mn = fmaxf(m_reg, pmax); alpha = __builtin_amdgcn_exp2f((m_reg - mn) * C2); m_reg = mn; }
    const float mnL = -mn * C2;
#pragma unroll
    for (int r = 0; r < 16; ++r) p0[r] = fmaf(p0[r], C2, mnL);
#pragma unroll
    for (int r = 0; r < 16; ++r) p1[r] = fmaf(p1[r], C2, mnL);
#pragma unroll
    for (int r = 0; r < 16; ++r) p0[r] = __builtin_amdgcn_exp2f(p0[r]);
}
__device__ __forceinline__ void finishSM(f32x16& p0, f32x16& p1, float alpha, float& l_reg, bf16x8& pa0, bf16x8& pa1, bf16x8& pa2, bf16x8& pa3) {
#pragma unroll
    for (int r = 0; r < 16; ++r) p1[r] = __builtin_amdgcn_exp2f(p1[r]);
    float ps = 0;
#pragma unroll
    for (int r = 0; r < 16; ++r) ps += p0[r];
#pragma unroll
    for (int r = 0; r < 16; ++r) ps += p1[r];
    { float a_, b_; swap32(ps, a_, b_); ps = a_ + b_; }
    l_reg = l_reg * alpha + ps;
#define PK4(P, B_, OUT) do { unsigned a0 = cvtpk(P[B_+0], P[B_+1]), a1 = cvtpk(P[B_+2], P[B_+3]); unsigned b0 = cvtpk(P[B_+4], P[B_+5]), b1 = cvtpk(P[B_+6], P[B_+7]); \
        auto r0 = __builtin_amdgcn_permlane32_swap(a0, b0, false, false); auto r1 = __builtin_amdgcn_permlane32_swap(a1, b1, false, false); \
        u32x4 w = {r0[0], r1[0], r0[1], r1[1]}; OUT = *reinterpret_cast<bf16x8*>(&w); } while (0)
    PK4(p0, 0, pa0); PK4(p0, 8, pa1); PK4(p1, 0, pa2); PK4(p1, 8, pa3);
#undef PK4
}
template <int KB>
__device__ __forceinline__ void qkt(f32x16& p0, f32x16& p1, const LAS unsigned char* kb, const bf16x8 (&qr)[12]) {
    p0 = f32x16{}; p1 = f32x16{};
#pragma unroll
    for (int d0 = 0; d0 < 12; ++d0) {
        const bf16x8 b0 = *(const LAS bf16x8*)(kb + KB * SHM_K + 32 * d0);
        const bf16x8 b1 = *(const LAS bf16x8*)(kb + KB * SHM_K + 32 * KPB + 32 * d0);
        p0 = __builtin_amdgcn_mfma_f32_32x32x16_bf16(b0, qr[d0], p0, 0, 0, 0);
        p1 = __builtin_amdgcn_mfma_f32_32x32x16_bf16(b1, qr[d0], p1, 0, 0, 0); }
}
template <int VB>
__device__ __forceinline__ void pv_tile(f32x16 (&o)[4], unsigned vb0, bf16x8 pa0, bf16x8 pa1, bf16x8 pa2, bf16x8 pa3) {
#define TRRD(dst, off) asm volatile("ds_read_b64_tr_b16 %0, %1 offset:%2" : "=&v"(dst) : "v"(vb0), "i"(off) : "memory")
#define PV_D0(d0) do { s16x4 l0, l1, l2, l3, h0, h1, h2, h3; constexpr int b_ = VB * SHM_V + v_rd_off(d0, 0, 0); \
        TRRD(l0, b_); TRRD(h0, b_ + 2048); TRRD(l1, b_ + 4096); TRRD(h1, b_ + 6144); TRRD(l2, b_ + 8192); TRRD(h2, b_ + 10240); TRRD(l3, b_ + 12288); TRRD(h3, b_ + 14336); \
        asm volatile("s_waitcnt lgkmcnt(0)" ::: "memory"); ASBAR(); \
        o[d0] = __builtin_amdgcn_mfma_f32_32x32x16_bf16(pa0, (bf16x8){l0[0], l0[1], l0[2], l0[3], h0[0], h0[1], h0[2], h0[3]}, o[d0], 0, 0, 0); \
        o[d0] = __builtin_amdgcn_mfma_f32_32x32x16_bf16(pa1, (bf16x8){l1[0], l1[1], l1[2], l1[3], h1[0], h1[1], h1[2], h1[3]}, o[d0], 0, 0, 0); \
        o[d0] = __builtin_amdgcn_mfma_f32_32x32x16_bf16(pa2, (bf16x8){l2[0], l2[1], l2[2], l2[3], h2[0], h2[1], h2[2], h2[3]}, o[d0], 0, 0, 0); \
        o[d0] = __builtin_amdgcn_mfma_f32_32x32x16_bf16(pa3, (bf16x8){l3[0], l3[1], l3[2], l3[3], h3[0], h3[1], h3[2], h3[3]}, o[d0], 0, 0, 0); } while (0)
    PV_D0(0); PV_D0(1); PV_D0(2); PV_D0(3);
#undef PV_D0
#undef TRRD
}
}

__device__ __forceinline__ void phase_attn(LAS unsigned char* lds, int wv) {
    const Args a = oargs();
    using namespace att;
    const int tid = otid(wv), lane = tid & 63, wid = __builtin_amdgcn_readfirstlane(tid >> 6), r32 = lane & 31, hi = lane >> 5, G = gridDim.x;
    unsigned char* ws = a.ws;
    const bf16_t* Q = (const bf16_t*)(ws + WS_Q); const bf16_t* KV = (const bf16_t*)(ws + WS_KV); const bf16_t* KR = (const bf16_t*)(ws + WS_KROPE);
    bf16_t* AO = (bf16_t*)(ws + WS_AO); const f32x2* rope = (const f32x2*)(ws + WS_ROPE);
    const __amdgpu_buffer_rsrc_t rsKV = __builtin_amdgcn_make_buffer_rsrc((void*)KV, 0, T * 2048 * 2, 0x00020000);
    const __amdgpu_buffer_rsrc_t rsKR = __builtin_amdgcn_make_buffer_rsrc((void*)KR, 0, T * 64 * 2, 0x00020000);
    LAS unsigned char* K_lds = lds + K_OFF;
    LAS float* wsc = (LAS float*)(lds + SCR_OFF) + wid * 64; LAS float* li_l = wsc; LAS float* al_l = wsc + 32;
    const int sr = tid >> 4, sc = (tid & 15) * 8, kr = tid >> 3, kc = tid & 7;
    const int vst0 = v_st(sr, sc), vst1 = v_st(32 + sr, sc), kw0 = sr * KPB + sc * 2, kw1 = (32 + sr) * KPB + sc * 2, kw2 = kr * KPB + 256 + kc * 16;
    const unsigned vb0 = (unsigned)(size_t)lds + (unsigned)v_rd_base(lane);
    const LAS unsigned char* kbp = K_lds + r32 * KPB + hi * 16;
    constexpr int NQB = SEQ / QB, NPAIR = NQB / 2, NITEM = NB * NH * NPAIR;
    for (int it0 = blockIdx.x; it0 < NITEM; it0 += G) {
        int item = it0; if ((G & 7) == 0 && NITEM % G == 0) { const int base = (it0 / G) * G, c = it0 - base; item = base + (c & 7) * (G >> 3) + (c >> 3); }
        const int bh = item / NPAIR, pr = item % NPAIR, b = bh / NH, h = bh % NH;
        const size_t tb0 = (size_t)b * SEQ;
        for (int pass = 0; pass < 2; ++pass) {
            const int qb = pass == 0 ? (NQB - 1 - pr) : pr;
            const int P0 = qb * QB, NT = 4 * (qb + 1), qlo = P0 + wid * 32, qm = qlo + r32 - 4 * hi;
            bf16x8 qr[12];
            { const size_t row = tb0 + P0 + wid * 32 + r32; const bf16_t* qp = Q + row * 1536 + h * DQK + 8 * hi;
#pragma unroll
              for (int d0 = 0; d0 < 12; ++d0) qr[d0] = *(const bf16x8*)(qp + 16 * d0);
#pragma unroll
              for (int dd = 0; dd < 2; ++dd) { ASBAR();
#pragma unroll
                  for (int j4 = 0; j4 < 2; ++j4) { const f32x4 ca = *(const f32x4*)(rope + row * 32 + 16 * dd + 8 * hi + 4 * j4), cb = *(const f32x4*)(rope + row * 32 + 16 * dd + 8 * hi + 4 * j4 + 2);
                      const float cc[4] = {ca.x, ca.z, cb.x, cb.z}, ss[4] = {ca.y, ca.w, cb.y, cb.w};
#pragma unroll
                      for (int jj = 0; jj < 4; ++jj) { const int j = 4 * j4 + jj; const float x1 = bf2f((unsigned short)qr[8 + dd][j]), x2 = bf2f((unsigned short)qr[10 + dd][j]);
                          qr[8 + dd][j] = (short)f2bf(x1 * cc[jj] - x2 * ss[jj]); qr[10 + dd][j] = (short)f2bf(x1 * ss[jj] + x2 * cc[jj]); } } }
              ASBAR(); }
            float m_reg = -1e30f, l_reg = 0.f; f32x16 o[4] = {};
            u32x4 st_v0, st_v1, st_k0, st_k1, st_k2;
            const unsigned voKV = (unsigned)(sr * 2048 + h * 256 + sc) * 2u, voKR = (unsigned)(kr * 64 + kc * 8) * 2u;
#define ALOAD(kb_) do { const unsigned t0_ = (unsigned)tb0 + (unsigned)(kb_); \
                st_v0 = __builtin_amdgcn_raw_buffer_load_b128(rsKV, voKV + 256u, t0_ * 4096u, 0); st_v1 = __builtin_amdgcn_raw_buffer_load_b128(rsKV, voKV + 256u, (t0_ + 32u) * 4096u, 0); \
                st_k0 = __builtin_amdgcn_raw_buffer_load_b128(rsKV, voKV, t0_ * 4096u, 0); st_k1 = __builtin_amdgcn_raw_buffer_load_b128(rsKV, voKV, (t0_ + 32u) * 4096u, 0); \
                st_k2 = __builtin_amdgcn_raw_buffer_load_b128(rsKR, voKR, t0_ * 128u, 0); } while (0)
#define AWRITE(bf) do { *(LAS u32x4*)(lds + (bf) * SHM_V + vst0) = st_v0; *(LAS u32x4*)(lds + (bf) * SHM_V + vst1) = st_v1; \
                *(LAS u32x4*)(K_lds + (bf) * SHM_K + kw0) = st_k0; *(LAS u32x4*)(K_lds + (bf) * SHM_K + kw1) = st_k1; *(LAS u32x4*)(K_lds + (bf) * SHM_K + kw2) = st_k2; } while (0)
#define RESC(a_) do { if (__any((a_) < 1.f)) { if (hi == 0) al_l[r32] = (a_); asm volatile("s_waitcnt lgkmcnt(0)" ::: "memory"); \
                _Pragma("unroll") for (int d_ = 0; d_ < 4; ++d_) _Pragma("unroll") for (int r = 0; r < 16; ++r) o[d_][r] *= al_l[crow(r, hi)]; } } while (0)
#define ASTEP(t, BF) do { f32x16 p0, p1; float mn, al; bf16x8 pa0, pa1, pa2, pa3; const int kb_ = (t) * KVB; \
                if ((t) + 1 < NT) ALOAD(kb_ + KVB); \
                ASBAR(); qkt<BF>(p0, p1, kbp, qr); \
                if (kb_ + KVB - 1 > qlo) mask_tile(p0, p1, qm - kb_); \
                partialSM(p0, p1, m_reg, mn, al); RESC(al); finishSM(p0, p1, al, l_reg, pa0, pa1, pa2, pa3); ASBAR(); \
                pv_tile<BF>(o, vb0, pa0, pa1, pa2, pa3); \
                if ((t) + 1 < NT) { asm volatile("s_waitcnt vmcnt(0)" ::: "memory"); AWRITE((BF) ^ 1); } \
                __syncthreads(); } while (0)
            __syncthreads();
            ALOAD(0); asm volatile("s_waitcnt vmcnt(0)" ::: "memory"); AWRITE(0);
            __syncthreads();
            for (int t = 0; t < NT; t += 2) { ASTEP(t, 0); ASTEP(t + 1, 1); }
            if (hi == 0) li_l[r32] = l_reg;
            asm volatile("s_waitcnt lgkmcnt(0)" ::: "memory");
            int r32e = r32, hie = hi; asm volatile("" : "+v"(r32e), "+v"(hie));
            bf16_t* Ow = AO + (tb0 + P0 + wid * 32) * D + h * 128 + r32e;
#pragma unroll
            for (int r = 0; r < 16; ++r) { const int orow = (r & 3) + 8 * (r >> 2) + 4 * hie; const float rl = __builtin_amdgcn_rcpf(li_l[orow]);
#pragma unroll
                for (int d0 = 0; d0 < 4; ++d0) { const float v = o[d0][r] * rl; const float vn = __shfl_xor(v, 1);
                    if ((r32e & 1) == 0) *(unsigned*)(Ow + (size_t)orow * D + d0 * 32) = cvtpk(v, vn); } }
#undef ALOAD
#undef AWRITE
#undef RESC
#undef ASTEP
        }
    }
    __syncthreads();
}

__device__ __forceinline__ void phase_c1(LAS unsigned char* lds, int wv, int l) {
    const Args a = oargs(); unsigned char* ws = a.ws;
    const pg8::Gemm g{(const bf16_t*)(ws + WS_HA), (const bf16_t*)(ws + WS_WIN) + (size_t)l * 2048 * 1024, T, 2048, D};
    pg8::StaticOrder S; S.init(T, 2048, (int)gridDim.x, (int)blockIdx.x);
    pg8::gemm_phase<pg8::EpiGated<0>, pg8::StaticOrder, true, true, false>(lds, wv, g, S, pg8::EpiGated<0>{(bf16_t*)(ws + WS_U), D, 0xffff, (const float*)a.in[8] + l * 2048});
}
__device__ __forceinline__ void phase_resid(LAS unsigned char* lds, int wv, int l, size_t a_off, size_t w_off) {
    const Args a = oargs(); unsigned char* ws = a.ws;
    const pg8::Gemm g{(const bf16_t*)(ws + a_off), (const bf16_t*)(ws + w_off), T, D, D};
    pg8::StaticOrder S; S.init(T, D, (int)gridDim.x, (int)blockIdx.x);
    pg8::gemm_phase<pg8::EpiResid, pg8::StaticOrder, true, true, false>(lds, wv, g, S, pg8::EpiResid{a.out, (const float*)(ws + WS_MOD) + (size_t)l * 4 * 6144 + 2048});
}
__device__ __forceinline__ void phase_a1(LAS unsigned char* lds, int wv, int j) {
    const Args a = oargs(); unsigned char* ws = a.ws;
    { const pg8::Gemm g{(const bf16_t*)(ws + WS_HA), (const bf16_t*)(ws + WS_WDQ) + (size_t)j * 512 * D, T, 512, D};
      pg8::StaticOrder S; S.init(T, 512, (int)gridDim.x, (int)blockIdx.x);
      pg8::gemm_phase<pg8::EpiF32, pg8::StaticOrder, true, true, false>(lds, wv, g, S, pg8::EpiF32{(float*)(ws + WS_CQRAW), QR, QR}); }
    if (j == 0) { const pg8::Gemm g{(const bf16_t*)(ws + WS_XKV), (const bf16_t*)(ws + WS_WDKV), T, 512, D};
      pg8::StaticOrder S; S.init(T, 512, (int)gridDim.x, (int)((blockIdx.x + gridDim.x / 2) % gridDim.x));
      pg8::gemm_phase<pg8::EpiF32, pg8::StaticOrder, true, true, false>(lds, wv, g, S, pg8::EpiF32{(float*)(ws + WS_CKVRAW), 320, 320}); }
}
__device__ __forceinline__ void phase_a2(LAS unsigned char* lds, int wv, int j) {
    const Args a = oargs(); unsigned char* ws = a.ws;
    { const pg8::Gemm g{(const bf16_t*)(ws + WS_CQ), (const bf16_t*)(ws + WS_WUQ) + (size_t)j * 1536 * QR, T, 1536, QR};
      pg8::StaticOrder S; S.init(T, 1536, (int)gridDim.x, (int)blockIdx.x);
      pg8::gemm_phase<pg8::EpiBf16, pg8::StaticOrder, true, true, false>(lds, wv, g, S, pg8::EpiBf16{(bf16_t*)(ws + WS_Q), 1536, 0xffff}); }
    if (j == 0) { const pg8::Gemm g{(const bf16_t*)(ws + WS_LAT), (const bf16_t*)(ws + WS_WUKV), T, 2048, KVR};
      pg8::StaticOrder S; S.init(T, 2048, (int)gridDim.x, (int)((blockIdx.x + gridDim.x / 2) % gridDim.x));
      pg8::gemm_phase<pg8::EpiBf16, pg8::StaticOrder, true, true, false>(lds, wv, g, S, pg8::EpiBf16{(bf16_t*)(ws + WS_KV), 2048, 0xffff}); }
}

constexpr int PH_PER_LAYER = 9, NPHASE = 2 + DEPTH * PH_PER_LAYER;
__global__ void __launch_bounds__(NTHREADS, 2) fwd(Args a) {
    extern __shared__ __attribute__((aligned(16))) unsigned char lds_raw[];
    LAS unsigned char* lds = (LAS unsigned char*)lds_raw;
    const int lo = a.ph_lo, hi = a.ph_hi;
    volatile LAS unsigned* misc = (volatile LAS unsigned*)(lds + LDS_MISC);
    const int wv = __builtin_amdgcn_readfirstlane((int)(threadIdx.x >> 6));
    if (threadIdx.x < 32) misc[threadIdx.x] = 0u;
    __syncthreads();
    if (hi - lo > 1) (void)xcd_barrier_post((unsigned*)(a.ws + WS_CTL) + CW_BAR, misc + 8);
#define IN(k) (lo <= (k) && (k) < hi)
#define SEAM(k) do { if ((k) + 1 < hi) { XcdBarrier bb_; bb_.bar = (unsigned*)(oargs().ws + WS_CTL) + CW_BAR; bb_.x = xb_xcc_id(); bb_.st = misc + 8; xcd_barrier(bb_, otid(wv) == 0); } } while (0)

    if (IN(0)) { phase_prologue(lds, wv); SEAM(0); }
    if (IN(1)) { phase_mod0(wv); SEAM(1); }
#pragma unroll 1
    for (int l = 0; l < DEPTH; ++l) {
        const int pb = 2 + PH_PER_LAYER * l;
        if (l < 2) {
            if (IN(pb + 0)) { phase_c1(lds, wv, l); SEAM(pb + 0); }
            if (IN(pb + 1)) { phase_conv(lds, wv, l); SEAM(pb + 1); }
            if (IN(pb + 2)) { phase_resid(lds, wv, l, WS_V2, WS_WOUT + (size_t)l * D * D * 2); SEAM(pb + 2); }
        } else {
            const int j = l - 2;
            if (IN(pb + 0)) { phase_a1(lds, wv, j); SEAM(pb + 0); }
            if (IN(pb + 1)) { phase_mla_norm(wv, j); SEAM(pb + 1); }
            if (IN(pb + 2)) { phase_a2(lds, wv, j); SEAM(pb + 2); }
            if (IN(pb + 3)) { phase_attn(lds, wv); SEAM(pb + 3); }
            if (IN(pb + 4)) { phase_resid(lds, wv, l, WS_AO, WS_WO + (size_t)j * D * D * 2); SEAM(pb + 4); }
        }
        if (IN(pb + 5)) { phase_route(lds, wv, l); SEAM(pb + 5); }
        if (IN(pb + 6)) { phase_moe_up(lds, wv, l); SEAM(pb + 6); }
        if (IN(pb + 7)) { phase_moe_down(lds, wv, l); SEAM(pb + 7); }
        if (IN(pb + 8)) { phase_combine(lds, wv, l); SEAM(pb + 8); }
    }
#undef IN
#undef SEAM
}

extern "C" void kernel_launch(void* const* d_in, const int* in_sizes, int n_in, void* d_out, int out_size, void* d_ws, size_t ws_size, hipStream_t stream) {
    static int grid = 0;
    if (grid == 0) {
        if (n_in != 28 || out_size != T * D || ws_size < WS_END) { fprintf(stderr, "kernel_launch: unexpected shapes (n_in %d out %d ws %zu)\n", n_in, out_size, ws_size); grid = -1; return; }
        int dev = 0, cus = 0, per_cu = 0;
        if (hipGetDevice(&dev) != hipSuccess || hipDeviceGetAttribute(&cus, hipDeviceAttributeMultiprocessorCount, dev) != hipSuccess) { grid = -1; return; }
        if (hipFuncSetAttribute((const void*)fwd, hipFuncAttributeMaxDynamicSharedMemorySize, LDS_BYTES) != hipSuccess) { fprintf(stderr, "kernel_launch: hipFuncSetAttribute failed\n"); grid = -1; return; }
        if (hipOccupancyMaxActiveBlocksPerMultiprocessor(&per_cu, (const void*)fwd, NTHREADS, LDS_BYTES) != hipSuccess || per_cu < 1) fprintf(stderr, "kernel_launch: occupancy query reports %d\n", per_cu);
        (void)hipGetLastError();
        grid = cus;
    }
    if (grid < 0) return;
    (void)hipMemsetAsync((char*)d_ws + WS_CTL, 0, CTL_BYTES, stream);
    Args a{};
    for (int i = 0; i < 28; ++i) a.in[i] = d_in[i];
    a.out = (float*)d_out; a.ws = (unsigned char*)d_ws;
#if MK_ONE_LAUNCH
    a.ph_lo = 0; a.ph_hi = NPHASE;
    hipLaunchKernelGGL(fwd, dim3(grid), dim3(NTHREADS), LDS_BYTES, stream, a);
#else
    for (int ph = 0; ph < NPHASE; ++ph) {
        if (ph >= 2) { const int l = (ph - 2) / PH_PER_LAYER, k = (ph - 2) % PH_PER_LAYER; if (l < 2 && (k == 3 || k == 4)) continue; }
        a.ph_lo = ph; a.ph_hi = ph + 1;
        hipLaunchKernelGGL(fwd, dim3(grid), dim3(NTHREADS), LDS_BYTES, stream, a);
    }
#endif
}
```

```cpp
#include <hip/hip_runtime.h>
#include <cstdio>
#include <cstdint>

#define LAS __attribute__((address_space(3)))
typedef unsigned short bf16_t;
typedef short bf16x8 __attribute__((ext_vector_type(8)));
typedef float f32x4 __attribute__((ext_vector_type(4)));
typedef float f32x2 __attribute__((ext_vector_type(2)));
typedef unsigned u32x4 __attribute__((ext_vector_type(4)));
typedef unsigned u32x2 __attribute__((ext_vector_type(2)));

#ifndef MK_ONE_LAUNCH
#define MK_ONE_LAUNCH 1
#endif

constexpr int NB = 4, SEQ = 4096, T = NB * SEQ, D = 1024, DEPTH = 4;
constexpr int CWID = 31, NH = 8, DQK = 192, QR = 384, KVR = 256;
constexpr int NE = 16, DE = 512;
constexpr float EPS = 1e-6f;
constexpr float ATTN_SCALE = 0.07216878364870322f;

constexpr size_t MiB = 1u << 20;
constexpr size_t WS_CTL = 0, CTL_BYTES = 1 * MiB;
constexpr size_t WS_MOD = 1 * MiB;
constexpr size_t WS_ROPE = 2 * MiB;
constexpr size_t WS_TOKINFO = 6 * MiB;
constexpr size_t WS_LIST = 7 * MiB;
constexpr size_t WS_WIN = 8 * MiB;
constexpr size_t WS_WOUT = 16 * MiB;
constexpr size_t WS_WDKV = 20 * MiB;
constexpr size_t WS_WUKV = 21 * MiB;
constexpr size_t WS_WDQ = 22 * MiB;
constexpr size_t WS_WUQ = 24 * MiB;
constexpr size_t WS_WO = 27 * MiB;
constexpr size_t WS_WGU = 32 * MiB;
constexpr size_t WS_WDN = 160 * MiB;
constexpr size_t WS_HA = 224 * MiB;
constexpr size_t WS_XKV = 256 * MiB;
constexpr size_t WS_U = 288 * MiB;
constexpr size_t WS_H2 = WS_U;
constexpr size_t WS_V2 = 320 * MiB;
constexpr size_t WS_AO = WS_V2;
constexpr size_t WS_YB = 352 * MiB;
constexpr size_t WS_CQRAW = 352 * MiB;
constexpr size_t WS_CKVRAW = 376 * MiB;
constexpr size_t WS_CQ = 396 * MiB;
constexpr size_t WS_LAT = 408 * MiB;
constexpr size_t WS_KROPE = 424 * MiB;
constexpr size_t WS_Q = 426 * MiB;
constexpr size_t WS_ACT = WS_Q;
constexpr size_t WS_KV = 474 * MiB;
constexpr size_t WS_X16 = 538 * MiB;
constexpr size_t WS_END = 570 * MiB;
constexpr int NSLOT_MAX = 2 * T + NE * 256;

constexpr int CW_BAR = 4096;
constexpr int CW_CNT = 16384;

constexpr int LDS_BYTES = 147456;
constexpr int LDS_EXTRA = 131072;
constexpr int LDS_MISC = LDS_EXTRA + 320;
constexpr int LDS_TB = LDS_EXTRA + 512;
constexpr int LDS_TOK = LDS_EXTRA + 1024;
constexpr int NTHREADS = 512;

#define XB_TMO      128
#define XB_XCNT(j)  (256  + 64 * (j))
#define XB_XSUB(j)  (1280 + 64 * (j))
#define XB_XGEN(j)  (2304 + 64 * (j))
#define XB_TOP      3328
#define XB_TOPGEN   3392
#define XCD_BAR_WORDS 3456
#define XB_SPIN_CAP (1u << 18)

__device__ __forceinline__ unsigned xb_ld(unsigned* p)              { return __hip_atomic_load(p, __ATOMIC_RELAXED, __HIP_MEMORY_SCOPE_AGENT); }
__device__ __forceinline__ unsigned xb_add(unsigned* p, unsigned v) { return __hip_atomic_fetch_add(p, v, __ATOMIC_RELAXED, __HIP_MEMORY_SCOPE_AGENT); }
__device__ __forceinline__ unsigned xb_xcc_id() { return (unsigned)__builtin_amdgcn_s_getreg((3 << 11) | 20) & 0xFu; }
#define XB_SPIN(cond, bar) do { unsigned _sp = 0; while (cond) { __builtin_amdgcn_s_sleep(1); \
    if ((++_sp & 255u) == 0u) { if (xb_ld(&(bar)[XB_TMO])) break; if (_sp > XB_SPIN_CAP) { atomicAdd(&(bar)[XB_TMO], 1u); break; } } } } while (0)

struct XcdBarrier { unsigned* bar; unsigned x; volatile LAS unsigned* st; };

__device__ __forceinline__ XcdBarrier xcd_barrier_post(unsigned* bar, volatile LAS unsigned* st) {
    XcdBarrier b; b.bar = bar; b.x = xb_xcc_id(); b.st = st;
    if (threadIdx.x == 0) (void)xb_add(&bar[XB_XCNT(b.x)], 1u);
    return b;
}
__device__ __forceinline__ void xcd_barrier_complete(unsigned* bar, unsigned x, unsigned& nloc, unsigned& nx) {
    const unsigned G = gridDim.x * gridDim.y * gridDim.z;
    unsigned sum, cnt, mine, sp = 0u;
    for (;;) {
        sum = 0u; cnt = 0u; mine = 0u;
#pragma unroll
        for (unsigned j = 0; j < 16; ++j) { const unsigned c = xb_ld(&bar[XB_XCNT(j)]); sum += c; cnt += (c > 0u) ? 1u : 0u; mine = (j == x) ? c : mine; }
        if (sum == G) break;
        __builtin_amdgcn_s_sleep(1);
        if ((++sp & 255u) == 0u) { if (xb_ld(&bar[XB_TMO])) break; if (sp > XB_SPIN_CAP) { atomicAdd(&bar[XB_TMO], 1u); break; } }
    }
    nloc = mine > 0u ? mine : 1u; nx = cnt > 0u ? cnt : 1u;
}
__device__ __forceinline__ void xcd_barrier(const XcdBarrier& b, bool leader) {
    asm volatile("s_waitcnt vmcnt(0)" ::: "memory");
    __syncthreads();
    if (leader) {
        unsigned* bar = b.bar;
        __builtin_amdgcn_s_waitcnt(0);
        unsigned nloc = b.st[0], nx = b.st[1];
        if (nloc == 0u) { xcd_barrier_complete(bar, b.x, nloc, nx); b.st[0] = nloc; b.st[1] = nx; }
        const unsigned old = xb_add(&bar[XB_XSUB(b.x)], 1u);
        const unsigned gen = old / nloc;
        if (old + 1u == (gen + 1u) * nloc) {
            __builtin_amdgcn_fence(__ATOMIC_RELEASE, "agent");
            asm volatile("s_waitcnt vmcnt(0)" ::: "memory");
            const unsigned og = xb_add(&bar[XB_TOP], 1u);
            const unsigned tg = og / nx;
            if (og + 1u == (tg + 1u) * nx) xb_add(&bar[XB_TOPGEN], 1u);
            else XB_SPIN(xb_ld(&bar[XB_TOPGEN]) == tg, bar);
            __builtin_amdgcn_fence(__ATOMIC_ACQUIRE, "agent");
            xb_add(&bar[XB_XGEN(b.x)], 1u);
            asm volatile("s_waitcnt vmcnt(0)" ::: "memory");
        } else {
            XB_SPIN(xb_ld(&bar[XB_XGEN(b.x)]) == gen, bar);
            __builtin_amdgcn_fence(__ATOMIC_ACQUIRE, "agent");
            asm volatile("s_waitcnt vmcnt(0)" ::: "memory");
        }
    }
    __syncthreads();
}

__device__ __forceinline__ unsigned f2bf(float f) { unsigned u = __builtin_bit_cast(unsigned, f); return (u + 0x7fffu + ((u >> 16) & 1u)) >> 16; }
__device__ __forceinline__ unsigned pk2(float lo, float hi) { unsigned r; asm("v_cvt_pk_bf16_f32 %0, %1, %2" : "=v"(r) : "v"(lo), "v"(hi)); return r; }
__device__ __forceinline__ float bf2f(unsigned short b) { return __builtin_bit_cast(float, (unsigned)b << 16); }
__device__ __forceinline__ float bflo(unsigned w) { return __builtin_bit_cast(float, w << 16); }
__device__ __forceinline__ float bfhi(unsigned w) { return __builtin_bit_cast(float, w & 0xffff0000u); }
__device__ __forceinline__ void swap32(float v, float& a, float& b) { unsigned x = __builtin_bit_cast(unsigned, v), y = x; asm volatile("" : "+v"(y));
    auto rr = __builtin_amdgcn_permlane32_swap(x, y, false, false); unsigned a_ = rr[0], b_ = rr[1]; asm volatile("" : "+v"(a_), "+v"(b_)); a = __builtin_bit_cast(float, a_); b = __builtin_bit_cast(float, b_); }
__device__ __forceinline__ void swap16(float v, float& a, float& b) { unsigned x = __builtin_bit_cast(unsigned, v), y = x; asm volatile("" : "+v"(y));
    auto rr = __builtin_amdgcn_permlane16_swap(x, y, false, false); unsigned a_ = rr[0], b_ = rr[1]; asm volatile("" : "+v"(a_), "+v"(b_)); a = __builtin_bit_cast(float, a_); b = __builtin_bit_cast(float, b_); }
__device__ __forceinline__ void swap32x(float d, float s_, float& a, float& b) { unsigned x = __builtin_bit_cast(unsigned, d), y = __builtin_bit_cast(unsigned, s_);
    auto rr = __builtin_amdgcn_permlane32_swap(x, y, false, false); unsigned a_ = rr[0], b_ = rr[1]; asm volatile("" : "+v"(a_), "+v"(b_)); a = __builtin_bit_cast(float, a_); b = __builtin_bit_cast(float, b_); }
__device__ __forceinline__ void swap16x(float d, float s_, float& a, float& b) { unsigned x = __builtin_bit_cast(unsigned, d), y = __builtin_bit_cast(unsigned, s_);
    auto rr = __builtin_amdgcn_permlane16_swap(x, y, false, false); unsigned a_ = rr[0], b_ = rr[1]; asm volatile("" : "+v"(a_), "+v"(b_)); a = __builtin_bit_cast(float, a_); b = __builtin_bit_cast(float, b_); }
__device__ __forceinline__ float row16_sum(float v);
__device__ __forceinline__ float dpp_add(float v, int ctrl_sel) {
    int r;
    if (ctrl_sel == 0) r = __builtin_amdgcn_update_dpp(0, __builtin_bit_cast(int, v), 0xB1, 0xf, 0xf, true);
    else if (ctrl_sel == 1) r = __builtin_amdgcn_update_dpp(0, __builtin_bit_cast(int, v), 0x4E, 0xf, 0xf, true);
    else if (ctrl_sel == 2) r = __builtin_amdgcn_update_dpp(0, __builtin_bit_cast(int, v), 0x141, 0xf, 0xf, true);
    else r = __builtin_amdgcn_update_dpp(0, __builtin_bit_cast(int, v), 0x140, 0xf, 0xf, true);
    return v + __builtin_bit_cast(float, r);
}
__device__ __forceinline__ float row16_sum(float v) { v = dpp_add(v, 0); v = dpp_add(v, 1); v = dpp_add(v, 2); v = dpp_add(v, 3); return v; }
__device__ __forceinline__ float wave_sum(float v) {
    v = dpp_add(v, 0); v = dpp_add(v, 1); v = dpp_add(v, 2); v = dpp_add(v, 3);
    float a, b; swap16(v, a, b); v = a + b; swap32(v, a, b); v = a + b;
    return v;
}
__device__ __forceinline__ float sigmoidf_(float x) { return 1.0f / (1.0f + __expf(-x)); }
__device__ __forceinline__ float siluf_(float x) { return x / (1.0f + __expf(-x)); }

struct Args { const void* in[28]; float* out; unsigned char* ws; int ph_lo, ph_hi; };
__device__ __forceinline__ int otid(int wv) { int t; asm volatile("v_mbcnt_lo_u32_b32 %0, -1, 0\n\tv_mbcnt_hi_u32_b32 %0, -1, %0" : "=v"(t)); return (wv << 6) + t; }
#define CAS __attribute__((address_space(4)))
__device__ __forceinline__ Args oargs() {
    const CAS Args* q = (const CAS Args*)__builtin_amdgcn_kernarg_segment_ptr(); asm volatile("" : "+s"(q));
    Args r;
#pragma unroll
    for (int i = 0; i < 28; ++i) r.in[i] = q->in[i];
    r.out = q->out; r.ws = q->ws; r.ph_lo = q->ph_lo; r.ph_hi = q->ph_hi; return r;
}
template <class P> __device__ __forceinline__ P* opq(P* p) { asm volatile("" : "+s"(p)); return p; }

namespace pg8 {
#define PG8_LAS __attribute__((address_space(3)))
constexpr int BM = 256, BK = 64, HALF = 128, HTB = HALF * BK * 2, STAGE_BYTES = 8 * HTB, NXCD = 8, WGM = 8;
__host__ __device__ __forceinline__ int lds_byte(int r, int c) { const int st = (r >> 4) * 2 + (c >> 5), rr = r & 15, cc = c & 31, ob = rr * 64 + cc * 2; return st * 1024 + (ob ^ (((ob >> 9) & 1) << 5)); }
__host__ __device__ __forceinline__ void stage_rc(int b, int& R, int& C) { const int st = b / 1024, sb = b % 1024, swz = sb ^ (((sb >> 9) & 1) << 5); R = (st >> 1) * 16 + swz / 64; C = (st & 1) * 32 + (swz % 64) / 2; }
__host__ __device__ __forceinline__ int perm32(int rho) { const int n = rho >> 4, i = rho & 15; return 8 * (i >> 2) + 4 * n + (i & 3); }
struct Unit { int pm, pn; };
struct Gemm { const bf16_t* A; const bf16_t* Bt; int M, N, K; };
struct StaticOrder {
    int nM, nN, nwg, G, c;
    __host__ __device__ void init(int M, int N, int G_, int c_) { nM = M / BM; nN = N / BM; nwg = nM * nN; G = G_; c = c_; }
    __host__ __device__ bool next(int i, Unit& u) const {
        const long L = (long)i * G + c; if (L >= nwg) return false;
        int wgid = (int)L; { const int q = nwg / NXCD, r = nwg % NXCD, xcd = wgid % NXCD, off = wgid / NXCD; wgid = (xcd < r ? xcd * (q + 1) : r * (q + 1) + (xcd - r) * q) + off; }
        const int nig = WGM * nN, gid = wgid / nig, fm = gid * WGM, gsz = (nM - fm) < WGM ? (nM - fm) : WGM;
        u.pm = fm + ((wgid % nig) % gsz); u.pn = (wgid % nig) / gsz; return true;
    }
    __device__ __forceinline__ const PG8_LAS int* tok(int) const { return nullptr; }
};
struct MoeOrder {
    const PG8_LAS int* ul; const PG8_LAS int* toks;
    __device__ __forceinline__ bool next(int i, Unit& u) const {
        if (i >= __builtin_amdgcn_readfirstlane(ul[0])) return false;
        u.pm = __builtin_amdgcn_readfirstlane(ul[2 + 2 * i]); u.pn = __builtin_amdgcn_readfirstlane(ul[3 + 2 * i]); return true;
    }
    __device__ __forceinline__ const PG8_LAS int* tok(int ui) const { return toks + ui * 256; }
};
__device__ __forceinline__ void moe_unit_list(int wv, const PG8_LAS int* tb, PG8_LAS int* ul) {
    if (otid(wv) == 0) { const int G = gridDim.x, c = blockIdx.x, x = c & 7, idx = c >> 3; int n = 0;
        for (int i = 0; i < 12; ++i) { const int rt = i * (G >> 2) + (idx >> 2) * 8 + x; if (rt >= tb[16]) break;
            int e = 0; for (int q = 1; q < 16; ++q) e += (rt >= tb[q]) ? 1 : 0;
            ul[2 + 2 * n] = rt; ul[3 + 2 * n] = e * 4 + (idx & 3); ++n; }
        ul[0] = n; }
    __syncthreads();
}

template <class Epi, class Sched, bool ALIGN_EPI = false, bool SP2 = false, bool GATHER = false>
__device__ __forceinline__ void gemm_phase(PG8_LAS unsigned char* lds, int wv, const Gemm g, const Sched& S, const Epi& E) {
    const int tid = otid(wv), wid = __builtin_amdgcn_readfirstlane(tid >> 6), lane = tid & 63, wr = wid >> 2, wc = wid & 3, fr = lane & 15, fq = lane >> 4;
    int K_ = g.K; asm volatile("" : "+s"(K_));
    const int K = K_, nt = K / BK;
    unsigned voffA[2], voffB[2];
#pragma unroll
    for (int i = 0; i < 2; ++i) { int R, C; stage_rc(tid * 16 + i * 8192, R, C); const int Rb = Epi::PERM ? ((R & ~31) + perm32(R & 31)) : R;
        voffA[i] = (unsigned)(R * K + C) * 2u; voffB[i] = (unsigned)(Rb * K + C) * 2u; }
    const size_t kstep = (size_t)(BK * 2);
    const size_t hstep = (size_t)HALF * K * 2;
    const size_t tstep = 2 * hstep;
    const unsigned ldsw = (unsigned)wid * 1024u;
    const int aoff = lds_byte(wr * 64 + fr, fq * 8), boff = lds_byte(wc * 32 + fr, fq * 8);
#define PG8_SA(b, h) (((b) * 2 + (h)) * HTB)
#define PG8_SB(b, h) ((4 + (b) * 2 + (h)) * HTB)
#define PG8_STAGE(bufoff, gbase, voff) do { _Pragma("unroll") for (int _i = 0; _i < 2; ++_i) \
        __builtin_amdgcn_global_load_lds((const unsigned*)((const char*)(gbase) + (voff)[_i]), (PG8_LAS unsigned*)(lds + (bufoff) + ldsw + _i * 8192), 16, 0, 0); } while (0)
#define PG8_STAGE_A(bufoff, gbase, hh, VO) do { if constexpr (GATHER) { PG8_STAGE(bufoff, gbase, VO[hh]); } else { PG8_STAGE(bufoff, (gbase) + (hh) * hstep, voffA); } } while (0)
#define PG8_LDA(dst, b, h) do { _Pragma("unroll") for (int m = 0; m < 4; ++m) _Pragma("unroll") for (int k = 0; k < 2; ++k) dst[m][k] = *(const PG8_LAS bf16x8*)(lds + PG8_SA(b, h) + aoff + m * 2048 + k * 1024); } while (0)
#define PG8_LDB(dst, b, h) do { _Pragma("unroll") for (int n = 0; n < 2; ++n) _Pragma("unroll") for (int k = 0; k < 2; ++k) dst[n][k] = *(const PG8_LAS bf16x8*)(lds + PG8_SB(b, h) + boff + n * 2048 + k * 1024); } while (0)
#define PG8_MMA(ai, bj, At, Bt) do { __builtin_amdgcn_s_setprio(1); _Pragma("unroll") for (int m = 0; m < 4; ++m) _Pragma("unroll") for (int n = 0; n < 2; ++n) _Pragma("unroll") for (int k = 0; k < 2; ++k) \
        acc[ai][bj][m][n] = __builtin_amdgcn_mfma_f32_16x16x32_bf16(Bt[n][k], At[m][k], acc[ai][bj][m][n], 0, 0, 0); __builtin_amdgcn_s_setprio(0); } while (0)
#define PG8_WAIT_V(n) asm volatile("s_waitcnt vmcnt(" #n ")" ::: "memory")
#define PG8_WAIT_L(n) asm volatile("s_waitcnt lgkmcnt(" #n ")" ::: "memory")
#define PG8_BAR __builtin_amdgcn_s_barrier()
#define PG8_SCHED __builtin_amdgcn_sched_barrier(0)
#define PG8_GOFF(dst, tk) do { _Pragma("unroll") for (int _i = 0; _i < 2; ++_i) { int _R, _C; stage_rc(tid * 16 + _i * 8192, _R, _C); _Pragma("unroll") for (int _h = 0; _h < 2; ++_h) dst[_h][_i] = (unsigned)((tk)[_h * 128 + _R] * K + _C) * 2u; } } while (0)
    Unit cur, nxt; int ui = 0;
    if (!S.next(0, cur)) return;
    f32x4 acc[2][2][4][2];
#pragma unroll
    for (int a = 0; a < 2; ++a)
#pragma unroll
        for (int b = 0; b < 2; ++b)
#pragma unroll
            for (int m = 0; m < 4; ++m)
#pragma unroll
                for (int n = 0; n < 2; ++n) acc[a][b][m][n] = (f32x4){0.f, 0.f, 0.f, 0.f};
    bf16x8 At[4][2], B0[2][2], B1[2][2];
    unsigned gA[2][2] = {{0u, 0u}, {0u, 0u}}, gAn[2][2] = {{0u, 0u}, {0u, 0u}}, gS[2][2] = {{0u, 0u}, {0u, 0u}};
    if constexpr (GATHER) { PG8_GOFF(gA, S.tok(0)); }
    const char* cA = GATHER ? (const char*)g.A : (const char*)g.A + (size_t)cur.pm * tstep; const char* cB = (const char*)g.Bt + (size_t)cur.pn * tstep;
    if constexpr (SP2) {
        PG8_STAGE(PG8_SB(0, 0), cB, voffB); PG8_STAGE(PG8_SB(0, 1), cB + hstep, voffB); PG8_STAGE_A(PG8_SA(0, 0), cA, 0, gA); PG8_STAGE_A(PG8_SA(0, 1), cA, 1, gA);
        if (wr == 1) PG8_BAR;
        PG8_WAIT_V(2); PG8_BAR;
        PG8_STAGE(PG8_SB(1, 0), cB + kstep, voffB); PG8_STAGE_A(PG8_SA(1, 0), cA + kstep, 0, gA); PG8_STAGE(PG8_SB(1, 1), cB + hstep + kstep, voffB);
        PG8_WAIT_V(6); PG8_BAR;
    } else {
        PG8_STAGE(PG8_SB(0, 0), cB, voffB); PG8_STAGE_A(PG8_SA(0, 0), cA, 0, gA); PG8_STAGE(PG8_SB(0, 1), cB + hstep, voffB); PG8_STAGE_A(PG8_SA(0, 1), cA, 1, gA);
        if (wr == 1) PG8_BAR;
        PG8_WAIT_V(4); PG8_BAR;
        PG8_STAGE(PG8_SB(1, 0), cB + kstep, voffB); PG8_STAGE_A(PG8_SA(1, 0), cA + kstep, 0, gA); PG8_STAGE(PG8_SB(1, 1), cB + hstep + kstep, voffB);
        PG8_WAIT_V(6); PG8_BAR;
    }
    for (;;) {
        const bool has_next = S.next(ui + 1, nxt);
        const char* nA = GATHER ? (const char*)g.A : (has_next ? (const char*)g.A + (size_t)nxt.pm * tstep : cA); const char* nB = has_next ? (const char*)g.Bt + (size_t)nxt.pn * tstep : cB;
        if constexpr (GATHER) { if (has_next) { PG8_GOFF(gAn, S.tok(ui + 1)); } else {
#pragma unroll
            for (int _h = 0; _h < 2; ++_h)
#pragma unroll
                for (int _i = 0; _i < 2; ++_i) gAn[_h][_i] = gA[_h][_i]; } }
        for (int t = 0; t < nt; t += 2) {
            const bool last = (t == nt - 2);
            const char* a1 = cA + (size_t)(t + 1) * kstep;
            const char* a2 = last ? nA : cA + (size_t)(t + 2) * kstep; const char* b2 = last ? nB : cB + (size_t)(t + 2) * kstep;
            const char* a3 = a2 + kstep; const char* b3 = b2 + kstep;
            if constexpr (GATHER) {
#pragma unroll
                for (int _h = 0; _h < 2; ++_h)
#pragma unroll
                    for (int _i = 0; _i < 2; ++_i) gS[_h][_i] = last ? gAn[_h][_i] : gA[_h][_i]; }
            if constexpr (SP2) {
            PG8_LDB(B0, 0, 0); PG8_LDB(B1, 0, 1); PG8_SCHED; PG8_LDA(At, 0, 0); PG8_STAGE_A(PG8_SA(1, 1), a1, 1, gA);
            PG8_WAIT_V(8); PG8_WAIT_L(0); PG8_BAR; PG8_MMA(0, 0, At, B0); PG8_MMA(0, 1, At, B1); PG8_BAR; PG8_SCHED;
            PG8_LDA(At, 0, 1); PG8_STAGE(PG8_SB(0, 0), b2, voffB); PG8_STAGE(PG8_SB(0, 1), b2 + hstep, voffB); PG8_STAGE_A(PG8_SA(0, 0), a2, 0, gS);
            PG8_WAIT_V(8); PG8_WAIT_L(0); PG8_BAR; PG8_MMA(1, 0, At, B0); PG8_MMA(1, 1, At, B1); PG8_BAR; PG8_SCHED;
            PG8_LDB(B0, 1, 0); PG8_LDB(B1, 1, 1); PG8_SCHED; PG8_LDA(At, 1, 0); PG8_STAGE_A(PG8_SA(0, 1), a2, 1, gS);
            PG8_WAIT_V(8); PG8_WAIT_L(0); PG8_BAR; PG8_MMA(0, 0, At, B0); PG8_MMA(0, 1, At, B1); PG8_BAR; PG8_SCHED;
            PG8_LDA(At, 1, 1); PG8_STAGE(PG8_SB(1, 0), b3, voffB); PG8_STAGE(PG8_SB(1, 1), b3 + hstep, voffB); PG8_STAGE_A(PG8_SA(1, 0), a3, 0, gS);
            PG8_WAIT_V(8); PG8_WAIT_L(0); PG8_BAR; PG8_MMA(1, 0, At, B0); PG8_MMA(1, 1, At, B1); PG8_BAR; PG8_SCHED;
            } else {
            PG8_LDB(B0, 0, 0); PG8_SCHED; PG8_LDA(At, 0, 0); PG8_STAGE_A(PG8_SA(1, 1), a1, 1, gA);
            PG8_WAIT_L(8); PG8_BAR; PG8_WAIT_L(0); PG8_MMA(0, 0, At, B0); PG8_BAR; PG8_SCHED;
            PG8_LDB(B1, 0, 1); PG8_STAGE(PG8_SB(0, 0), b2, voffB);
            PG8_BAR; PG8_WAIT_L(0); PG8_MMA(0, 1, At, B1); PG8_BAR;
            PG8_LDA(At, 0, 1); PG8_STAGE_A(PG8_SA(0, 0), a2, 0, gS);
            PG8_BAR; PG8_WAIT_L(0); PG8_MMA(1, 0, At, B0); PG8_BAR; PG8_SCHED;
            PG8_STAGE(PG8_SB(0, 1), b2 + hstep, voffB);
            PG8_WAIT_V(6); PG8_BAR; PG8_MMA(1, 1, At, B1); PG8_BAR;
            PG8_LDB(B0, 1, 0); PG8_SCHED; PG8_LDA(At, 1, 0); PG8_STAGE_A(PG8_SA(0, 1), a2, 1, gS);
            PG8_WAIT_L(8); PG8_BAR; PG8_WAIT_L(0); PG8_MMA(0, 0, At, B0); PG8_BAR; PG8_SCHED;
            PG8_LDB(B1, 1, 1); PG8_STAGE(PG8_SB(1, 0), b3, voffB);
            PG8_BAR; PG8_WAIT_L(0); PG8_MMA(0, 1, At, B1); PG8_BAR;
            PG8_LDA(At, 1, 1); PG8_STAGE_A(PG8_SA(1, 0), a3, 0, gS);
            PG8_BAR; PG8_WAIT_L(0); PG8_MMA(1, 0, At, B0); PG8_BAR; PG8_SCHED;
            PG8_STAGE(PG8_SB(1, 1), b3 + hstep, voffB);
            PG8_WAIT_V(6); PG8_BAR; PG8_MMA(1, 1, At, B1); PG8_BAR;
            }
        }
        if constexpr (ALIGN_EPI) { if (wr == 0) PG8_BAR; }
        E(acc, cur, wr, wc, fr, fq);
        if (!has_next) break;
#pragma unroll
        for (int a = 0; a < 2; ++a)
#pragma unroll
            for (int b = 0; b < 2; ++b)
#pragma unroll
                for (int m = 0; m < 4; ++m)
#pragma unroll
                    for (int n = 0; n < 2; ++n) acc[a][b][m][n] = (f32x4){0.f, 0.f, 0.f, 0.f};
        cur = nxt; cA = nA; cB = nB; ++ui;
        if constexpr (GATHER) {
#pragma unroll
            for (int _h = 0; _h < 2; ++_h)
#pragma unroll
                for (int _i = 0; _i < 2; ++_i) gA[_h][_i] = gAn[_h][_i]; }
        if constexpr (ALIGN_EPI) { if (wr == 1) PG8_BAR; }
    }
    PG8_WAIT_V(0);
    if constexpr (!ALIGN_EPI) { if (wr == 0) PG8_BAR; }
    PG8_BAR;
#undef PG8_SA
#undef PG8_SB
#undef PG8_STAGE
#undef PG8_STAGE_A
#undef PG8_LDA
#undef PG8_LDB
#undef PG8_MMA
#undef PG8_WAIT_V
#undef PG8_WAIT_L
#undef PG8_BAR
#undef PG8_SCHED
#undef PG8_GOFF
}
__device__ __forceinline__ unsigned cvt_pk_bf16(float lo, float hi) { unsigned r; asm volatile("v_cvt_pk_bf16_f32 %0, %1, %2" : "=v"(r) : "v"(lo), "v"(hi)); return r; }
struct EpiBf16 {
    static constexpr bool PERM = true;
    bf16_t* O; int ldc, pnmask;
    __device__ __forceinline__ void operator()(const f32x4 (&acc)[2][2][4][2], const Unit& u, int wr, int wc, int fr, int fq) const {
        const int row0 = u.pm * BM + wr * 64 + fr, col0 = (u.pn & pnmask) * BM + wc * 32 + 8 * fq;
#pragma unroll
        for (int ai = 0; ai < 2; ++ai)
#pragma unroll
            for (int m = 0; m < 4; ++m) { bf16_t* rowp = O + (size_t)(row0 + ai * HALF + m * 16) * ldc + col0;
#pragma unroll
                for (int bj = 0; bj < 2; ++bj) { const f32x4 v0 = acc[ai][bj][m][0], v1 = acc[ai][bj][m][1];
                    u32x4 w; w.x = cvt_pk_bf16(v0[0], v0[1]); w.y = cvt_pk_bf16(v0[2], v0[3]); w.z = cvt_pk_bf16(v1[0], v1[1]); w.w = cvt_pk_bf16(v1[2], v1[3]);
                    *(u32x4*)(rowp + bj * HALF) = w; } }
    }
};
template <int MODE  > struct EpiGated {
    static constexpr bool PERM = true;
    bf16_t* O; int ldc, pnmask; const float* bias;
    __device__ __forceinline__ void operator()(const f32x4 (&acc)[2][2][4][2], const Unit& u, int wr, int wc, int fr, int fq) const {
        const int row0 = u.pm * BM + wr * 64 + fr, ch0 = (u.pn & pnmask) * HALF + wc * 32 + 8 * fq;
        f32x4 ba[2], bg[2];
#pragma unroll
        for (int n = 0; n < 2; ++n) { ba[n] = (f32x4){0.f, 0.f, 0.f, 0.f}; bg[n] = ba[n]; if (MODE == 0) { ba[n] = *(const f32x4*)(bias + ch0 + 4 * n); bg[n] = *(const f32x4*)(bias + 1024 + ch0 + 4 * n); } }
#pragma unroll
        for (int ai = 0; ai < 2; ++ai)
#pragma unroll
            for (int m = 0; m < 4; ++m) { float r[8];
#pragma unroll
                for (int n = 0; n < 2; ++n) { const f32x4 x = acc[ai][0][m][n] + ba[n], y = acc[ai][1][m][n] + bg[n];
#pragma unroll
                    for (int q = 0; q < 4; ++q) r[4 * n + q] = (MODE == 0) ? x[q] * sigmoidf_(y[q]) : siluf_(x[q]) * y[q]; }
                u32x4 w; w.x = cvt_pk_bf16(r[0], r[1]); w.y = cvt_pk_bf16(r[2], r[3]); w.z = cvt_pk_bf16(r[4], r[5]); w.w = cvt_pk_bf16(r[6], r[7]);
                *(u32x4*)(O + (size_t)(row0 + ai * HALF + m * 16) * ldc + ch0) = w; }
    }
};
struct EpiResid {
    static constexpr bool PERM = true;
    bf16_t* X; const float* gate;
    __device__ __forceinline__ void operator()(const f32x4 (&acc)[2][2][4][2], const Unit& u, int wr, int wc, int fr, int fq) const {
        const int row0 = u.pm * BM + wr * 64 + fr, col0 = u.pn * BM + wc * 32 + 8 * fq; const float* gp = gate + (size_t)((u.pm * BM) / SEQ) * 6144 + col0;
#pragma unroll
        for (int bj = 0; bj < 2; ++bj) { const f32x4 g0 = *(const f32x4*)(gp + bj * HALF), g1 = *(const f32x4*)(gp + bj * HALF + 4);
#pragma unroll
            for (int ai = 0; ai < 2; ++ai)
#pragma unroll
                for (int m = 0; m < 4; ++m) { bf16_t* p = X + (size_t)(row0 + ai * HALF + m * 16) * D + col0 + bj * HALF; const u32x4 o = *(const u32x4*)p;
                    const f32x4 a0 = acc[ai][bj][m][0], a1 = acc[ai][bj][m][1]; u32x4 w;
                    w.x = cvt_pk_bf16(bflo(o.x) + g0[0] * a0[0], bfhi(o.x) + g0[1] * a0[1]); w.y = cvt_pk_bf16(bflo(o.y) + g0[2] * a0[2], bfhi(o.y) + g0[3] * a0[3]);
                    w.z = cvt_pk_bf16(bflo(o.z) + g1[0] * a1[0], bfhi(o.z) + g1[1] * a1[1]); w.w = cvt_pk_bf16(bflo(o.w) + g1[2] * a1[2], bfhi(o.w) + g1[3] * a1[3]);
                    *(u32x4*)p = w; } }
    }
};
struct EpiF32 {
    static constexpr bool PERM = false;
    float* O; int ldc, ncols;
    __device__ __forceinline__ void operator()(const f32x4 (&acc)[2][2][4][2], const Unit& u, int wr, int wc, int fr, int fq) const {
        const int row0 = u.pm * BM + wr * 64 + fr, col0 = u.pn * BM + wc * 32 + 4 * fq;
#pragma unroll
        for (int bj = 0; bj < 2; ++bj)
#pragma unroll
            for (int n = 0; n < 2; ++n) { const int c = col0 + bj * HALF + n * 16;
                if (c < ncols) {
#pragma unroll
                    for (int ai = 0; ai < 2; ++ai)
#pragma unroll
                        for (int m = 0; m < 4; ++m) *(f32x4*)(O + (size_t)(row0 + ai * HALF + m * 16) * ldc + c) = acc[ai][bj][m][n]; } }
    }
};
}

__device__ __forceinline__ int pair_row(int ch, int half) { return (ch >> 7) * 256 + half * 128 + (ch & 127); }

template <int MODE>
__device__ __forceinline__ void cvt_item(const float* W, int K, int N, int ld, bf16_t* WT, int row_off_or_half, LAS float* scr, int item, int lane) {
    const int nblk = N / 32, kb = item / nblk, nb = item % nblk, k0 = 64 * kb, n0 = 32 * nb;
#pragma unroll 8
    for (int i = 0; i < 32; ++i) { const int kk = 2 * i + (lane >> 5); scr[kk * 33 + (lane & 31)] = W[(size_t)(k0 + kk) * ld + n0 + (lane & 31)]; }
    asm volatile("s_waitcnt lgkmcnt(0)" ::: "memory");
    const int c = lane & 7;
#pragma unroll
    for (int j = 0; j < 4; ++j) { const int n = (lane >> 3) + 8 * j; const LAS float* s = scr + (8 * c) * 33 + n;
        u32x4 o; o.x = pk2(s[0 * 33], s[1 * 33]); o.y = pk2(s[2 * 33], s[3 * 33]); o.z = pk2(s[4 * 33], s[5 * 33]); o.w = pk2(s[6 * 33], s[7 * 33]);
        const int drow = (MODE == 0) ? (row_off_or_half + n0 + n) : pair_row(n0 + n, row_off_or_half);
        *(u32x4*)(WT + (size_t)drow * K + k0 + 8 * c) = o; }
    asm volatile("s_waitcnt lgkmcnt(0)" ::: "memory");
}

__device__ __forceinline__ void phase_prologue(LAS unsigned char* lds, int wv) {
    const Args a = oargs();
    const int tid = otid(wv), lane = tid & 63, wave = tid >> 6, G = gridDim.x;
    unsigned char* ws = a.ws;
    {
        const float* c = (const float*)a.in[1]; const float* ada_w = (const float*)a.in[3]; const float* ada_b = (const float*)a.in[4];
        float* mod = (float*)(ws + WS_MOD);
        LAS float* cs = (LAS float*)lds;
        LAS float* red = cs + 4096;
        bool have = false;
        for (int it = blockIdx.x; it < 4 * 48; it += G) {
            if (!have) { for (int i = tid; i < 4096; i += NTHREADS) cs[i] = siluf_(c[i]); have = true; }
            __syncthreads();
            const int l = it / 48, n0 = (it % 48) * 128;
            const float* wp = ada_w + (size_t)l * D * 6144 + n0 + 2 * lane;
            float acc[4][2] = {{0.f, 0.f}, {0.f, 0.f}, {0.f, 0.f}, {0.f, 0.f}};
            const int kb = wave * 128;
#pragma unroll 4
            for (int k = 0; k < 128; ++k) {
                const f32x2 w = *(const f32x2*)(wp + (size_t)(kb + k) * 6144);
#pragma unroll
                for (int b = 0; b < 4; ++b) { const float cv = cs[b * 1024 + kb + k]; acc[b][0] += cv * w.x; acc[b][1] += cv * w.y; }
            }
#pragma unroll
            for (int b = 0; b < 4; ++b) { red[(wave * 4 + b) * 128 + 2 * lane] = acc[b][0]; red[(wave * 4 + b) * 128 + 2 * lane + 1] = acc[b][1]; }
            __syncthreads();
            { const int b = tid >> 7, col = tid & 127; float s = 0.f;
#pragma unroll
              for (int w = 0; w < 8; ++w) s += red[(w * 4 + b) * 128 + col];
              mod[((size_t)l * 4 + b) * 6144 + n0 + col] = s + ada_b[l * 6144 + n0 + col]; }
        }
        __syncthreads();
    }
    {
        const int* pos = (const int*)a.in[2]; f32x2* rt = (f32x2*)(ws + WS_ROPE);
        for (int idx = blockIdx.x * NTHREADS + tid; idx < T * 32; idx += G * NTHREADS) {
            const int t = idx >> 5, i = idx & 31;
            const float inv = exp2f(-(float)i * (13.287712379549449f / 32.0f));
            const float ang = (float)pos[t] * inv;
            const float kf = rintf(ang * 0.15915494309189535f);
            float r = fmaf(-kf, 6.28125f, ang); r = fmaf(-kf, 1.9353071795864769e-3f, r);
            rt[idx] = (f32x2){__cosf(r), __sinf(r)};
        }
    }
    {
        LAS float* scr = (LAS float*)(lds + wave * 16384);
        const int gw = blockIdx.x * 8 + wave, NGW = G * 8;
        const float* w_in = (const float*)a.in[7]; const float* w_out = (const float*)a.in[13]; const float* w_dkv = (const float*)a.in[15]; const float* w_ukv = (const float*)a.in[17];
        const float* w_dq = (const float*)a.in[18]; const float* w_uq = (const float*)a.in[20]; const float* w_o = (const float*)a.in[21];
        const float* wg = (const float*)a.in[24]; const float* wu = (const float*)a.in[25]; const float* wd = (const float*)a.in[26];
        constexpr int I_IN = 16 * 64, I_OUT = 16 * 32, I_DKV = 16 * 10, I_UKV = 4 * 64, I_DQ = 16 * 12, I_UQ = 6 * 48, I_O = 16 * 32;
        constexpr int I_G = 16 * 16, I_D = 8 * 32;
        constexpr int NSMALL = 2 * I_IN + 2 * I_OUT + I_DKV + I_UKV + 2 * I_DQ + 2 * I_UQ + 2 * I_O;
        constexpr int NEXP = 4 * 16 * (2 * I_G + I_D);
        for (int it = gw; it < NSMALL + NEXP; it += NGW) {
            int r = it;
            if (r < 2 * I_IN) { const int l = r / I_IN; r %= I_IN; const int half = r / 512;
                cvt_item<1>(w_in + (size_t)l * D * 2048 + half * 1024, D, 1024, 2048, (bf16_t*)(ws + WS_WIN) + (size_t)l * 2048 * 1024, half, scr, r % 512, lane); continue; }
            r -= 2 * I_IN;
            if (r < 2 * I_OUT) { const int l = r / I_OUT; cvt_item<0>(w_out + (size_t)l * D * D, D, D, D, (bf16_t*)(ws + WS_WOUT) + (size_t)l * D * D, 0, scr, r % I_OUT, lane); continue; }
            r -= 2 * I_OUT;
            if (r < I_DKV) { cvt_item<0>(w_dkv, D, 320, 320, (bf16_t*)(ws + WS_WDKV), 0, scr, r, lane); continue; }
            r -= I_DKV;
            if (r < I_UKV) { cvt_item<0>(w_ukv, KVR, 2048, 2048, (bf16_t*)(ws + WS_WUKV), 0, scr, r, lane); continue; }
            r -= I_UKV;
            if (r < 2 * I_DQ) { const int j = r / I_DQ; cvt_item<0>(w_dq + (size_t)j * D * QR, D, QR, QR, (bf16_t*)(ws + WS_WDQ) + (size_t)j * 512 * D, 0, scr, r % I_DQ, lane); continue; }
            r -= 2 * I_DQ;
            if (r < 2 * I_UQ) { const int j = r / I_UQ; cvt_item<0>(w_uq + (size_t)j * QR * 1536, QR, 1536, 1536, (bf16_t*)(ws + WS_WUQ) + (size_t)j * 1536 * QR, 0, scr, r % I_UQ, lane); continue; }
            r -= 2 * I_UQ;
            if (r < 2 * I_O) { const int j = r / I_O; cvt_item<0>(w_o + (size_t)j * D * D, D, D, D, (bf16_t*)(ws + WS_WO) + (size_t)j * D * D, 0, scr, r % I_O, lane); continue; }
            r -= 2 * I_O;
            { const int per = 2 * I_G + I_D; const int le = r / per; r %= per;
              bf16_t* gu = (bf16_t*)(ws + WS_WGU) + (size_t)le * 1024 * 1024; bf16_t* dn = (bf16_t*)(ws + WS_WDN) + (size_t)le * 1024 * 512;
              if (r < I_G) cvt_item<1>(wg + (size_t)le * D * DE, D, DE, DE, gu, 0, scr, r, lane);
              else if (r < 2 * I_G) cvt_item<1>(wu + (size_t)le * D * DE, D, DE, DE, gu, 1, scr, r - I_G, lane);
              else cvt_item<0>(wd + (size_t)le * DE * D, DE, D, D, dn, 0, scr, r - 2 * I_G, lane); }
        }
        { const int gt = blockIdx.x * NTHREADS + tid, NT_ = G * NTHREADS; const u32x4 z = (u32x4){0u, 0u, 0u, 0u};
          u32x4* z0 = (u32x4*)((bf16_t*)(ws + WS_WDKV) + 320 * 1024); for (int i = gt; i < 192 * 1024 * 2 / 16; i += NT_) z0[i] = z;
          for (int j = 0; j < 2; ++j) { u32x4* z1 = (u32x4*)((bf16_t*)(ws + WS_WDQ) + (size_t)j * 512 * 1024 + 384 * 1024); for (int i = gt; i < 128 * 1024 * 2 / 16; i += NT_) z1[i] = z; } }
    }
}

__device__ __forceinline__ void row_load(const float* p, int lane, f32x4 (&v)[4]) {
#pragma unroll
    for (int j = 0; j < 4; ++j) v[j] = *(const f32x4*)(p + 4 * lane + 256 * j);
}
__device__ __forceinline__ float row_rstd(const f32x4 (&v)[4]) {
    float s = 0.f;
#pragma unroll
    for (int j = 0; j < 4; ++j) s += (v[j].x * v[j].x + v[j].y * v[j].y) + (v[j].z * v[j].z + v[j].w * v[j].w);
    return 1.0f / sqrtf(wave_sum(s) * (1.0f / D) + EPS);
}
__device__ __forceinline__ void row_modulate_store(const f32x4 (&v)[4], float r, const float* g, const float* sc, const float* sh, bf16_t* orow, int lane, f32x4 (*hout)[4] = nullptr) {
#pragma unroll
    for (int j = 0; j < 4; ++j) {
        const int c = 4 * lane + 256 * j;
        const f32x4 gv = *(const f32x4*)(g + c);
        f32x4 h = v[j] * r * gv;
        if (sc) { const f32x4 s1 = *(const f32x4*)(sc + c), s0 = *(const f32x4*)(sh + c); h = h * (s1 + 1.0f) + s0; }
        if (hout) (*hout)[j] = h;
        u32x2 o; o.x = pk2(h.x, h.y); o.y = pk2(h.z, h.w);
        *(u32x2*)(orow + c) = o;
    }
}

__device__ __forceinline__ void phase_mod0(int wv) {
    const Args a = oargs();
    const int tid_ = otid(wv); const int lane = tid_ & 63, gw = blockIdx.x * 8 + (tid_ >> 6), NGW = gridDim.x * 8;
    const float* x = (const float*)a.in[0]; const float* g = (const float*)a.in[5]; const float* mod = (const float*)(a.ws + WS_MOD);
    bf16_t* HA = (bf16_t*)(a.ws + WS_HA);
    for (int row = gw; row < T; row += NGW) {
        f32x4 v[4]; row_load(x + (size_t)row * D, lane, v);
#pragma unroll
        for (int j = 0; j < 4; ++j) { u32x2 o; o.x = pk2(v[j].x, v[j].y); o.y = pk2(v[j].z, v[j].w); *(u32x2*)((bf16_t*)(a.ws + WS_X16) + (size_t)row * D + 4 * lane + 256 * j) = o; }
        const float r = row_rstd(v); const int b = row / SEQ;
        row_modulate_store(v, r, g, mod + (size_t)b * 6144 + 1024, mod + (size_t)b * 6144, HA + (size_t)row * D, lane);
    }
}

__device__ __forceinline__ void phase_conv(LAS unsigned char* lds, int wv, int l) {
    const Args a = oargs();
    const int tid = otid(wv), lane = tid & 63, wave = tid >> 6;
    const bf16_t* U = (const bf16_t*)(a.ws + WS_U); bf16_t* V2 = (bf16_t*)(a.ws + WS_V2);
    const float* w_dw = (const float*)a.in[9] + (size_t)l * CWID * D; const float* b_dw = (const float*)a.in[10] + l * D;
    const float* ln_g = (const float*)a.in[11] + l * D; const float* ln_b = (const float*)a.in[12] + l * D;
    constexpr int RC = 16, NR = RC + CWID - 1;
    LAS unsigned* ub = (LAS unsigned*)lds;
    LAS float* red = (LAS float*)(lds + NR * 2048);
    const int c = 2 * tid;
    float w0[CWID], w1[CWID];
#pragma unroll
    for (int j = 0; j < CWID; ++j) { const f32x2 w = *(const f32x2*)(w_dw + (size_t)j * D + c); w0[j] = w.x; w1[j] = w.y; }
    const f32x2 bd = *(const f32x2*)(b_dw + c), lg = *(const f32x2*)(ln_g + c), lb = *(const f32x2*)(ln_b + c);
    for (int it = blockIdx.x; it < T / RC; it += gridDim.x) {
        const int b = it / (SEQ / RC), t0 = (it % (SEQ / RC)) * RC;
        __syncthreads();
        for (int i = tid; i < NR * 128; i += NTHREADS) { const int rr = i >> 7, ch = i & 127; const int t = t0 - (CWID - 1) + rr;
            u32x4 val = (u32x4){0u, 0u, 0u, 0u};
            if (t >= 0) val = *(const u32x4*)(U + ((size_t)b * SEQ + t) * D + ch * 8);
            *(LAS u32x4*)(ub + rr * 512 + ch * 4) = val; }
        __syncthreads();
        float o0[RC], o1[RC];
#pragma unroll
        for (int t = 0; t < RC; ++t) { float s0 = bd.x, s1 = bd.y;
#pragma unroll
            for (int j = 0; j < CWID; ++j) { const unsigned w = ub[(t + j) * 512 + tid]; s0 += bflo(w) * w0[j]; s1 += bfhi(w) * w1[j]; }
            o0[t] = s0; o1[t] = s1; }
#pragma unroll
        for (int t = 0; t < RC; ++t) { const float s = wave_sum(o0[t] + o1[t]); const float q = wave_sum(o0[t] * o0[t] + o1[t] * o1[t]);
            if (lane == 0) { red[(wave * RC + t) * 2] = s; red[(wave * RC + t) * 2 + 1] = q; } }
        __syncthreads();
#pragma unroll
        for (int t = 0; t < RC; ++t) { float s = 0.f, q = 0.f;
#pragma unroll
            for (int w = 0; w < 8; ++w) { s += red[(w * RC + t) * 2]; q += red[(w * RC + t) * 2 + 1]; }
            const float mean = s * (1.0f / D); const float var = fmaxf(q * (1.0f / D) - mean * mean, 0.f); const float rstd = 1.0f / sqrtf(var + EPS);
            const float y0 = (o0[t] - mean) * rstd * lg.x + lb.x, y1 = (o1[t] - mean) * rstd * lg.y + lb.y;
            *(unsigned*)(V2 + ((size_t)b * SEQ + t0 + t) * D + c) = pk2(siluf_(y0), siluf_(y1)); }
    }
}

__device__ __forceinline__ float top2sum4(float a, float b, float c, float d) {
    return fmaxf(fmaxf(fmaxf(a + b, a + c), fmaxf(a + d, b + c)), fmaxf(b + d, c + d));
}
__device__ __forceinline__ void phase_route(LAS unsigned char* lds, int wv, int l) {
    const Args a = oargs();
    const int tid = otid(wv), lane = tid & 63, wave = tid >> 6, fr = lane & 15, fq = lane >> 4, G = gridDim.x;
    const bf16_t* X = (const bf16_t*)(a.ws + WS_X16); bf16_t* H2 = (bf16_t*)(a.ws + WS_H2);
    const float* g = (const float*)a.in[6] + l * D; const float* mod = (const float*)(a.ws + WS_MOD) + (size_t)l * 4 * 6144;
    const float* rw_g = (const float*)a.in[22]; const float* rb = (const float*)a.in[23];
    unsigned* cnt = (unsigned*)(a.ws + WS_CTL) + CW_CNT + 64 * l;
    int* list = (int*)(a.ws + WS_LIST); int* tokinfo = (int*)(a.ws + WS_TOKINFO);
    LAS unsigned char* Bhi = lds; LAS unsigned char* Blo = lds + 32768;
    LAS float* gam = (LAS float*)(lds + 65536); LAS float* shv = (LAS float*)(lds + 69632);
    LAS float* lgs = (LAS float*)(lds + 73728) + wave * 256;
    LAS float* sbs = (LAS float*)(lds + 81920) + wave * 512;
    LAS int* lcnt = (LAS int*)(lds + 98304);
    LAS int* sel = (LAS int*)(lds + 98560);
    const int RB = T / G, row0 = blockIdx.x * RB, b = row0 / SEQ;
    for (int c = tid; c < 2048; c += NTHREADS) { const int ks = c >> 6, ln = c & 63, e = ln & 15, q = ln >> 4; float w[8]; unsigned hi[4], lo[4];
#pragma unroll
        for (int j = 0; j < 8; ++j) w[j] = rw_g[(size_t)(32 * ks + 8 * q + j) * 16 + e];
#pragma unroll
        for (int j = 0; j < 4; ++j) { hi[j] = pk2(w[2 * j], w[2 * j + 1]); lo[j] = pk2(w[2 * j] - bflo(hi[j]), w[2 * j + 1] - bfhi(hi[j])); }
        *(LAS u32x4*)(Bhi + c * 16) = (u32x4){hi[0], hi[1], hi[2], hi[3]}; *(LAS u32x4*)(Blo + c * 16) = (u32x4){lo[0], lo[1], lo[2], lo[3]}; }
    for (int c = tid; c < 1024; c += NTHREADS) { gam[c] = g[c] * (1.0f + mod[(size_t)b * 6144 + 4 * 1024 + c]); shv[c] = mod[(size_t)b * 6144 + 3 * 1024 + c]; }
    if (tid < 32) lcnt[tid] = 0;
    __syncthreads();
    if (wave < RB / 16) {
        const int row = row0 + 16 * wave + fr; const bf16_t* xr = X + (size_t)row * D + 8 * fq;
        float ssq = 0.f;
#pragma unroll 8
        for (int ks = 0; ks < 32; ++ks) { const u32x4 xw = *(const u32x4*)(xr + 32 * ks); const f32x4 x0 = {bflo(xw.x), bfhi(xw.x), bflo(xw.y), bfhi(xw.y)}, x1 = {bflo(xw.z), bfhi(xw.z), bflo(xw.w), bfhi(xw.w)};
            ssq += (x0.x * x0.x + x0.y * x0.y) + (x0.z * x0.z + x0.w * x0.w) + (x1.x * x1.x + x1.y * x1.y) + (x1.z * x1.z + x1.w * x1.w); }
        { float a_, b_; swap16(ssq, a_, b_); ssq = a_ + b_; swap32(ssq, a_, b_); ssq = a_ + b_; }
        const float r = 1.0f / sqrtf(ssq * (1.0f / D) + EPS);
        f32x4 acc = {0.f, 0.f, 0.f, 0.f};
        bf16_t* hrow = H2 + (size_t)row * D + 8 * fq;
#pragma unroll 4
        for (int ks = 0; ks < 32; ++ks) {
            const u32x4 xw = *(const u32x4*)(xr + 32 * ks); const f32x4 x0 = {bflo(xw.x), bfhi(xw.x), bflo(xw.y), bfhi(xw.y)}, x1 = {bflo(xw.z), bfhi(xw.z), bflo(xw.w), bfhi(xw.w)};
            const f32x4 g0 = *(const LAS f32x4*)(gam + 32 * ks + 8 * fq), g1 = *(const LAS f32x4*)(gam + 32 * ks + 8 * fq + 4);
            const f32x4 s0 = *(const LAS f32x4*)(shv + 32 * ks + 8 * fq), s1 = *(const LAS f32x4*)(shv + 32 * ks + 8 * fq + 4);
            const f32x4 h0 = x0 * r * g0 + s0, h1 = x1 * r * g1 + s1;
            u32x4 hi; hi.x = pk2(h0.x, h0.y); hi.y = pk2(h0.z, h0.w); hi.z = pk2(h1.x, h1.y); hi.w = pk2(h1.z, h1.w);
            *(u32x4*)(hrow + 32 * ks) = hi;
            u32x4 lo; lo.x = pk2(h0.x - bflo(hi.x), h0.y - bfhi(hi.x)); lo.y = pk2(h0.z - bflo(hi.y), h0.w - bfhi(hi.y));
            lo.z = pk2(h1.x - bflo(hi.z), h1.y - bfhi(hi.z)); lo.w = pk2(h1.z - bflo(hi.w), h1.w - bfhi(hi.w));
            const bf16x8 bh = *(const LAS bf16x8*)(Bhi + (ks * 64 + lane) * 16), bl = *(const LAS bf16x8*)(Blo + (ks * 64 + lane) * 16);
            const bf16x8 ah = __builtin_bit_cast(bf16x8, hi), al = __builtin_bit_cast(bf16x8, lo);
            acc = __builtin_amdgcn_mfma_f32_16x16x32_bf16(ah, bh, acc, 0, 0, 0);
            acc = __builtin_amdgcn_mfma_f32_16x16x32_bf16(ah, bl, acc, 0, 0, 0);
            acc = __builtin_amdgcn_mfma_f32_16x16x32_bf16(al, bh, acc, 0, 0, 0);
        }
#pragma unroll
        for (int rg = 0; rg < 4; ++rg) lgs[(4 * fq + rg) * 16 + fr] = acc[rg];
        asm volatile("s_waitcnt lgkmcnt(0)" ::: "memory");
        const int rl = lane >> 2, gq = lane & 3;
        const f32x4 t4 = *(const LAS f32x4*)(lgs + rl * 16 + 4 * gq); const f32x4 rb4 = *(const f32x4*)(rb + 4 * gq);
        f32x4 s4, sb4;
#pragma unroll
        for (int e = 0; e < 4; ++e) { s4[e] = __builtin_amdgcn_rcpf(1.0f + __builtin_amdgcn_exp2f(-1.4426950408889634f * t4[e])); sb4[e] = s4[e] + rb4[e]; }
        const float gs = top2sum4(sb4[0], sb4[1], sb4[2], sb4[3]);
        *(LAS f32x4*)(sbs + (rl * 4 + gq) * 8) = s4; *(LAS f32x4*)(sbs + (rl * 4 + gq) * 8 + 4) = sb4;
#define QB(x, c_) __builtin_bit_cast(float, __builtin_amdgcn_update_dpp(0, __builtin_bit_cast(int, (x)), (c_), 0xf, 0xf, true))
        const float q0 = QB(gs, 0x00), q1 = QB(gs, 0x55), q2 = QB(gs, 0xAA), q3 = QB(gs, 0xFF);
#undef QB
        float best = q0; int gi = 0;
        { const bool u = q1 > best; best = u ? q1 : best; gi = u ? 1 : gi; } { const bool u = q2 > best; best = u ? q2 : best; gi = u ? 2 : gi; } { const bool u = q3 > best; best = u ? q3 : best; gi = u ? 3 : gi; }
        asm volatile("s_waitcnt lgkmcnt(0)" ::: "memory");
        const f32x4 ws = *(const LAS f32x4*)(sbs + (rl * 4 + gi) * 8), wb = *(const LAS f32x4*)(sbs + (rl * 4 + gi) * 8 + 4);
        int i1 = 0; float m1 = wb[0], sv1 = ws[0];
        { const bool c1 = wb[1] > m1; m1 = c1 ? wb[1] : m1; i1 = c1 ? 1 : i1; sv1 = c1 ? ws[1] : sv1; }
        { const bool c2 = wb[2] > m1; m1 = c2 ? wb[2] : m1; i1 = c2 ? 2 : i1; sv1 = c2 ? ws[2] : sv1; }
        { const bool c3 = wb[3] > m1; m1 = c3 ? wb[3] : m1; i1 = c3 ? 3 : i1; sv1 = c3 ? ws[3] : sv1; }
        int i2 = -1; float m2 = -1e30f, sv2 = 0.f;
        { const bool c0 = (i1 != 0) && (wb[0] > m2); m2 = c0 ? wb[0] : m2; i2 = c0 ? 0 : i2; sv2 = c0 ? ws[0] : sv2; }
        { const bool c1 = (i1 != 1) && (wb[1] > m2); m2 = c1 ? wb[1] : m2; i2 = c1 ? 1 : i2; sv2 = c1 ? ws[1] : sv2; }
        { const bool c2 = (i1 != 2) && (wb[2] > m2); m2 = c2 ? wb[2] : m2; i2 = c2 ? 2 : i2; sv2 = c2 ? ws[2] : sv2; }
        { const bool c3 = (i1 != 3) && (wb[3] > m2); m2 = c3 ? wb[3] : m2; i2 = c3 ? 3 : i2; sv2 = c3 ? ws[3] : sv2; }
        const int e0 = 4 * gi + i1, e1 = 4 * gi + i2; const float rws = __builtin_amdgcn_rcpf(sv1 + sv2); const float w0 = sv1 * rws, w1 = sv2 * rws;
        if (gq == 0) { const int lp0 = atomicAdd((int*)&lcnt[e0], 1), lp1 = atomicAdd((int*)&lcnt[e1], 1);
            LAS int* sp = sel + (wave * 16 + rl) * 8; sp[0] = row0 + 16 * wave + rl; sp[1] = e0; sp[2] = e1; sp[3] = lp0; sp[4] = lp1; sp[5] = __builtin_bit_cast(int, w0); sp[6] = __builtin_bit_cast(int, w1); }
    }
    __syncthreads();
    if (tid < 16) lcnt[16 + tid] = (int)atomicAdd(&cnt[tid], (unsigned)lcnt[tid]);
    __syncthreads();
    for (int i = tid; i < RB; i += NTHREADS) { const LAS int* sp = sel + i * 8; const int row = sp[0], e0 = sp[1], e1 = sp[2];
        const int p0 = lcnt[16 + e0] + sp[3], p1 = lcnt[16 + e1] + sp[4];
        list[(size_t)e0 * T + p0] = row; list[(size_t)e1 * T + p1] = row;
        int* ti = tokinfo + (size_t)row * 8; ti[0] = e0; ti[1] = p0; ti[2] = sp[5]; ti[3] = e1; ti[4] = p1; ti[5] = sp[6]; }
    __syncthreads();
}

__device__ __forceinline__ void moe_tiles(int wv, const unsigned* cnt, LAS int* tb, LAS int* cn) {
    __syncthreads();
    if (otid(wv) == 0) { int s = 0; for (int e = 0; e < 16; ++e) { const int c = (int)cnt[e]; cn[e] = c; tb[e] = s; s += (c + 255) >> 8; } tb[16] = s; }
    __syncthreads();
}
__device__ __forceinline__ void phase_moe_up(LAS unsigned char* lds, int wv, int l) {
    const Args a = oargs();
    LAS int* tb = (LAS int*)(lds + LDS_TB); LAS int* cn = tb + 32; LAS int* toks = (LAS int*)(lds + LDS_TOK);
    unsigned char* ws = a.ws;
    moe_tiles(wv, (const unsigned*)(ws + WS_CTL) + CW_CNT + 64 * l, tb, cn);
    LAS int* ul = (LAS int*)(lds + LDS_TB + 256);
    pg8::moe_unit_list(wv, tb, ul);
    pg8::MoeOrder S{ul, toks};
    { const int tid = otid(wv); const int* list = (const int*)(ws + WS_LIST); pg8::Unit u;
      for (int ui = 0; ui < 12 && S.next(ui, u); ++ui) { const int e = u.pn >> 2;
          for (int r = tid; r < 256; r += NTHREADS) { const int pos = (u.pm - tb[e]) * 256 + r; toks[ui * 256 + r] = pos < cn[e] ? list[(size_t)e * T + pos] : 0; } }
      __syncthreads(); }
    const pg8::Gemm g{(const bf16_t*)(ws + WS_H2), (const bf16_t*)(ws + WS_WGU) + (size_t)l * 16 * 1024 * 1024, 0, 0, D};
    pg8::gemm_phase<pg8::EpiGated<1>, pg8::MoeOrder, true, true, true>(lds, wv, g, S, pg8::EpiGated<1>{(bf16_t*)(ws + WS_ACT), DE, 3, nullptr});
}
__device__ __forceinline__ void phase_moe_down(LAS unsigned char* lds, int wv, int l) {
    const Args a = oargs();
    LAS int* tb = (LAS int*)(lds + LDS_TB); LAS int* cn = tb + 32; LAS int* toks = (LAS int*)(lds + LDS_TOK);
    unsigned char* ws = a.ws;
    moe_tiles(wv, (const unsigned*)(ws + WS_CTL) + CW_CNT + 64 * l, tb, cn);
    LAS int* ul = (LAS int*)(lds + LDS_TB + 256);
    pg8::moe_unit_list(wv, tb, ul);
    pg8::MoeOrder S{ul, toks};
    const pg8::Gemm g{(const bf16_t*)(ws + WS_ACT), (const bf16_t*)(ws + WS_WDN) + (size_t)l * 16 * 1024 * 512, 0, 0, DE};
    pg8::gemm_phase<pg8::EpiBf16, pg8::MoeOrder, true, true, false>(lds, wv, g, S, pg8::EpiBf16{(bf16_t*)(ws + WS_YB), D, 3});
}
__device__ __forceinline__ void phase_combine(LAS unsigned char* lds, int wv, int l) {
    const Args a = oargs();
    LAS int* tb = (LAS int*)(lds + LDS_TB); LAS int* cn = tb + 32;
    const unsigned* cnt = (const unsigned*)(a.ws + WS_CTL) + CW_CNT + 64 * l;
    moe_tiles(wv, cnt, tb, cn);
    const int tid_ = otid(wv); const int lane = tid_ & 63, gw = blockIdx.x * 8 + (tid_ >> 6), NGW = gridDim.x * 8;
    bf16_t* X = (bf16_t*)(a.ws + WS_X16); float* OUT = a.out; const bf16_t* YB = (const bf16_t*)(a.ws + WS_YB); const int* tokinfo = (const int*)(a.ws + WS_TOKINFO);
    const float* mod = (const float*)(a.ws + WS_MOD);
    for (int row0 = gw; row0 < T; row0 += 2 * NGW) {
        int e0[2], p0[2], e1[2], p1[2]; float w0[2], w1[2]; f32x4 v[2][4]; u32x2 ya[2][4], yc[2][4];
#pragma unroll
        for (int q = 0; q < 2; ++q) { const int row = row0 + q * NGW; const int* ti = tokinfo + (size_t)row * 8;
            e0[q] = ti[0]; p0[q] = ti[1]; e1[q] = ti[3]; p1[q] = ti[4]; w0[q] = __builtin_bit_cast(float, ti[2]); w1[q] = __builtin_bit_cast(float, ti[5]); }
#pragma unroll
        for (int q = 0; q < 2; ++q) { const int row = row0 + q * NGW;
            const bf16_t* y0 = YB + (size_t)(tb[e0[q]] * 256 + p0[q]) * D; const bf16_t* y1 = YB + (size_t)(tb[e1[q]] * 256 + p1[q]) * D;
#pragma unroll
            for (int j = 0; j < 4; ++j) { const u32x2 xw = *(const u32x2*)(X + (size_t)row * D + 4 * lane + 256 * j); v[q][j] = (f32x4){bflo(xw.x), bfhi(xw.x), bflo(xw.y), bfhi(xw.y)}; }
#pragma unroll
            for (int j = 0; j < 4; ++j) { ya[q][j] = *(const u32x2*)(y0 + 4 * lane + 256 * j); yc[q][j] = *(const u32x2*)(y1 + 4 * lane + 256 * j); } }
#pragma unroll
        for (int q = 0; q < 2; ++q) { const int row = row0 + q * NGW; const int b = row / SEQ;
            const float* g2 = mod + ((size_t)l * 4 + b) * 6144 + 5 * 1024;
#pragma unroll
            for (int j = 0; j < 4; ++j) { const int c = 4 * lane + 256 * j; const u32x2 a0 = ya[q][j], a1 = yc[q][j]; const f32x4 gv = *(const f32x4*)(g2 + c);
                f32x4 y; y.x = w0[q] * bflo(a0.x) + w1[q] * bflo(a1.x); y.y = w0[q] * bfhi(a0.x) + w1[q] * bfhi(a1.x); y.z = w0[q] * bflo(a0.y) + w1[q] * bflo(a1.y); y.w = w0[q] * bfhi(a0.y) + w1[q] * bfhi(a1.y);
                v[q][j] = v[q][j] + gv * y; }
            const float r = row_rstd(v[q]);
            if (l == DEPTH - 1) {
                const float* fg = (const float*)a.in[27];
#pragma unroll
                for (int j = 0; j < 4; ++j) { const int c = 4 * lane + 256 * j; *(f32x4*)(OUT + (size_t)row * D + c) = v[q][j] * r * *(const f32x4*)(fg + c); }
            } else {
#pragma unroll
                for (int j = 0; j < 4; ++j) { u32x2 o; o.x = pk2(v[q][j].x, v[q][j].y); o.y = pk2(v[q][j].z, v[q][j].w); *(u32x2*)(X + (size_t)row * D + 4 * lane + 256 * j) = o; }
                const float* mn = mod + ((size_t)(l + 1) * 4 + b) * 6144;
                row_modulate_store(v[q], r, (const float*)a.in[5] + (l + 1) * D, mn + 1024, mn, (bf16_t*)(a.ws + WS_HA) + (size_t)row * D, lane);
                if (l == 1) row_modulate_store(v[q], r, (const float*)a.in[14], nullptr, nullptr, (bf16_t*)(a.ws + WS_XKV) + (size_t)row * D, lane);
            } }
    }
}

__device__ __forceinline__ void phase_mla_norm(int wv, int j) {
    const Args a = oargs();
    const int tid_ = otid(wv); const int lane = tid_ & 63, gw = blockIdx.x * 8 + (tid_ >> 6), NGW = gridDim.x * 8;
    const float* CQRAW = (const float*)(a.ws + WS_CQRAW); const float* CKVRAW = (const float*)(a.ws + WS_CKVRAW);
    bf16_t* CQ = (bf16_t*)(a.ws + WS_CQ); bf16_t* LAT = (bf16_t*)(a.ws + WS_LAT); bf16_t* KROPE = (bf16_t*)(a.ws + WS_KROPE);
    const float* qg = (const float*)a.in[19] + j * QR; const float* kg = (const float*)a.in[16]; const f32x2* rope = (const f32x2*)(a.ws + WS_ROPE);
    for (int row = gw; row < T; row += NGW) {
        { f32x2 v[3]; float s = 0.f;
#pragma unroll
          for (int q = 0; q < 3; ++q) { v[q] = *(const f32x2*)(CQRAW + (size_t)row * QR + 2 * lane + 128 * q); s += v[q].x * v[q].x + v[q].y * v[q].y; }
          const float r = 1.0f / sqrtf(wave_sum(s) * (1.0f / QR) + EPS);
#pragma unroll
          for (int q = 0; q < 3; ++q) { const int c = 2 * lane + 128 * q; const f32x2 gv = *(const f32x2*)(qg + c); *(unsigned*)(CQ + (size_t)row * QR + c) = pk2(v[q].x * r * gv.x, v[q].y * r * gv.y); } }
        if (j == 0) {
            const f32x4 v = *(const f32x4*)(CKVRAW + (size_t)row * 320 + 4 * lane);
            const float s = (v.x * v.x + v.y * v.y) + (v.z * v.z + v.w * v.w);
            const float r = 1.0f / sqrtf(wave_sum(s) * (1.0f / KVR) + EPS);
            const f32x4 gv = *(const f32x4*)(kg + 4 * lane);
            u32x2 o; o.x = pk2(v.x * r * gv.x, v.y * r * gv.y); o.y = pk2(v.z * r * gv.z, v.w * r * gv.w);
            *(u32x2*)(LAT + (size_t)row * KVR + 4 * lane) = o;
            if (lane < 32) { const float x1 = CKVRAW[(size_t)row * 320 + 256 + lane], x2 = CKVRAW[(size_t)row * 320 + 288 + lane]; const f32x2 cs = rope[(size_t)row * 32 + lane];
                KROPE[(size_t)row * 64 + lane] = (bf16_t)f2bf(x1 * cs.x - x2 * cs.y); KROPE[(size_t)row * 64 + 32 + lane] = (bf16_t)f2bf(x1 * cs.y + x2 * cs.x); }
        }
    }
}

namespace att {
typedef float f32x16 __attribute__((ext_vector_type(16)));
typedef short s16x4 __attribute__((ext_vector_type(4)));
constexpr int QB = 256, KVB = 64, KPB = 400  , SHM_V = KVB * 128 * 2, SHM_K = KVB * KPB;
constexpr int K_OFF = 2 * SHM_V, SCR_OFF = K_OFF + 2 * SHM_K;
constexpr float THR = 8.f;
__device__ __forceinline__ int v_st(int k, int c) { const int kk = (k & ~0xC) | ((k & 4) << 1) | ((k & 8) >> 1); return ((kk >> 3) * 4 + (c >> 5)) * 512 + ((kk & 7) * 32 + (c & 31)) * 2; }
__device__ __forceinline__ int v_rd_base(int lane) { return ((lane & 3) << 3) | (((lane >> 2) & 3) << 6) | (((lane >> 4) & 1) << 5) | (((lane >> 5) & 1) << 8); }
constexpr int v_rd_off(int d0, int ks, int half) { return d0 * 512 + ks * 4096 + half * 2048; }
__device__ __forceinline__ int crow(int r, int hi) { return (r & 3) + 8 * (r >> 2) + 4 * hi; }
__device__ __forceinline__ unsigned cvtpk(float lo, float hi) { unsigned r; asm volatile("v_cvt_pk_bf16_f32 %0, %1, %2" : "=v"(r) : "v"(lo), "v"(hi)); return r; }
#define ASBAR() __builtin_amdgcn_sched_barrier(0)
__device__ __forceinline__ void mask_tile(f32x16& p0, f32x16& p1, int dq) {
    const float NEG = -__builtin_inff();
#pragma unroll
    for (int r = 0; r < 16; ++r) { const int c = (r & 3) + 8 * (r >> 2); if (dq - c < 0) p0[r] = NEG; if (dq - c - 32 < 0) p1[r] = NEG; }
}
__device__ __forceinline__ void partialSM(f32x16& p0, f32x16& p1, float& m_reg, float& mn, float& alpha) {
    float pmax = p0[0];
#pragma unroll
    for (int r = 1; r < 16; ++r) pmax = fmaxf(pmax, p0[r]);
#pragma unroll
    for (int r = 0; r < 16; ++r) pmax = fmaxf(pmax, p1[r]);
    { float a_, b_; swap32(pmax, a_, b_); pmax = fmaxf(a_, b_); }
    constexpr float C2 = 1.4426950408889634f * ATTN_SCALE;
    if (__builtin_expect(__all((pmax - m_reg) * ATTN_SCALE <= THR), 1)) { mn = m_reg; alpha = 1.f; }
    else { mn = fmaxf(m_reg, pmax); alpha = __builtin_amdgcn_exp2f((m_reg - mn) * C2); m_reg = mn; }
    const float mnL = -mn * C2;
#pragma unroll
    for (int r = 0; r < 16; ++r) p0[r] = fmaf(p0[r], C2, mnL);
#pragma unroll
    for (int r = 0; r < 16; ++r) p1[r] = fmaf(p1[r], C2, mnL);
#pragma unroll
    for (int r = 0; r < 16; ++r) p0[r] = __builtin_amdgcn_exp2f(p0[r]);
}
__device__ __forceinline__ void finishSM(f32x16& p0, f32x16& p1, float alpha, float& l_reg, bf16x8& pa0, bf16x8& pa1, bf16x8& pa2, bf16x8& pa3) {
#pragma unroll
    for (int r = 0; r < 16; ++r) p1[r] = __builtin_amdgcn_exp2f(p1[r]);
    float ps = 0;
#pragma unroll
    for (int r = 0; r < 16; ++r) ps += p0[r];
#pragma unroll
    for (int r = 0; r < 16; ++r) ps += p1[r];
    { float a_, b_; swap32(ps, a_, b_); ps = a_ + b_; }
    l_reg = l_reg * alpha + ps;
#define PK4(P, B_, OUT) do { unsigned a0 = cvtpk(P[B_+0], P[B_+1]), a1 = cvtpk(P[B_+2], P[B_+3]); unsigned b0 = cvtpk(P[B_+4], P[B_+5]), b1 = cvtpk(P[B_+6], P[B_+7]); \
        auto r0 = __builtin_amdgcn_permlane32_swap(a0, b0, false, false); auto r1 = __builtin_amdgcn_permlane32_swap(a1, b1, false, false); \
        u32x4 w = {r0[0], r1[0], r0[1], r1[1]}; OUT = *reinterpret_cast<bf16x8*>(&w); } while (0)
    PK4(p0, 0, pa0); PK4(p0, 8, pa1); PK4(p1, 0, pa2); PK4(p1, 8, pa3);
#undef PK4
}
template <int KB>
__device__ __forceinline__ void qkt(f32x16& p0, f32x16& p1, const LAS unsigned char* kb, const bf16x8 (&qr)[12]) {
    p0 = f32x16{}; p1 = f32x16{};
#pragma unroll
    for (int d0 = 0; d0 < 12; ++d0) {
        const bf16x8 b0 = *(const LAS bf16x8*)(kb + KB * SHM_K + 32 * d0);
        const bf16x8 b1 = *(const LAS bf16x8*)(kb + KB * SHM_K + 32 * KPB + 32 * d0);
        p0 = __builtin_amdgcn_mfma_f32_32x32x16_bf16(b0, qr[d0], p0, 0, 0, 0);
        p1 = __builtin_amdgcn_mfma_f32_32x32x16_bf16(b1, qr[d0], p1, 0, 0, 0); }
}
template <int VB>
__device__ __forceinline__ void pv_tile(f32x16 (&o)[4], unsigned vb0, bf16x8 pa0, bf16x8 pa1, bf16x8 pa2, bf16x8 pa3) {
#define TRRD(dst, off) asm volatile("ds_read_b64_tr_b16 %0, %1 offset:%2" : "=&v"(dst) : "v"(vb0), "i"(off) : "memory")
#define PV_D0(d0) do { s16x4 l0, l1, l2, l3, h0, h1, h2, h3; constexpr int b_ = VB * SHM_V + v_rd_off(d0, 0, 0); \
        TRRD(l0, b_); TRRD(h0, b_ + 2048); TRRD(l1, b_ + 4096); TRRD(h1, b_ + 6144); TRRD(l2, b_ + 8192); TRRD(h2, b_ + 10240); TRRD(l3, b_ + 12288); TRRD(h3, b_ + 14336); \
        asm volatile("s_waitcnt lgkmcnt(0)" ::: "memory"); ASBAR(); \
        o[d0] = __builtin_amdgcn_mfma_f32_32x32x16_bf16(pa0, (bf16x8){l0[0], l0[1], l0[2], l0[3], h0[0], h0[1], h0[2], h0[3]}, o[d0], 0, 0, 0); \
        o[d0] = __builtin_amdgcn_mfma_f32_32x32x16_bf16(pa1, (bf16x8){l1[0], l1[1], l1[2], l1[3], h1[0], h1[1], h1[2], h1[3]}, o[d0], 0, 0, 0); \
        o[d0] = __builtin_amdgcn_mfma_f32_32x32x16_bf16(pa2, (bf16x8){l2[0], l2[1], l2[2], l2[3], h2[0], h2[1], h2[2], h2[3]}, o[d0], 0, 0, 0); \
        o[d0] = __builtin_amdgcn_mfma_f32_32x32x16_bf16(pa3, (bf16x8){l3[0], l3[1], l3[2], l3[3], h3[0], h3[1], h3[2], h3[3]}, o[d0], 0, 0, 0); } while (0)
    PV_D0(0); PV_D0(1); PV_D0(2); PV_D0(3);
#undef PV_D0
#undef TRRD
}
}

__device__ __forceinline__ void phase_attn(LAS unsigned char* lds, int wv) {
    const Args a = oargs();
    using namespace att;
    const int tid = otid(wv), lane = tid & 63, wid = __builtin_amdgcn_readfirstlane(tid >> 6), r32 = lane & 31, hi = lane >> 5, G = gridDim.x;
    unsigned char* ws = a.ws;
    const bf16_t* Q = (const bf16_t*)(ws + WS_Q); const bf16_t* KV = (const bf16_t*)(ws + WS_KV); const bf16_t* KR = (const bf16_t*)(ws + WS_KROPE);
    bf16_t* AO = (bf16_t*)(ws + WS_AO); const f32x2* rope = (const f32x2*)(ws + WS_ROPE);
    const __amdgpu_buffer_rsrc_t rsKV = __builtin_amdgcn_make_buffer_rsrc((void*)KV, 0, T * 2048 * 2, 0x00020000);
    const __amdgpu_buffer_rsrc_t rsKR = __builtin_amdgcn_make_buffer_rsrc((void*)KR, 0, T * 64 * 2, 0x00020000);
    LAS unsigned char* K_lds = lds + K_OFF;
    LAS float* wsc = (LAS float*)(lds + SCR_OFF) + wid * 64; LAS float* li_l = wsc; LAS float* al_l = wsc + 32;
    const int sr = tid >> 4, sc = (tid & 15) * 8, kr = tid >> 3, kc = tid & 7;
    const int vst0 = v_st(sr, sc), vst1 = v_st(32 + sr, sc), kw0 = sr * KPB + sc * 2, kw1 = (32 + sr) * KPB + sc * 2, kw2 = kr * KPB + 256 + kc * 16;
    const unsigned vb0 = (unsigned)(size_t)lds + (unsigned)v_rd_base(lane);
    const LAS unsigned char* kbp = K_lds + r32 * KPB + hi * 16;
    constexpr int NQB = SEQ / QB, NPAIR = NQB / 2, NITEM = NB * NH * NPAIR;
    for (int it0 = blockIdx.x; it0 < NITEM; it0 += G) {
        int item = it0; if ((G & 7) == 0 && NITEM % G == 0) { const int base = (it0 / G) * G, c = it0 - base; item = base + (c & 7) * (G >> 3) + (c >> 3); }
        const int bh = item / NPAIR, pr = item % NPAIR, b = bh / NH, h = bh % NH;
        const size_t tb0 = (size_t)b * SEQ;
        for (int pass = 0; pass < 2; ++pass) {
            const int qb = pass == 0 ? (NQB - 1 - pr) : pr;
            const int P0 = qb * QB, NT = 4 * (qb + 1), qlo = P0 + wid * 32, qm = qlo + r32 - 4 * hi;
            bf16x8 qr[12];
            { const size_t row = tb0 + P0 + wid * 32 + r32; const bf16_t* qp = Q + row * 1536 + h * DQK + 8 * hi;
#pragma unroll
              for (int d0 = 0; d0 < 12; ++d0) qr[d0] = *(const bf16x8*)(qp + 16 * d0);
#pragma unroll
              for (int dd = 0; dd < 2; ++dd) { ASBAR();
#pragma unroll
                  for (int j4 = 0; j4 < 2; ++j4) { const f32x4 ca = *(const f32x4*)(rope + row * 32 + 16 * dd + 8 * hi + 4 * j4), cb = *(const f32x4*)(rope + row * 32 + 16 * dd + 8 * hi + 4 * j4 + 2);
                      const float cc[4] = {ca.x, ca.z, cb.x, cb.z}, ss[4] = {ca.y, ca.w, cb.y, cb.w};
#pragma unroll
                      for (int jj = 0; jj < 4; ++jj) { const int j = 4 * j4 + jj; const float x1 = bf2f((unsigned short)qr[8 + dd][j]), x2 = bf2f((unsigned short)qr[10 + dd][j]);
                          qr[8 + dd][j] = (short)f2bf(x1 * cc[jj] - x2 * ss[jj]); qr[10 + dd][j] = (short)f2bf(x1 * ss[jj] + x2 * cc[jj]); } } }
              ASBAR(); }
            float m_reg = -1e30f, l_reg = 0.f; f32x16 o[4] = {};
            u32x4 st_v0, st_v1, st_k0, st_k1, st_k2;
            const unsigned voKV = (unsigned)(sr * 2048 + h * 256 + sc) * 2u, voKR = (unsigned)(kr * 64 + kc * 8) * 2u;
#define ALOAD(kb_) do { const unsigned t0_ = (unsigned)tb0 + (unsigned)(kb_); \
                st_v0 = __builtin_amdgcn_raw_buffer_load_b128(rsKV, voKV + 256u, t0_ * 4096u, 0); st_v1 = __builtin_amdgcn_raw_buffer_load_b128(rsKV, voKV + 256u, (t0_ + 32u) * 4096u, 0); \
                st_k0 = __builtin_amdgcn_raw_buffer_load_b128(rsKV, voKV, t0_ * 4096u, 0); st_k1 = __builtin_amdgcn_raw_buffer_load_b128(rsKV, voKV, (t0_ + 32u) * 4096u, 0); \
                st_k2 = __builtin_amdgcn_raw_buffer_load_b128(rsKR, voKR, t0_ * 128u, 0); } while (0)
#define AWRITE(bf) do { *(LAS u32x4*)(lds + (bf) * SHM_V + vst0) = st_v0; *(LAS u32x4*)(lds + (bf) * SHM_V + vst1) = st_v1; \
                *(LAS u32x4*)(K_lds + (bf) * SHM_K + kw0) = st_k0; *(LAS u32x4*)(K_lds + (bf) * SHM_K + kw1) = st_k1; *(LAS u32x4*)(K_lds + (bf) * SHM_K + kw2) = st_k2; } while (0)
#define RESC(a_) do { if (__any((a_) < 1.f)) { if (hi == 0) al_l[r32] = (a_); asm volatile("s_waitcnt lgkmcnt(0)" ::: "memory"); \
                _Pragma("unroll") for (int d_ = 0; d_ < 4; ++d_) _Pragma("unroll") for (int r = 0; r < 16; ++r) o[d_][r] *= al_l[crow(r, hi)]; } } while (0)
#define ASTEP(t, BF) do { f32x16 p0, p1; float mn, al; bf16x8 pa0, pa1, pa2, pa3; const int kb_ = (t) * KVB; \
                if ((t) + 1 < NT) ALOAD(kb_ + KVB); \
                ASBAR(); qkt<BF>(p0, p1, kbp, qr); \
                if (kb_ + KVB - 1 > qlo) mask_tile(p0, p1, qm - kb_); \
                partialSM(p0, p1, m_reg, mn, al); RESC(al); finishSM(p0, p1, al, l_reg, pa0, pa1, pa2, pa3); ASBAR(); \
                pv_tile<BF>(o, vb0, pa0, pa1, pa2, pa3); \
                if ((t) + 1 < NT) { asm volatile("s_waitcnt vmcnt(0)" ::: "memory"); AWRITE((BF) ^ 1); } \
                __syncthreads(); } while (0)
            __syncthreads();
            ALOAD(0); asm volatile("s_waitcnt vmcnt(0)" ::: "memory"); AWRITE(0);
            __syncthreads();
            for (int t = 0; t < NT; t += 2) { ASTEP(t, 0); ASTEP(t + 1, 1); }
            if (hi == 0) li_l[r32] = l_reg;
            asm volatile("s_waitcnt lgkmcnt(0)" ::: "memory");
            int r32e = r32, hie = hi; asm volatile("" : "+v"(r32e), "+v"(hie));
            bf16_t* Ow = AO + (tb0 + P0 + wid * 32) * D + h * 128 + r32e;
#pragma unroll
            for (int r = 0; r < 16; ++r) { const int orow = (r & 3) + 8 * (r >> 2) + 4 * hie; const float rl = __builtin_amdgcn_rcpf(li_l[orow]);
#pragma unroll
                for (int d0 = 0; d0 < 4; ++d0) { const float v = o[d0][r] * rl; const float vn = __shfl_xor(v, 1);
                    if ((r32e & 1) == 0) *(unsigned*)(Ow + (size_t)orow * D + d0 * 32) = cvtpk(v, vn); } }
#undef ALOAD
#undef AWRITE
#undef RESC
#undef ASTEP
        }
    }
    __syncthreads();
}

__device__ __forceinline__ void phase_c1(LAS unsigned char* lds, int wv, int l) {
    const Args a = oargs(); unsigned char* ws = a.ws;
    const pg8::Gemm g{(const bf16_t*)(ws + WS_HA), (const bf16_t*)(ws + WS_WIN) + (size_t)l * 2048 * 1024, T, 2048, D};
    pg8::StaticOrder S; S.init(T, 2048, (int)gridDim.x, (int)blockIdx.x);
    pg8::gemm_phase<pg8::EpiGated<0>, pg8::StaticOrder, true, true, false>(lds, wv, g, S, pg8::EpiGated<0>{(bf16_t*)(ws + WS_U), D, 0xffff, (const float*)a.in[8] + l * 2048});
}
__device__ __forceinline__ void phase_resid(LAS unsigned char* lds, int wv, int l, size_t a_off, size_t w_off) {
    const Args a = oargs(); unsigned char* ws = a.ws;
    const pg8::Gemm g{(const bf16_t*)(ws + a_off), (const bf16_t*)(ws + w_off), T, D, D};
    pg8::StaticOrder S; S.init(T, D, (int)gridDim.x, (int)blockIdx.x);
    pg8::gemm_phase<pg8::EpiResid, pg8::StaticOrder, true, true, false>(lds, wv, g, S, pg8::EpiResid{(bf16_t*)(ws + WS_X16), (const float*)(ws + WS_MOD) + (size_t)l * 4 * 6144 + 2048});
}
__device__ __forceinline__ void phase_a1(LAS unsigned char* lds, int wv, int j) {
    const Args a = oargs(); unsigned char* ws = a.ws;
    { const pg8::Gemm g{(const bf16_t*)(ws + WS_HA), (const bf16_t*)(ws + WS_WDQ) + (size_t)j * 512 * D, T, 512, D};
      pg8::StaticOrder S; S.init(T, 512, (int)gridDim.x, (int)blockIdx.x);
      pg8::gemm_phase<pg8::EpiF32, pg8::StaticOrder, true, true, false>(lds, wv, g, S, pg8::EpiF32{(float*)(ws + WS_CQRAW), QR, QR}); }
    if (j == 0) { const pg8::Gemm g{(const bf16_t*)(ws + WS_XKV), (const bf16_t*)(ws + WS_WDKV), T, 512, D};
      pg8::StaticOrder S; S.init(T, 512, (int)gridDim.x, (int)((blockIdx.x + gridDim.x / 2) % gridDim.x));
      pg8::gemm_phase<pg8::EpiF32, pg8::StaticOrder, true, true, false>(lds, wv, g, S, pg8::EpiF32{(float*)(ws + WS_CKVRAW), 320, 320}); }
}
__device__ __forceinline__ void phase_a2(LAS unsigned char* lds, int wv, int j) {
    const Args a = oargs(); unsigned char* ws = a.ws;
    { const pg8::Gemm g{(const bf16_t*)(ws + WS_CQ), (const bf16_t*)(ws + WS_WUQ) + (size_t)j * 1536 * QR, T, 1536, QR};
      pg8::StaticOrder S; S.init(T, 1536, (int)gridDim.x, (int)blockIdx.x);
      pg8::gemm_phase<pg8::EpiBf16, pg8::StaticOrder, true, true, false>(lds, wv, g, S, pg8::EpiBf16{(bf16_t*)(ws + WS_Q), 1536, 0xffff}); }
    if (j == 0) { const pg8::Gemm g{(const bf16_t*)(ws + WS_LAT), (const bf16_t*)(ws + WS_WUKV), T, 2048, KVR};
      pg8::StaticOrder S; S.init(T, 2048, (int)gridDim.x, (int)((blockIdx.x + gridDim.x / 2) % gridDim.x));
      pg8::gemm_phase<pg8::EpiBf16, pg8::StaticOrder, true, true, false>(lds, wv, g, S, pg8::EpiBf16{(bf16_t*)(ws + WS_KV), 2048, 0xffff}); }
}

constexpr int PH_PER_LAYER = 9, NPHASE = 2 + DEPTH * PH_PER_LAYER;
__global__ void __launch_bounds__(NTHREADS, 2) fwd(Args a) {
    extern __shared__ __attribute__((aligned(16))) unsigned char lds_raw[];
    LAS unsigned char* lds = (LAS unsigned char*)lds_raw;
    const int lo = a.ph_lo, hi = a.ph_hi;
    volatile LAS unsigned* misc = (volatile LAS unsigned*)(lds + LDS_MISC);
    const int wv = __builtin_amdgcn_readfirstlane((int)(threadIdx.x >> 6));
    if (threadIdx.x < 32) misc[threadIdx.x] = 0u;
    __syncthreads();
    if (hi - lo > 1) (void)xcd_barrier_post((unsigned*)(a.ws + WS_CTL) + CW_BAR, misc + 8);
#define IN(k) (lo <= (k) && (k) < hi)
#define SEAM(k) do { if ((k) + 1 < hi) { XcdBarrier bb_; bb_.bar = (unsigned*)(oargs().ws + WS_CTL) + CW_BAR; bb_.x = xb_xcc_id(); bb_.st = misc + 8; xcd_barrier(bb_, otid(wv) == 0); } } while (0)

    if (IN(0)) { phase_prologue(lds, wv); SEAM(0); }
    if (IN(1)) { phase_mod0(wv); SEAM(1); }
#pragma unroll 1
    for (int l = 0; l < DEPTH; ++l) {
        const int pb = 2 + PH_PER_LAYER * l;
        if (l < 2) {
            if (IN(pb + 0)) { phase_c1(lds, wv, l); SEAM(pb + 0); }
            if (IN(pb + 1)) { phase_conv(lds, wv, l); SEAM(pb + 1); }
            if (IN(pb + 2)) { phase_resid(lds, wv, l, WS_V2, WS_WOUT + (size_t)l * D * D * 2); SEAM(pb + 2); }
        } else {
            const int j = l - 2;
            if (IN(pb + 0)) { phase_a1(lds, wv, j); SEAM(pb + 0); }
            if (IN(pb + 1)) { phase_mla_norm(wv, j); SEAM(pb + 1); }
            if (IN(pb + 2)) { phase_a2(lds, wv, j); SEAM(pb + 2); }
            if (IN(pb + 3)) { phase_attn(lds, wv); SEAM(pb + 3); }
            if (IN(pb + 4)) { phase_resid(lds, wv, l, WS_AO, WS_WO + (size_t)j * D * D * 2); SEAM(pb + 4); }
        }
        if (IN(pb + 5)) { phase_route(lds, wv, l); SEAM(pb + 5); }
        if (IN(pb + 6)) { phase_moe_up(lds, wv, l); SEAM(pb + 6); }
        if (IN(pb + 7)) { phase_moe_down(lds, wv, l); SEAM(pb + 7); }
        if (IN(pb + 8)) { phase_combine(lds, wv, l); SEAM(pb + 8); }
    }
#undef IN
#undef SEAM
}

extern "C" void kernel_launch(void* const* d_in, const int* in_sizes, int n_in, void* d_out, int out_size, void* d_ws, size_t ws_size, hipStream_t stream) {
    static int grid = 0;
    if (grid == 0) {
        if (n_in != 28 || out_size != T * D || ws_size < WS_END) { fprintf(stderr, "kernel_launch: unexpected shapes (n_in %d out %d ws %zu)\n", n_in, out_size, ws_size); grid = -1; return; }
        int dev = 0, cus = 0, per_cu = 0;
        if (hipGetDevice(&dev) != hipSuccess || hipDeviceGetAttribute(&cus, hipDeviceAttributeMultiprocessorCount, dev) != hipSuccess) { grid = -1; return; }
        if (hipFuncSetAttribute((const void*)fwd, hipFuncAttributeMaxDynamicSharedMemorySize, LDS_BYTES) != hipSuccess) { fprintf(stderr, "kernel_launch: hipFuncSetAttribute failed\n"); grid = -1; return; }
        if (hipOccupancyMaxActiveBlocksPerMultiprocessor(&per_cu, (const void*)fwd, NTHREADS, LDS_BYTES) != hipSuccess || per_cu < 1) fprintf(stderr, "kernel_launch: occupancy query reports %d\n", per_cu);
        (void)hipGetLastError();
        grid = cus;
    }
    if (grid < 0) return;
    (void)hipMemsetAsync((char*)d_ws + WS_CTL, 0, CTL_BYTES, stream);
    Args a{};
    for (int i = 0; i < 28; ++i) a.in[i] = d_in[i];
    a.out = (float*)d_out; a.ws = (unsigned char*)d_ws;
#if MK_ONE_LAUNCH
    a.ph_lo = 0; a.ph_hi = NPHASE;
    hipLaunchKernelGGL(fwd, dim3(grid), dim3(NTHREADS), LDS_BYTES, stream, a);
#else
    for (int ph = 0; ph < NPHASE; ++ph) {
        if (ph >= 2) { const int l = (ph - 2) / PH_PER_LAYER, k = (ph - 2) % PH_PER_LAYER; if (l < 2 && (k == 3 || k == 4)) continue; }
        a.ph_lo = ph; a.ph_hi = ph + 1;
        hipLaunchKernelGGL(fwd, dim3(grid), dim3(NTHREADS), LDS_BYTES, stream, a);
    }
#endif
}
```

```cpp
#include <hip/hip_runtime.h>
#include <cstdio>
#include <cstdint>

#define LAS __attribute__((address_space(3)))
typedef unsigned short bf16_t;
typedef short bf16x8 __attribute__((ext_vector_type(8)));
typedef float f32x4 __attribute__((ext_vector_type(4)));
typedef float f32x2 __attribute__((ext_vector_type(2)));
typedef unsigned u32x4 __attribute__((ext_vector_type(4)));
typedef unsigned u32x2 __attribute__((ext_vector_type(2)));

#ifndef MK_ONE_LAUNCH
#define MK_ONE_LAUNCH 1
#endif

constexpr int NB = 4, SEQ = 4096, T = NB * SEQ, D = 1024, DEPTH = 4;
constexpr int CWID = 31, NH = 8, DQK = 192, QR = 384, KVR = 256;
constexpr int NE = 16, DE = 512;
constexpr float EPS = 1e-6f;
constexpr float ATTN_SCALE = 0.07216878364870322f;

constexpr size_t MiB = 1u << 20;
constexpr size_t WS_CTL = 0, CTL_BYTES = 1 * MiB;
constexpr size_t WS_MOD = 1 * MiB;
constexpr size_t WS_ROPE = 2 * MiB;
constexpr size_t WS_TOKINFO = 6 * MiB;
constexpr size_t WS_LIST = 7 * MiB;
constexpr size_t WS_WIN = 8 * MiB;
constexpr size_t WS_WOUT = 16 * MiB;
constexpr size_t WS_WDKV = 20 * MiB;
constexpr size_t WS_WUKV = 21 * MiB;
constexpr size_t WS_WDQ = 22 * MiB;
constexpr size_t WS_WUQ = 24 * MiB;
constexpr size_t WS_WO = 27 * MiB;
constexpr size_t WS_WGU = 32 * MiB;
constexpr size_t WS_WDN = 160 * MiB;
constexpr size_t WS_HA = 224 * MiB;
constexpr size_t WS_XKV = 256 * MiB;
constexpr size_t WS_U = 288 * MiB;
constexpr size_t WS_H2 = WS_U;
constexpr size_t WS_V2 = 320 * MiB;
constexpr size_t WS_AO = WS_V2;
constexpr size_t WS_YB = 352 * MiB;
constexpr size_t WS_CQRAW = 352 * MiB;
constexpr size_t WS_CKVRAW = 376 * MiB;
constexpr size_t WS_CQ = 396 * MiB;
constexpr size_t WS_LAT = 408 * MiB;
constexpr size_t WS_KROPE = 424 * MiB;
constexpr size_t WS_Q = 426 * MiB;
constexpr size_t WS_ACT = WS_Q;
constexpr size_t WS_KV = 474 * MiB;
constexpr size_t WS_X16 = 538 * MiB;
constexpr size_t WS_END = 570 * MiB;
constexpr int NSLOT_MAX = 2 * T + NE * 256;

constexpr int CW_BAR = 4096;
constexpr int CW_CNT = 16384;

constexpr int LDS_BYTES = 147456;
constexpr int LDS_EXTRA = 131072;
constexpr int LDS_MISC = LDS_EXTRA + 320;
constexpr int LDS_TB = LDS_EXTRA + 512;
constexpr int LDS_TOK = LDS_EXTRA + 1024;
constexpr int NTHREADS = 512;

#define XB_TMO      128
#define XB_XCNT(j)  (256  + 64 * (j))
#define XB_XSUB(j)  (1280 + 64 * (j))
#define XB_XGEN(j)  (2304 + 64 * (j))
#define XB_TOP      3328
#define XB_TOPGEN   3392
#define XCD_BAR_WORDS 3456
#define XB_SPIN_CAP (1u << 18)

__device__ __forceinline__ unsigned xb_ld(unsigned* p)              { return __hip_atomic_load(p, __ATOMIC_RELAXED, __HIP_MEMORY_SCOPE_AGENT); }
__device__ __forceinline__ unsigned xb_add(unsigned* p, unsigned v) { return __hip_atomic_fetch_add(p, v, __ATOMIC_RELAXED, __HIP_MEMORY_SCOPE_AGENT); }
__device__ __forceinline__ unsigned xb_xcc_id() { return (unsigned)__builtin_amdgcn_s_getreg((3 << 11) | 20) & 0xFu; }
#define XB_SPIN(cond, bar) do { unsigned _sp = 0; while (cond) { __builtin_amdgcn_s_sleep(1); \
    if ((++_sp & 255u) == 0u) { if (xb_ld(&(bar)[XB_TMO])) break; if (_sp > XB_SPIN_CAP) { atomicAdd(&(bar)[XB_TMO], 1u); break; } } } } while (0)

struct XcdBarrier { unsigned* bar; unsigned x; volatile LAS unsigned* st; };

__device__ __forceinline__ XcdBarrier xcd_barrier_post(unsigned* bar, volatile LAS unsigned* st) {
    XcdBarrier b; b.bar = bar; b.x = xb_xcc_id(); b.st = st;
    if (threadIdx.x == 0) (void)xb_add(&bar[XB_XCNT(b.x)], 1u);
    return b;
}
__device__ __forceinline__ void xcd_barrier_complete(unsigned* bar, unsigned x, unsigned& nloc, unsigned& nx) {
    const unsigned G = gridDim.x * gridDim.y * gridDim.z;
    unsigned sum, cnt, mine, sp = 0u;
    for (;;) {
        sum = 0u; cnt = 0u; mine = 0u;
#pragma unroll
        for (unsigned j = 0; j < 16; ++j) { const unsigned c = xb_ld(&bar[XB_XCNT(j)]); sum += c; cnt += (c > 0u) ? 1u : 0u; mine = (j == x) ? c : mine; }
        if (sum == G) break;
        __builtin_amdgcn_s_sleep(1);
        if ((++sp & 255u) == 0u) { if (xb_ld(&bar[XB_TMO])) break; if (sp > XB_SPIN_CAP) { atomicAdd(&bar[XB_TMO], 1u); break; } }
    }
    nloc = mine > 0u ? mine : 1u; nx = cnt > 0u ? cnt : 1u;
}
__device__ __forceinline__ void xcd_barrier(const XcdBarrier& b, bool leader) {
    asm volatile("s_waitcnt vmcnt(0)" ::: "memory");
    __syncthreads();
    if (leader) {
        unsigned* bar = b.bar;
        __builtin_amdgcn_s_waitcnt(0);
        unsigned nloc = b.st[0], nx = b.st[1];
        if (nloc == 0u) { xcd_barrier_complete(bar, b.x, nloc, nx); b.st[0] = nloc; b.st[1] = nx; }
        const unsigned old = xb_add(&bar[XB_XSUB(b.x)], 1u);
        const unsigned gen = old / nloc;
        if (old + 1u == (gen + 1u) * nloc) {
            __builtin_amdgcn_fence(__ATOMIC_RELEASE, "agent");
            asm volatile("s_waitcnt vmcnt(0)" ::: "memory");
            const unsigned og = xb_add(&bar[XB_TOP], 1u);
            const unsigned tg = og / nx;
            if (og + 1u == (tg + 1u) * nx) xb_add(&bar[XB_TOPGEN], 1u);
            else XB_SPIN(xb_ld(&bar[XB_TOPGEN]) == tg, bar);
            __builtin_amdgcn_fence(__ATOMIC_ACQUIRE, "agent");
            xb_add(&bar[XB_XGEN(b.x)], 1u);
            asm volatile("s_waitcnt vmcnt(0)" ::: "memory");
        } else {
            XB_SPIN(xb_ld(&bar[XB_XGEN(b.x)]) == gen, bar);
            __builtin_amdgcn_fence(__ATOMIC_ACQUIRE, "agent");
            asm volatile("s_waitcnt vmcnt(0)" ::: "memory");
        }
    }
    __syncthreads();
}

__device__ __forceinline__ unsigned f2bf(float f) { unsigned u = __builtin_bit_cast(unsigned, f); return (u + 0x7fffu + ((u >> 16) & 1u)) >> 16; }
__device__ __forceinline__ unsigned pk2(float lo, float hi) { unsigned r; asm("v_cvt_pk_bf16_f32 %0, %1, %2" : "=v"(r) : "v"(lo), "v"(hi)); return r; }
__device__ __forceinline__ float bf2f(unsigned short b) { return __builtin_bit_cast(float, (unsigned)b << 16); }
__device__ __forceinline__ float bflo(unsigned w) { return __builtin_bit_cast(float, w << 16); }
__device__ __forceinline__ float bfhi(unsigned w) { return __builtin_bit_cast(float, w & 0xffff0000u); }
__device__ __forceinline__ void swap32(float v, float& a, float& b) { unsigned x = __builtin_bit_cast(unsigned, v), y = x; asm volatile("" : "+v"(y));
    auto rr = __builtin_amdgcn_permlane32_swap(x, y, false, false); unsigned a_ = rr[0], b_ = rr[1]; asm volatile("" : "+v"(a_), "+v"(b_)); a = __builtin_bit_cast(float, a_); b = __builtin_bit_cast(float, b_); }
__device__ __forceinline__ void swap16(float v, float& a, float& b) { unsigned x = __builtin_bit_cast(unsigned, v), y = x; asm volatile("" : "+v"(y));
    auto rr = __builtin_amdgcn_permlane16_swap(x, y, false, false); unsigned a_ = rr[0], b_ = rr[1]; asm volatile("" : "+v"(a_), "+v"(b_)); a = __builtin_bit_cast(float, a_); b = __builtin_bit_cast(float, b_); }
__device__ __forceinline__ void swap32x(float d, float s_, float& a, float& b) { unsigned x = __builtin_bit_cast(unsigned, d), y = __builtin_bit_cast(unsigned, s_);
    auto rr = __builtin_amdgcn_permlane32_swap(x, y, false, false); unsigned a_ = rr[0], b_ = rr[1]; asm volatile("" : "+v"(a_), "+v"(b_)); a = __builtin_bit_cast(float, a_); b = __builtin_bit_cast(float, b_); }
__device__ __forceinline__ void swap16x(float d, float s_, float& a, float& b) { unsigned x = __builtin_bit_cast(unsigned, d), y = __builtin_bit_cast(unsigned, s_);
    auto rr = __builtin_amdgcn_permlane16_swap(x, y, false, false); unsigned a_ = rr[0], b_ = rr[1]; asm volatile("" : "+v"(a_), "+v"(b_)); a = __builtin_bit_cast(float, a_); b = __builtin_bit_cast(float, b_); }
__device__ __forceinline__ float row16_sum(float v);
__device__ __forceinline__ float dpp_add(float v, int ctrl_sel) {
    int r;
    if (ctrl_sel == 0) r = __builtin_amdgcn_update_dpp(0, __builtin_bit_cast(int, v), 0xB1, 0xf, 0xf, true);
    else if (ctrl_sel == 1) r = __builtin_amdgcn_update_dpp(0, __builtin_bit_cast(int, v), 0x4E, 0xf, 0xf, true);
    else if (ctrl_sel == 2) r = __builtin_amdgcn_update_dpp(0, __builtin_bit_cast(int, v), 0x141, 0xf, 0xf, true);
    else r = __builtin_amdgcn_update_dpp(0, __builtin_bit_cast(int, v), 0x140, 0xf, 0xf, true);
    return v + __builtin_bit_cast(float, r);
}
__device__ __forceinline__ float row16_sum(float v) { v = dpp_add(v, 0); v = dpp_add(v, 1); v = dpp_add(v, 2); v = dpp_add(v, 3); return v; }
__device__ __forceinline__ float wave_sum(float v) {
    v = dpp_add(v, 0); v = dpp_add(v, 1); v = dpp_add(v, 2); v = dpp_add(v, 3);
    float a, b; swap16(v, a, b); v = a + b; swap32(v, a, b); v = a + b;
    return v;
}
__device__ __forceinline__ float sigmoidf_(float x) { return 1.0f / (1.0f + __expf(-x)); }
__device__ __forceinline__ float siluf_(float x) { return x / (1.0f + __expf(-x)); }

struct Args { const void* in[28]; float* out; unsigned char* ws; int ph_lo, ph_hi; };
__device__ __forceinline__ int otid(int wv) { int t; asm volatile("v_mbcnt_lo_u32_b32 %0, -1, 0\n\tv_mbcnt_hi_u32_b32 %0, -1, %0" : "=v"(t)); return (wv << 6) + t; }
#define CAS __attribute__((address_space(4)))
__device__ __forceinline__ Args oargs() {
    const CAS Args* q = (const CAS Args*)__builtin_amdgcn_kernarg_segment_ptr(); asm volatile("" : "+s"(q));
    Args r;
#pragma unroll
    for (int i = 0; i < 28; ++i) r.in[i] = q->in[i];
    r.out = q->out; r.ws = q->ws; r.ph_lo = q->ph_lo; r.ph_hi = q->ph_hi; return r;
}
template <class P> __device__ __forceinline__ P* opq(P* p) { asm volatile("" : "+s"(p)); return p; }

namespace pg8 {
#define PG8_LAS __attribute__((address_space(3)))
constexpr int BM = 256, BK = 64, HALF = 128, HTB = HALF * BK * 2, STAGE_BYTES = 8 * HTB, NXCD = 8, WGM = 8;
__host__ __device__ __forceinline__ int lds_byte(int r, int c) { const int st = (r >> 4) * 2 + (c >> 5), rr = r & 15, cc = c & 31, ob = rr * 64 + cc * 2; return st * 1024 + (ob ^ (((ob >> 9) & 1) << 5)); }
__host__ __device__ __forceinline__ void stage_rc(int b, int& R, int& C) { const int st = b / 1024, sb = b % 1024, swz = sb ^ (((sb >> 9) & 1) << 5); R = (st >> 1) * 16 + swz / 64; C = (st & 1) * 32 + (swz % 64) / 2; }
__host__ __device__ __forceinline__ int perm32(int rho) { const int n = rho >> 4, i = rho & 15; return 8 * (i >> 2) + 4 * n + (i & 3); }
struct Unit { int pm, pn; };
struct Gemm { const bf16_t* A; const bf16_t* Bt; int M, N, K; };
struct StaticOrder {
    int nM, nN, nwg, G, c;
    __host__ __device__ void init(int M, int N, int G_, int c_) { nM = M / BM; nN = N / BM; nwg = nM * nN; G = G_; c = c_; }
    __host__ __device__ bool next(int i, Unit& u) const {
        const long L = (long)i * G + c; if (L >= nwg) return false;
        int wgid = (int)L; { const int q = nwg / NXCD, r = nwg % NXCD, xcd = wgid % NXCD, off = wgid / NXCD; wgid = (xcd < r ? xcd * (q + 1) : r * (q + 1) + (xcd - r) * q) + off; }
        const int nig = WGM * nN, gid = wgid / nig, fm = gid * WGM, gsz = (nM - fm) < WGM ? (nM - fm) : WGM;
        u.pm = fm + ((wgid % nig) % gsz); u.pn = (wgid % nig) / gsz; return true;
    }
    __device__ __forceinline__ const PG8_LAS int* tok(int) const { return nullptr; }
};
struct MoeOrder {
    const PG8_LAS int* ul; const PG8_LAS int* toks;
    __device__ __forceinline__ bool next(int i, Unit& u) const {
        if (i >= __builtin_amdgcn_readfirstlane(ul[0])) return false;
        u.pm = __builtin_amdgcn_readfirstlane(ul[2 + 2 * i]); u.pn = __builtin_amdgcn_readfirstlane(ul[3 + 2 * i]); return true;
    }
    __device__ __forceinline__ const PG8_LAS int* tok(int ui) const { return toks + ui * 256; }
};
__device__ __forceinline__ void moe_unit_list(int wv, const PG8_LAS int* tb, PG8_LAS int* ul) {
    if (otid(wv) == 0) { const int G = gridDim.x, c = blockIdx.x, x = c & 7, idx = c >> 3; int n = 0;
        for (int i = 0; i < 12; ++i) { const int rt = i * (G >> 2) + (idx >> 2) * 8 + x; if (rt >= tb[16]) break;
            int e = 0; for (int q = 1; q < 16; ++q) e += (rt >= tb[q]) ? 1 : 0;
            ul[2 + 2 * n] = rt; ul[3 + 2 * n] = e * 4 + (idx & 3); ++n; }
        ul[0] = n; }
    __syncthreads();
}

template <class Epi, class Sched, bool ALIGN_EPI = false, bool SP2 = false, bool GATHER = false>
__device__ __forceinline__ void gemm_phase(PG8_LAS unsigned char* lds, int wv, const Gemm g, const Sched& S, const Epi& E) {
    const int tid = otid(wv), wid = __builtin_amdgcn_readfirstlane(tid >> 6), lane = tid & 63, wr = wid >> 2, wc = wid & 3, fr = lane & 15, fq = lane >> 4;
    int K_ = g.K; asm volatile("" : "+s"(K_));
    const int K = K_, nt = K / BK;
    unsigned voffA[2], voffB[2];
#pragma unroll
    for (int i = 0; i < 2; ++i) { int R, C; stage_rc(tid * 16 + i * 8192, R, C); const int Rb = Epi::PERM ? ((R & ~31) + perm32(R & 31)) : R;
        voffA[i] = (unsigned)(R * K + C) * 2u; voffB[i] = (unsigned)(Rb * K + C) * 2u; }
    const size_t kstep = (size_t)(BK * 2);
    const size_t hstep = (size_t)HALF * K * 2;
    const size_t tstep = 2 * hstep;
    const unsigned ldsw = (unsigned)wid * 1024u;
    const int aoff = lds_byte(wr * 64 + fr, fq * 8), boff = lds_byte(wc * 32 + fr, fq * 8);
#define PG8_SA(b, h) (((b) * 2 + (h)) * HTB)
#define PG8_SB(b, h) ((4 + (b) * 2 + (h)) * HTB)
#define PG8_STAGE(bufoff, gbase, voff) do { _Pragma("unroll") for (int _i = 0; _i < 2; ++_i) \
        __builtin_amdgcn_global_load_lds((const unsigned*)((const char*)(gbase) + (voff)[_i]), (PG8_LAS unsigned*)(lds + (bufoff) + ldsw + _i * 8192), 16, 0, 0); } while (0)
#define PG8_STAGE_A(bufoff, gbase, hh, VO) do { if constexpr (GATHER) { PG8_STAGE(bufoff, gbase, VO[hh]); } else { PG8_STAGE(bufoff, (gbase) + (hh) * hstep, voffA); } } while (0)
#define PG8_LDA(dst, b, h) do { _Pragma("unroll") for (int m = 0; m < 4; ++m) _Pragma("unroll") for (int k = 0; k < 2; ++k) dst[m][k] = *(const PG8_LAS bf16x8*)(lds + PG8_SA(b, h) + aoff + m * 2048 + k * 1024); } while (0)
#define PG8_LDB(dst, b, h) do { _Pragma("unroll") for (int n = 0; n < 2; ++n) _Pragma("unroll") for (int k = 0; k < 2; ++k) dst[n][k] = *(const PG8_LAS bf16x8*)(lds + PG8_SB(b, h) + boff + n * 2048 + k * 1024); } while (0)
#define PG8_MMA(ai, bj, At, Bt) do { __builtin_amdgcn_s_setprio(1); _Pragma("unroll") for (int m = 0; m < 4; ++m) _Pragma("unroll") for (int n = 0; n < 2; ++n) _Pragma("unroll") for (int k = 0; k < 2; ++k) \
        acc[ai][bj][m][n] = __builtin_amdgcn_mfma_f32_16x16x32_bf16(Bt[n][k], At[m][k], acc[ai][bj][m][n], 0, 0, 0); __builtin_amdgcn_s_setprio(0); } while (0)
#define PG8_WAIT_V(n) asm volatile("s_waitcnt vmcnt(" #n ")" ::: "memory")
#define PG8_WAIT_L(n) asm volatile("s_waitcnt lgkmcnt(" #n ")" ::: "memory")
#define PG8_BAR __builtin_amdgcn_s_barrier()
#define PG8_SCHED __builtin_amdgcn_sched_barrier(0)
#define PG8_GOFF(dst, tk) do { _Pragma("unroll") for (int _i = 0; _i < 2; ++_i) { int _R, _C; stage_rc(tid * 16 + _i * 8192, _R, _C); _Pragma("unroll") for (int _h = 0; _h < 2; ++_h) dst[_h][_i] = (unsigned)((tk)[_h * 128 + _R] * K + _C) * 2u; } } while (0)
    Unit cur, nxt; int ui = 0;
    if (!S.next(0, cur)) return;
    f32x4 acc[2][2][4][2];
#pragma unroll
    for (int a = 0; a < 2; ++a)
#pragma unroll
        for (int b = 0; b < 2; ++b)
#pragma unroll
            for (int m = 0; m < 4; ++m)
#pragma unroll
                for (int n = 0; n < 2; ++n) acc[a][b][m][n] = (f32x4){0.f, 0.f, 0.f, 0.f};
    bf16x8 At[4][2], B0[2][2], B1[2][2];
    unsigned gA[2][2] = {{0u, 0u}, {0u, 0u}}, gAn[2][2] = {{0u, 0u}, {0u, 0u}}, gS[2][2] = {{0u, 0u}, {0u, 0u}};
    if constexpr (GATHER) { PG8_GOFF(gA, S.tok(0)); }
    const char* cA = GATHER ? (const char*)g.A : (const char*)g.A + (size_t)cur.pm * tstep; const char* cB = (const char*)g.Bt + (size_t)cur.pn * tstep;
    if constexpr (SP2) {
        PG8_STAGE(PG8_SB(0, 0), cB, voffB); PG8_STAGE(PG8_SB(0, 1), cB + hstep, voffB); PG8_STAGE_A(PG8_SA(0, 0), cA, 0, gA); PG8_STAGE_A(PG8_SA(0, 1), cA, 1, gA);
        if (wr == 1) PG8_BAR;
        PG8_WAIT_V(2); PG8_BAR;
        PG8_STAGE(PG8_SB(1, 0), cB + kstep, voffB); PG8_STAGE_A(PG8_SA(1, 0), cA + kstep, 0, gA); PG8_STAGE(PG8_SB(1, 1), cB + hstep + kstep, voffB);
        PG8_WAIT_V(6); PG8_BAR;
    } else {
        PG8_STAGE(PG8_SB(0, 0), cB, voffB); PG8_STAGE_A(PG8_SA(0, 0), cA, 0, gA); PG8_STAGE(PG8_SB(0, 1), cB + hstep, voffB); PG8_STAGE_A(PG8_SA(0, 1), cA, 1, gA);
        if (wr == 1) PG8_BAR;
        PG8_WAIT_V(4); PG8_BAR;
        PG8_STAGE(PG8_SB(1, 0), cB + kstep, voffB); PG8_STAGE_A(PG8_SA(1, 0), cA + kstep, 0, gA); PG8_STAGE(PG8_SB(1, 1), cB + hstep + kstep, voffB);
        PG8_WAIT_V(6); PG8_BAR;
    }
    for (;;) {
        const bool has_next = S.next(ui + 1, nxt);
        const char* nA = GATHER ? (const char*)g.A : (has_next ? (const char*)g.A + (size_t)nxt.pm * tstep : cA); const char* nB = has_next ? (const char*)g.Bt + (size_t)nxt.pn * tstep : cB;
        if constexpr (GATHER) { if (has_next) { PG8_GOFF(gAn, S.tok(ui + 1)); } else {
#pragma unroll
            for (int _h = 0; _h < 2; ++_h)
#pragma unroll
                for (int _i = 0; _i < 2; ++_i) gAn[_h][_i] = gA[_h][_i]; } }
        for (int t = 0; t < nt; t += 2) {
            const bool last = (t == nt - 2);
            const char* a1 = cA + (size_t)(t + 1) * kstep;
            const char* a2 = last ? nA : cA + (size_t)(t + 2) * kstep; const char* b2 = last ? nB : cB + (size_t)(t + 2) * kstep;
            const char* a3 = a2 + kstep; const char* b3 = b2 + kstep;
            if constexpr (GATHER) {
#pragma unroll
                for (int _h = 0; _h < 2; ++_h)
#pragma unroll
                    for (int _i = 0; _i < 2; ++_i) gS[_h][_i] = last ? gAn[_h][_i] : gA[_h][_i]; }
            if constexpr (SP2) {
            PG8_LDB(B0, 0, 0); PG8_LDB(B1, 0, 1); PG8_SCHED; PG8_LDA(At, 0, 0); PG8_STAGE_A(PG8_SA(1, 1), a1, 1, gA);
            PG8_WAIT_V(8); PG8_WAIT_L(0); PG8_BAR; PG8_MMA(0, 0, At, B0); PG8_MMA(0, 1, At, B1); PG8_BAR; PG8_SCHED;
            PG8_LDA(At, 0, 1); PG8_STAGE(PG8_SB(0, 0), b2, voffB); PG8_STAGE(PG8_SB(0, 1), b2 + hstep, voffB); PG8_STAGE_A(PG8_SA(0, 0), a2, 0, gS);
            PG8_WAIT_V(8); PG8_WAIT_L(0); PG8_BAR; PG8_MMA(1, 0, At, B0); PG8_MMA(1, 1, At, B1); PG8_BAR; PG8_SCHED;
            PG8_LDB(B0, 1, 0); PG8_LDB(B1, 1, 1); PG8_SCHED; PG8_LDA(At, 1, 0); PG8_STAGE_A(PG8_SA(0, 1), a2, 1, gS);
            PG8_WAIT_V(8); PG8_WAIT_L(0); PG8_BAR; PG8_MMA(0, 0, At, B0); PG8_MMA(0, 1, At, B1); PG8_BAR; PG8_SCHED;
            PG8_LDA(At, 1, 1); PG8_STAGE(PG8_SB(1, 0), b3, voffB); PG8_STAGE(PG8_SB(1, 1), b3 + hstep, voffB); PG8_STAGE_A(PG8_SA(1, 0), a3, 0, gS);
            PG8_WAIT_V(8); PG8_WAIT_L(0); PG8_BAR; PG8_MMA(1, 0, At, B0); PG8_MMA(1, 1, At, B1); PG8_BAR; PG8_SCHED;
            } else {
            PG8_LDB(B0, 0, 0); PG8_SCHED; PG8_LDA(At, 0, 0); PG8_STAGE_A(PG8_SA(1, 1), a1, 1, gA);
            PG8_WAIT_L(8); PG8_BAR; PG8_WAIT_L(0); PG8_MMA(0, 0, At, B0); PG8_BAR; PG8_SCHED;
            PG8_LDB(B1, 0, 1); PG8_STAGE(PG8_SB(0, 0), b2, voffB);
            PG8_BAR; PG8_WAIT_L(0); PG8_MMA(0, 1, At, B1); PG8_BAR;
            PG8_LDA(At, 0, 1); PG8_STAGE_A(PG8_SA(0, 0), a2, 0, gS);
            PG8_BAR; PG8_WAIT_L(0); PG8_MMA(1, 0, At, B0); PG8_BAR; PG8_SCHED;
            PG8_STAGE(PG8_SB(0, 1), b2 + hstep, voffB);
            PG8_WAIT_V(6); PG8_BAR; PG8_MMA(1, 1, At, B1); PG8_BAR;
            PG8_LDB(B0, 1, 0); PG8_SCHED; PG8_LDA(At, 1, 0); PG8_STAGE_A(PG8_SA(0, 1), a2, 1, gS);
            PG8_WAIT_L(8); PG8_BAR; PG8_WAIT_L(0); PG8_MMA(0, 0, At, B0); PG8_BAR; PG8_SCHED;
            PG8_LDB(B1, 1, 1); PG8_STAGE(PG8_SB(1, 0), b3, voffB);
            PG8_BAR; PG8_WAIT_L(0); PG8_MMA(0, 1, At, B1); PG8_BAR;
            PG8_LDA(At, 1, 1); PG8_STAGE_A(PG8_SA(1, 0), a3, 0, gS);
            PG8_BAR; PG8_WAIT_L(0); PG8_MMA(1, 0, At, B0); PG8_BAR; PG8_SCHED;
            PG8_STAGE(PG8_SB(1, 1), b3 + hstep, voffB);
            PG8_WAIT_V(6); PG8_BAR; PG8_MMA(1, 1, At, B1); PG8_BAR;
            }
        }
        if constexpr (ALIGN_EPI) { if (wr == 0) PG8_BAR; }
        E(acc, cur, wr, wc, fr, fq);
        if (!has_next) break;
#pragma unroll
        for (int a = 0; a < 2; ++a)
#pragma unroll
            for (int b = 0; b < 2; ++b)
#pragma unroll
                for (int m = 0; m < 4; ++m)
#pragma unroll
                    for (int n = 0; n < 2; ++n) acc[a][b][m][n] = (f32x4){0.f, 0.f, 0.f, 0.f};
        cur = nxt; cA = nA; cB = nB; ++ui;
        if constexpr (GATHER) {
#pragma unroll
            for (int _h = 0; _h < 2; ++_h)
#pragma unroll
                for (int _i = 0; _i < 2; ++_i) gA[_h][_i] = gAn[_h][_i]; }
        if constexpr (ALIGN_EPI) { if (wr == 1) PG8_BAR; }
    }
    PG8_WAIT_V(0);
    if constexpr (!ALIGN_EPI) { if (wr == 0) PG8_BAR; }
    PG8_BAR;
#undef PG8_SA
#undef PG8_SB
#undef PG8_STAGE
#undef PG8_STAGE_A
#undef PG8_LDA
#undef PG8_LDB
#undef PG8_MMA
#undef PG8_WAIT_V
#undef PG8_WAIT_L
#undef PG8_BAR
#undef PG8_SCHED
#undef PG8_GOFF
}
__device__ __forceinline__ unsigned cvt_pk_bf16(float lo, float hi) { unsigned r; asm volatile("v_cvt_pk_bf16_f32 %0, %1, %2" : "=v"(r) : "v"(lo), "v"(hi)); return r; }
struct EpiBf16 {
    static constexpr bool PERM = true;
    bf16_t* O; int ldc, pnmask;
    __device__ __forceinline__ void operator()(const f32x4 (&acc)[2][2][4][2], const Unit& u, int wr, int wc, int fr, int fq) const {
        const int row0 = u.pm * BM + wr * 64 + fr, col0 = (u.pn & pnmask) * BM + wc * 32 + 8 * fq;
#pragma unroll
        for (int ai = 0; ai < 2; ++ai)
#pragma unroll
            for (int m = 0; m < 4; ++m) { bf16_t* rowp = O + (size_t)(row0 + ai * HALF + m * 16) * ldc + col0;
#pragma unroll
                for (int bj = 0; bj < 2; ++bj) { const f32x4 v0 = acc[ai][bj][m][0], v1 = acc[ai][bj][m][1];
                    u32x4 w; w.x = cvt_pk_bf16(v0[0], v0[1]); w.y = cvt_pk_bf16(v0[2], v0[3]); w.z = cvt_pk_bf16(v1[0], v1[1]); w.w = cvt_pk_bf16(v1[2], v1[3]);
                    *(u32x4*)(rowp + bj * HALF) = w; } }
    }
};
template <int MODE  > struct EpiGated {
    static constexpr bool PERM = true;
    bf16_t* O; int ldc, pnmask; const float* bias;
    __device__ __forceinline__ void operator()(const f32x4 (&acc)[2][2][4][2], const Unit& u, int wr, int wc, int fr, int fq) const {
        const int row0 = u.pm * BM + wr * 64 + fr, ch0 = (u.pn & pnmask) * HALF + wc * 32 + 8 * fq;
        f32x4 ba[2], bg[2];
#pragma unroll
        for (int n = 0; n < 2; ++n) { ba[n] = (f32x4){0.f, 0.f, 0.f, 0.f}; bg[n] = ba[n]; if (MODE == 0) { ba[n] = *(const f32x4*)(bias + ch0 + 4 * n); bg[n] = *(const f32x4*)(bias + 1024 + ch0 + 4 * n); } }
#pragma unroll
        for (int ai = 0; ai < 2; ++ai)
#pragma unroll
            for (int m = 0; m < 4; ++m) { float r[8];
#pragma unroll
                for (int n = 0; n < 2; ++n) { const f32x4 x = acc[ai][0][m][n] + ba[n], y = acc[ai][1][m][n] + bg[n];
#pragma unroll
                    for (int q = 0; q < 4; ++q) r[4 * n + q] = (MODE == 0) ? x[q] * sigmoidf_(y[q]) : siluf_(x[q]) * y[q]; }
                u32x4 w; w.x = cvt_pk_bf16(r[0], r[1]); w.y = cvt_pk_bf16(r[2], r[3]); w.z = cvt_pk_bf16(r[4], r[5]); w.w = cvt_pk_bf16(r[6], r[7]);
                *(u32x4*)(O + (size_t)(row0 + ai * HALF + m * 16) * ldc + ch0) = w; }
    }
};
struct EpiResid {
    static constexpr bool PERM = true;
    bf16_t* X; const float* gate;
    __device__ __forceinline__ void operator()(const f32x4 (&acc)[2][2][4][2], const Unit& u, int wr, int wc, int fr, int fq) const {
        const int row0 = u.pm * BM + wr * 64 + fr, col0 = u.pn * BM + wc * 32 + 8 * fq; const float* gp = gate + (size_t)((u.pm * BM) / SEQ) * 6144 + col0;
#pragma unroll
        for (int bj = 0; bj < 2; ++bj) { const f32x4 g0 = *(const f32x4*)(gp + bj * HALF), g1 = *(const f32x4*)(gp + bj * HALF + 4);
#pragma unroll
            for (int ai = 0; ai < 2; ++ai)
#pragma unroll
                for (int m = 0; m < 4; ++m) { bf16_t* p = X + (size_t)(row0 + ai * HALF + m * 16) * D + col0 + bj * HALF; const u32x4 o = *(const u32x4*)p;
                    const f32x4 a0 = acc[ai][bj][m][0], a1 = acc[ai][bj][m][1]; u32x4 w;
                    w.x = cvt_pk_bf16(bflo(o.x) + g0[0] * a0[0], bfhi(o.x) + g0[1] * a0[1]); w.y = cvt_pk_bf16(bflo(o.y) + g0[2] * a0[2], bfhi(o.y) + g0[3] * a0[3]);
                    w.z = cvt_pk_bf16(bflo(o.z) + g1[0] * a1[0], bfhi(o.z) + g1[1] * a1[1]); w.w = cvt_pk_bf16(bflo(o.w) + g1[2] * a1[2], bfhi(o.w) + g1[3] * a1[3]);
                    *(u32x4*)p = w; } }
    }
};
struct EpiF32 {
    static constexpr bool PERM = false;
    float* O; int ldc, ncols;
    __device__ __forceinline__ void operator()(const f32x4 (&acc)[2][2][4][2], const Unit& u, int wr, int wc, int fr, int fq) const {
        const int row0 = u.pm * BM + wr * 64 + fr, col0 = u.pn * BM + wc * 32 + 4 * fq;
#pragma unroll
        for (int bj = 0; bj < 2; ++bj)
#pragma unroll
            for (int n = 0; n < 2; ++n) { const int c = col0 + bj * HALF + n * 16;
                if (c < ncols) {
#pragma unroll
                    for (int ai = 0; ai < 2; ++ai)
#pragma unroll
                        for (int m = 0; m < 4; ++m) *(f32x4*)(O + (size_t)(row0 + ai * HALF + m * 16) * ldc + c) = acc[ai][bj][m][n]; } }
    }
};
}

__device__ __forceinline__ int pair_row(int ch, int half) { return (ch >> 7) * 256 + half * 128 + (ch & 127); }

template <int MODE>
__device__ __forceinline__ void cvt_item(const float* W, int K, int N, int ld, bf16_t* WT, int row_off_or_half, LAS float* scr, int item, int lane) {
    const int nblk = N / 32, kb = item / nblk, nb = item % nblk, k0 = 64 * kb, n0 = 32 * nb;
#pragma unroll 8
    for (int i = 0; i < 32; ++i) { const int kk = 2 * i + (lane >> 5); scr[kk * 33 + (lane & 31)] = W[(size_t)(k0 + kk) * ld + n0 + (lane & 31)]; }
    asm volatile("s_waitcnt lgkmcnt(0)" ::: "memory");
    const int c = lane & 7;
#pragma unroll
    for (int j = 0; j < 4; ++j) { const int n = (lane >> 3) + 8 * j; const LAS float* s = scr + (8 * c) * 33 + n;
        u32x4 o; o.x = pk2(s[0 * 33], s[1 * 33]); o.y = pk2(s[2 * 33], s[3 * 33]); o.z = pk2(s[4 * 33], s[5 * 33]); o.w = pk2(s[6 * 33], s[7 * 33]);
        const int drow = (MODE == 0) ? (row_off_or_half + n0 + n) : pair_row(n0 + n, row_off_or_half);
        *(u32x4*)(WT + (size_t)drow * K + k0 + 8 * c) = o; }
    asm volatile("s_waitcnt lgkmcnt(0)" ::: "memory");
}

__device__ __forceinline__ void phase_prologue(LAS unsigned char* lds, int wv) {
    const Args a = oargs();
    const int tid = otid(wv), lane = tid & 63, wave = tid >> 6, G = gridDim.x;
    unsigned char* ws = a.ws;
    {
        const float* c = (const float*)a.in[1]; const float* ada_w = (const float*)a.in[3]; const float* ada_b = (const float*)a.in[4];
        float* mod = (float*)(ws + WS_MOD);
        LAS float* cs = (LAS float*)lds;
        LAS float* red = cs + 4096;
        bool have = false;
        for (int it = blockIdx.x; it < 4 * 48; it += G) {
            if (!have) { for (int i = tid; i < 4096; i += NTHREADS) cs[i] = siluf_(c[i]); have = true; }
            __syncthreads();
            const int l = it / 48, n0 = (it % 48) * 128;
            const float* wp = ada_w + (size_t)l * D * 6144 + n0 + 2 * lane;
            float acc[4][2] = {{0.f, 0.f}, {0.f, 0.f}, {0.f, 0.f}, {0.f, 0.f}};
            const int kb = wave * 128;
#pragma unroll 4
            for (int k = 0; k < 128; ++k) {
                const f32x2 w = *(const f32x2*)(wp + (size_t)(kb + k) * 6144);
#pragma unroll
                for (int b = 0; b < 4; ++b) { const float cv = cs[b * 1024 + kb + k]; acc[b][0] += cv * w.x; acc[b][1] += cv * w.y; }
            }
#pragma unroll
            for (int b = 0; b < 4; ++b) { red[(wave * 4 + b) * 128 + 2 * lane] = acc[b][0]; red[(wave * 4 + b) * 128 + 2 * lane + 1] = acc[b][1]; }
            __syncthreads();
            { const int b = tid >> 7, col = tid & 127; float s = 0.f;
#pragma unroll
              for (int w = 0; w < 8; ++w) s += red[(w * 4 + b) * 128 + col];
              mod[((size_t)l * 4 + b) * 6144 + n0 + col] = s + ada_b[l * 6144 + n0 + col]; }
        }
        __syncthreads();
    }
    {
        const int* pos = (const int*)a.in[2]; f32x2* rt = (f32x2*)(ws + WS_ROPE);
        for (int idx = blockIdx.x * NTHREADS + tid; idx < T * 32; idx += G * NTHREADS) {
            const int t = idx >> 5, i = idx & 31;
            const float inv = exp2f(-(float)i * (13.287712379549449f / 32.0f));
            const float ang = (float)pos[t] * inv;
            const float kf = rintf(ang * 0.15915494309189535f);
            float r = fmaf(-kf, 6.28125f, ang); r = fmaf(-kf, 1.9353071795864769e-3f, r);
            rt[idx] = (f32x2){__cosf(r), __sinf(r)};
        }
    }
    {
        LAS float* scr = (LAS float*)(lds + wave * 16384);
        const int gw = blockIdx.x * 8 + wave, NGW = G * 8;
        const float* w_in = (const float*)a.in[7]; const float* w_out = (const float*)a.in[13]; const float* w_dkv = (const float*)a.in[15]; const float* w_ukv = (const float*)a.in[17];
        const float* w_dq = (const float*)a.in[18]; const float* w_uq = (const float*)a.in[20]; const float* w_o = (const float*)a.in[21];
        const float* wg = (const float*)a.in[24]; const float* wu = (const float*)a.in[25]; const float* wd = (const float*)a.in[26];
        constexpr int I_IN = 16 * 64, I_OUT = 16 * 32, I_DKV = 16 * 10, I_UKV = 4 * 64, I_DQ = 16 * 12, I_UQ = 6 * 48, I_O = 16 * 32;
        constexpr int I_G = 16 * 16, I_D = 8 * 32;
        constexpr int NSMALL = 2 * I_IN + 2 * I_OUT + I_DKV + I_UKV + 2 * I_DQ + 2 * I_UQ + 2 * I_O;
        constexpr int NEXP = 4 * 16 * (2 * I_G + I_D);
        for (int it = gw; it < NSMALL + NEXP; it += NGW) {
            int r = it;
            if (r < 2 * I_IN) { const int l = r / I_IN; r %= I_IN; const int half = r / 512;
                cvt_item<1>(w_in + (size_t)l * D * 2048 + half * 1024, D, 1024, 2048, (bf16_t*)(ws + WS_WIN) + (size_t)l * 2048 * 1024, half, scr, r % 512, lane); continue; }
            r -= 2 * I_IN;
            if (r < 2 * I_OUT) { const int l = r / I_OUT; cvt_item<0>(w_out + (size_t)l * D * D, D, D, D, (bf16_t*)(ws + WS_WOUT) + (size_t)l * D * D, 0, scr, r % I_OUT, lane); continue; }
            r -= 2 * I_OUT;
            if (r < I_DKV) { cvt_item<0>(w_dkv, D, 320, 320, (bf16_t*)(ws + WS_WDKV), 0, scr, r, lane); continue; }
            r -= I_DKV;
            if (r < I_UKV) { cvt_item<0>(w_ukv, KVR, 2048, 2048, (bf16_t*)(ws + WS_WUKV), 0, scr, r, lane); continue; }
            r -= I_UKV;
            if (r < 2 * I_DQ) { const int j = r / I_DQ; cvt_item<0>(w_dq + (size_t)j * D * QR, D, QR, QR, (bf16_t*)(ws + WS_WDQ) + (size_t)j * 512 * D, 0, scr, r % I_DQ, lane); continue; }
            r -= 2 * I_DQ;
            if (r < 2 * I_UQ) { const int j = r / I_UQ; cvt_item<0>(w_uq + (size_t)j * QR * 1536, QR, 1536, 1536, (bf16_t*)(ws + WS_WUQ) + (size_t)j * 1536 * QR, 0, scr, r % I_UQ, lane); continue; }
            r -= 2 * I_UQ;
            if (r < 2 * I_O) { const int j = r / I_O; cvt_item<0>(w_o + (size_t)j * D * D, D, D, D, (bf16_t*)(ws + WS_WO) + (size_t)j * D * D, 0, scr, r % I_O, lane); continue; }
            r -= 2 * I_O;
            { const int per = 2 * I_G + I_D; const int le = r / per; r %= per;
              bf16_t* gu = (bf16_t*)(ws + WS_WGU) + (size_t)le * 1024 * 1024; bf16_t* dn = (bf16_t*)(ws + WS_WDN) + (size_t)le * 1024 * 512;
              if (r < I_G) cvt_item<1>(wg + (size_t)le * D * DE, D, DE, DE, gu, 0, scr, r, lane);
              else if (r < 2 * I_G) cvt_item<1>(wu + (size_t)le * D * DE, D, DE, DE, gu, 1, scr, r - I_G, lane);
              else cvt_item<0>(wd + (size_t)le * DE * D, DE, D, D, dn, 0, scr, r - 2 * I_G, lane); }
        }
        { const int gt = blockIdx.x * NTHREADS + tid, NT_ = G * NTHREADS; const u32x4 z = (u32x4){0u, 0u, 0u, 0u};
          u32x4* z0 = (u32x4*)((bf16_t*)(ws + WS_WDKV) + 320 * 1024); for (int i = gt; i < 192 * 1024 * 2 / 16; i += NT_) z0[i] = z;
          for (int j = 0; j < 2; ++j) { u32x4* z1 = (u32x4*)((bf16_t*)(ws + WS_WDQ) + (size_t)j * 512 * 1024 + 384 * 1024); for (int i = gt; i < 128 * 1024 * 2 / 16; i += NT_) z1[i] = z; } }
    }
}

__device__ __forceinline__ void row_load(const float* p, int lane, f32x4 (&v)[4]) {
#pragma unroll
    for (int j = 0; j < 4; ++j) v[j] = *(const f32x4*)(p + 4 * lane + 256 * j);
}
__device__ __forceinline__ float row_rstd(const f32x4 (&v)[4]) {
    float s = 0.f;
#pragma unroll
    for (int j = 0; j < 4; ++j) s += (v[j].x * v[j].x + v[j].y * v[j].y) + (v[j].z * v[j].z + v[j].w * v[j].w);
    return 1.0f / sqrtf(wave_sum(s) * (1.0f / D) + EPS);
}
__device__ __forceinline__ void row_modulate_store(const f32x4 (&v)[4], float r, const float* g, const float* sc, const float* sh, bf16_t* orow, int lane, f32x4 (*hout)[4] = nullptr) {
#pragma unroll
    for (int j = 0; j < 4; ++j) {
        const int c = 4 * lane + 256 * j;
        const f32x4 gv = *(const f32x4*)(g + c);
        f32x4 h = v[j] * r * gv;
        if (sc) { const f32x4 s1 = *(const f32x4*)(sc + c), s0 = *(const f32x4*)(sh + c); h = h * (s1 + 1.0f) + s0; }
        if (hout) (*hout)[j] = h;
        u32x2 o; o.x = pk2(h.x, h.y); o.y = pk2(h.z, h.w);
        *(u32x2*)(orow + c) = o;
    }
}

__device__ __forceinline__ void phase_mod0(int wv) {
    const Args a = oargs();
    const int tid_ = otid(wv); const int lane = tid_ & 63, gw = blockIdx.x * 8 + (tid_ >> 6), NGW = gridDim.x * 8;
    const float* x = (const float*)a.in[0]; const float* g = (const float*)a.in[5]; const float* mod = (const float*)(a.ws + WS_MOD);
    bf16_t* HA = (bf16_t*)(a.ws + WS_HA);
    for (int row = gw; row < T; row += NGW) {
        f32x4 v[4]; row_load(x + (size_t)row * D, lane, v);
#pragma unroll
        for (int j = 0; j < 4; ++j) { u32x2 o; o.x = pk2(v[j].x, v[j].y); o.y = pk2(v[j].z, v[j].w); *(u32x2*)((bf16_t*)(a.ws + WS_X16) + (size_t)row * D + 4 * lane + 256 * j) = o; }
        const float r = row_rstd(v); const int b = row / SEQ;
        row_modulate_store(v, r, g, mod + (size_t)b * 6144 + 1024, mod + (size_t)b * 6144, HA + (size_t)row * D, lane);
    }
}

typedef __bf16 bf16x2_t __attribute__((ext_vector_type(2)));
__device__ __forceinline__ float dot2bf(unsigned a, unsigned b, float c) { return __builtin_amdgcn_fdot2_f32_bf16(__builtin_bit_cast(bf16x2_t, a), __builtin_bit_cast(bf16x2_t, b), c, false); }
__device__ __forceinline__ void phase_conv(LAS unsigned char* lds, int wv, int l) {
    const Args a = oargs();
    const int tid = otid(wv), lane = tid & 63, wave = tid >> 6;
    const bf16_t* U = (const bf16_t*)(a.ws + WS_U); bf16_t* V2 = (bf16_t*)(a.ws + WS_V2);
    const float* w_dw = (const float*)a.in[9] + (size_t)l * CWID * D; const float* b_dw = (const float*)a.in[10] + l * D;
    const float* ln_g = (const float*)a.in[11] + l * D; const float* ln_b = (const float*)a.in[12] + l * D;
    constexpr int RC = 16, NR = RC + CWID - 1;
    LAS float* red = (LAS float*)lds;
    const int c = 2 * tid;
    unsigned pe0[16], po0[16], pe1[16], po1[16];
    { float w0[CWID], w1[CWID];
#pragma unroll
      for (int j = 0; j < CWID; ++j) { const f32x2 w = *(const f32x2*)(w_dw + (size_t)j * D + c); w0[j] = w.x; w1[j] = w.y; }
#pragma unroll
      for (int m = 0; m < 15; ++m) { pe0[m] = pk2(w0[2 * m], w0[2 * m + 1]); pe1[m] = pk2(w1[2 * m], w1[2 * m + 1]); po0[m + 1] = pk2(w0[2 * m + 1], w0[2 * m + 2]); po1[m + 1] = pk2(w1[2 * m + 1], w1[2 * m + 2]); }
      pe0[15] = pk2(w0[30], 0.f); pe1[15] = pk2(w1[30], 0.f); po0[0] = pk2(0.f, w0[0]); po1[0] = pk2(0.f, w1[0]); }
    const f32x2 bd = *(const f32x2*)(b_dw + c), lg = *(const f32x2*)(ln_g + c), lb = *(const f32x2*)(ln_b + c);
    for (int it = blockIdx.x; it < T / RC; it += gridDim.x) {
        const int b = it / (SEQ / RC), t0 = (it % (SEQ / RC)) * RC;
        const bf16_t* up = U + ((size_t)b * SEQ + t0 - (CWID - 1)) * D + c;
        unsigned W0[NR / 2], W1[NR / 2];
#pragma unroll
        for (int k = 0; k < NR / 2; ++k) { const int t = t0 - (CWID - 1) + 2 * k;
            unsigned la = 0u, lb_ = 0u; if (t >= 0) { la = *(const unsigned*)(up + (size_t)(2 * k) * D); lb_ = *(const unsigned*)(up + (size_t)(2 * k + 1) * D); }
            W0[k] = __builtin_amdgcn_perm(lb_, la, 0x05040100u); W1[k] = __builtin_amdgcn_perm(lb_, la, 0x07060302u); }
        float o0[RC], o1[RC];
#pragma unroll
        for (int i = 0; i < RC; ++i) { float s0 = bd.x, s1 = bd.y;
#pragma unroll
            for (int m = 0; m < 16; ++m) { const int k = (i >> 1) + m;
                if (i & 1) { s0 = dot2bf(W0[k], po0[m], s0); s1 = dot2bf(W1[k], po1[m], s1); } else { s0 = dot2bf(W0[k], pe0[m], s0); s1 = dot2bf(W1[k], pe1[m], s1); } }
            o0[i] = s0; o1[i] = s1; }
        __syncthreads();
#pragma unroll
        for (int t = 0; t < RC; ++t) { const float s = wave_sum(o0[t] + o1[t]); const float q = wave_sum(o0[t] * o0[t] + o1[t] * o1[t]);
            if (lane == 0) { red[(wave * RC + t) * 2] = s; red[(wave * RC + t) * 2 + 1] = q; } }
        __syncthreads();
#pragma unroll
        for (int t = 0; t < RC; ++t) { float s = 0.f, q = 0.f;
#pragma unroll
            for (int w = 0; w < 8; ++w) { s += red[(w * RC + t) * 2]; q += red[(w * RC + t) * 2 + 1]; }
            const float mean = s * (1.0f / D); const float var = fmaxf(q * (1.0f / D) - mean * mean, 0.f); const float rstd = 1.0f / sqrtf(var + EPS);
            const float y0 = (o0[t] - mean) * rstd * lg.x + lb.x, y1 = (o1[t] - mean) * rstd * lg.y + lb.y;
            *(unsigned*)(V2 + ((size_t)b * SEQ + t0 + t) * D + c) = pk2(siluf_(y0), siluf_(y1)); }
    }
    __syncthreads();
}

__device__ __forceinline__ float top2sum4(float a, float b, float c, float d) {
    return fmaxf(fmaxf(fmaxf(a + b, a + c), fmaxf(a + d, b + c)), fmaxf(b + d, c + d));
}
__device__ __forceinline__ void phase_route(LAS unsigned char* lds, int wv, int l) {
    const Args a = oargs();
    const int tid = otid(wv), lane = tid & 63, wave = tid >> 6, fr = lane & 15, fq = lane >> 4, G = gridDim.x;
    const bf16_t* X = (const bf16_t*)(a.ws + WS_X16); bf16_t* H2 = (bf16_t*)(a.ws + WS_H2);
    const float* g = (const float*)a.in[6] + l * D; const float* mod = (const float*)(a.ws + WS_MOD) + (size_t)l * 4 * 6144;
    const float* rw_g = (const float*)a.in[22]; const float* rb = (const float*)a.in[23];
    unsigned* cnt = (unsigned*)(a.ws + WS_CTL) + CW_CNT + 64 * l;
    int* list = (int*)(a.ws + WS_LIST); int* tokinfo = (int*)(a.ws + WS_TOKINFO);
    LAS unsigned char* Bhi = lds; LAS unsigned char* Blo = lds + 32768;
    LAS float* gam = (LAS float*)(lds + 65536); LAS float* shv = (LAS float*)(lds + 69632);
    LAS float* lgs = (LAS float*)(lds + 73728) + wave * 256;
    LAS float* sbs = (LAS float*)(lds + 81920) + wave * 512;
    LAS int* lcnt = (LAS int*)(lds + 98304);
    LAS int* sel = (LAS int*)(lds + 98560);
    const int RB = T / G, row0 = blockIdx.x * RB, b = row0 / SEQ;
    for (int c = tid; c < 2048; c += NTHREADS) { const int ks = c >> 6, ln = c & 63, e = ln & 15, q = ln >> 4; float w[8]; unsigned hi[4], lo[4];
#pragma unroll
        for (int j = 0; j < 8; ++j) w[j] = rw_g[(size_t)(32 * ks + 8 * q + j) * 16 + e];
#pragma unroll
        for (int j = 0; j < 4; ++j) { hi[j] = pk2(w[2 * j], w[2 * j + 1]); lo[j] = pk2(w[2 * j] - bflo(hi[j]), w[2 * j + 1] - bfhi(hi[j])); }
        *(LAS u32x4*)(Bhi + c * 16) = (u32x4){hi[0], hi[1], hi[2], hi[3]}; *(LAS u32x4*)(Blo + c * 16) = (u32x4){lo[0], lo[1], lo[2], lo[3]}; }
    for (int c = tid; c < 1024; c += NTHREADS) { gam[c] = g[c] * (1.0f + mod[(size_t)b * 6144 + 4 * 1024 + c]); shv[c] = mod[(size_t)b * 6144 + 3 * 1024 + c]; }
    if (tid < 32) lcnt[tid] = 0;
    __syncthreads();
    if (wave < RB / 16) {
        const int row = row0 + 16 * wave + fr; const bf16_t* xr = X + (size_t)row * D + 8 * fq;
        float ssq = 0.f;
#pragma unroll 8
        for (int ks = 0; ks < 32; ++ks) { const u32x4 xw = *(const u32x4*)(xr + 32 * ks); const f32x4 x0 = {bflo(xw.x), bfhi(xw.x), bflo(xw.y), bfhi(xw.y)}, x1 = {bflo(xw.z), bfhi(xw.z), bflo(xw.w), bfhi(xw.w)};
            ssq += (x0.x * x0.x + x0.y * x0.y) + (x0.z * x0.z + x0.w * x0.w) + (x1.x * x1.x + x1.y * x1.y) + (x1.z * x1.z + x1.w * x1.w); }
        { float a_, b_; swap16(ssq, a_, b_); ssq = a_ + b_; swap32(ssq, a_, b_); ssq = a_ + b_; }
        const float r = 1.0f / sqrtf(ssq * (1.0f / D) + EPS);
        f32x4 acc = {0.f, 0.f, 0.f, 0.f};
        bf16_t* hrow = H2 + (size_t)row * D + 8 * fq;
#pragma unroll 4
        for (int ks = 0; ks < 32; ++ks) {
            const u32x4 xw = *(const u32x4*)(xr + 32 * ks); const f32x4 x0 = {bflo(xw.x), bfhi(xw.x), bflo(xw.y), bfhi(xw.y)}, x1 = {bflo(xw.z), bfhi(xw.z), bflo(xw.w), bfhi(xw.w)};
            const f32x4 g0 = *(const LAS f32x4*)(gam + 32 * ks + 8 * fq), g1 = *(const LAS f32x4*)(gam + 32 * ks + 8 * fq + 4);
            const f32x4 s0 = *(const LAS f32x4*)(shv + 32 * ks + 8 * fq), s1 = *(const LAS f32x4*)(shv + 32 * ks + 8 * fq + 4);
            const f32x4 h0 = x0 * r * g0 + s0, h1 = x1 * r * g1 + s1;
            u32x4 hi; hi.x = pk2(h0.x, h0.y); hi.y = pk2(h0.z, h0.w); hi.z = pk2(h1.x, h1.y); hi.w = pk2(h1.z, h1.w);
            *(u32x4*)(hrow + 32 * ks) = hi;
            u32x4 lo; lo.x = pk2(h0.x - bflo(hi.x), h0.y - bfhi(hi.x)); lo.y = pk2(h0.z - bflo(hi.y), h0.w - bfhi(hi.y));
            lo.z = pk2(h1.x - bflo(hi.z), h1.y - bfhi(hi.z)); lo.w = pk2(h1.z - bflo(hi.w), h1.w - bfhi(hi.w));
            const bf16x8 bh = *(const LAS bf16x8*)(Bhi + (ks * 64 + lane) * 16), bl = *(const LAS bf16x8*)(Blo + (ks * 64 + lane) * 16);
            const bf16x8 ah = __builtin_bit_cast(bf16x8, hi), al = __builtin_bit_cast(bf16x8, lo);
            acc = __builtin_amdgcn_mfma_f32_16x16x32_bf16(ah, bh, acc, 0, 0, 0);
            acc = __builtin_amdgcn_mfma_f32_16x16x32_bf16(ah, bl, acc, 0, 0, 0);
            acc = __builtin_amdgcn_mfma_f32_16x16x32_bf16(al, bh, acc, 0, 0, 0);
        }
#pragma unroll
        for (int rg = 0; rg < 4; ++rg) lgs[(4 * fq + rg) * 16 + fr] = acc[rg];
        asm volatile("s_waitcnt lgkmcnt(0)" ::: "memory");
        const int rl = lane >> 2, gq = lane & 3;
        const f32x4 t4 = *(const LAS f32x4*)(lgs + rl * 16 + 4 * gq); const f32x4 rb4 = *(const f32x4*)(rb + 4 * gq);
        f32x4 s4, sb4;
#pragma unroll
        for (int e = 0; e < 4; ++e) { s4[e] = __builtin_amdgcn_rcpf(1.0f + __builtin_amdgcn_exp2f(-1.4426950408889634f * t4[e])); sb4[e] = s4[e] + rb4[e]; }
        const float gs = top2sum4(sb4[0], sb4[1], sb4[2], sb4[3]);
        *(LAS f32x4*)(sbs + (rl * 4 + gq) * 8) = s4; *(LAS f32x4*)(sbs + (rl * 4 + gq) * 8 + 4) = sb4;
#define QB(x, c_) __builtin_bit_cast(float, __builtin_amdgcn_update_dpp(0, __builtin_bit_cast(int, (x)), (c_), 0xf, 0xf, true))
        const float q0 = QB(gs, 0x00), q1 = QB(gs, 0x55), q2 = QB(gs, 0xAA), q3 = QB(gs, 0xFF);
#undef QB
        float best = q0; int gi = 0;
        { const bool u = q1 > best; best = u ? q1 : best; gi = u ? 1 : gi; } { const bool u = q2 > best; best = u ? q2 : best; gi = u ? 2 : gi; } { const bool u = q3 > best; best = u ? q3 : best; gi = u ? 3 : gi; }
        asm volatile("s_waitcnt lgkmcnt(0)" ::: "memory");
        const f32x4 ws = *(const LAS f32x4*)(sbs + (rl * 4 + gi) * 8), wb = *(const LAS f32x4*)(sbs + (rl * 4 + gi) * 8 + 4);
        int i1 = 0; float m1 = wb[0], sv1 = ws[0];
        { const bool c1 = wb[1] > m1; m1 = c1 ? wb[1] : m1; i1 = c1 ? 1 : i1; sv1 = c1 ? ws[1] : sv1; }
        { const bool c2 = wb[2] > m1; m1 = c2 ? wb[2] : m1; i1 = c2 ? 2 : i1; sv1 = c2 ? ws[2] : sv1; }
        { const bool c3 = wb[3] > m1; m1 = c3 ? wb[3] : m1; i1 = c3 ? 3 : i1; sv1 = c3 ? ws[3] : sv1; }
        int i2 = -1; float m2 = -1e30f, sv2 = 0.f;
        { const bool c0 = (i1 != 0) && (wb[0] > m2); m2 = c0 ? wb[0] : m2; i2 = c0 ? 0 : i2; sv2 = c0 ? ws[0] : sv2; }
        { const bool c1 = (i1 != 1) && (wb[1] > m2); m2 = c1 ? wb[1] : m2; i2 = c1 ? 1 : i2; sv2 = c1 ? ws[1] : sv2; }
        { const bool c2 = (i1 != 2) && (wb[2] > m2); m2 = c2 ? wb[2] : m2; i2 = c2 ? 2 : i2; sv2 = c2 ? ws[2] : sv2; }
        { const bool c3 = (i1 != 3) && (wb[3] > m2); m2 = c3 ? wb[3] : m2; i2 = c3 ? 3 : i2; sv2 = c3 ? ws[3] : sv2; }
        const int e0 = 4 * gi + i1, e1 = 4 * gi + i2; const float rws = __builtin_amdgcn_rcpf(sv1 + sv2); const float w0 = sv1 * rws, w1 = sv2 * rws;
        if (gq == 0) { const int lp0 = atomicAdd((int*)&lcnt[e0], 1), lp1 = atomicAdd((int*)&lcnt[e1], 1);
            LAS int* sp = sel + (wave * 16 + rl) * 8; sp[0] = row0 + 16 * wave + rl; sp[1] = e0; sp[2] = e1; sp[3] = lp0; sp[4] = lp1; sp[5] = __builtin_bit_cast(int, w0); sp[6] = __builtin_bit_cast(int, w1); }
    }
    __syncthreads();
    if (tid < 16) lcnt[16 + tid] = (int)atomicAdd(&cnt[tid], (unsigned)lcnt[tid]);
    __syncthreads();
    for (int i = tid; i < RB; i += NTHREADS) { const LAS int* sp = sel + i * 8; const int row = sp[0], e0 = sp[1], e1 = sp[2];
        const int p0 = lcnt[16 + e0] + sp[3], p1 = lcnt[16 + e1] + sp[4];
        list[(size_t)e0 * T + p0] = row; list[(size_t)e1 * T + p1] = row;
        int* ti = tokinfo + (size_t)row * 8; ti[0] = e0; ti[1] = p0; ti[2] = sp[5]; ti[3] = e1; ti[4] = p1; ti[5] = sp[6]; }
    __syncthreads();
}

__device__ __forceinline__ void moe_tiles(int wv, const unsigned* cnt, LAS int* tb, LAS int* cn) {
    __syncthreads();
    if (otid(wv) == 0) { int s = 0; for (int e = 0; e < 16; ++e) { const int c = (int)cnt[e]; cn[e] = c; tb[e] = s; s += (c + 255) >> 8; } tb[16] = s; }
    __syncthreads();
}
__device__ __forceinline__ void phase_moe_up(LAS unsigned char* lds, int wv, int l) {
    const Args a = oargs();
    LAS int* tb = (LAS int*)(lds + LDS_TB); LAS int* cn = tb + 32; LAS int* toks = (LAS int*)(lds + LDS_TOK);
    unsigned char* ws = a.ws;
    moe_tiles(wv, (const unsigned*)(ws + WS_CTL) + CW_CNT + 64 * l, tb, cn);
    LAS int* ul = (LAS int*)(lds + LDS_TB + 256);
    pg8::moe_unit_list(wv, tb, ul);
    pg8::MoeOrder S{ul, toks};
    { const int tid = otid(wv); const int* list = (const int*)(ws + WS_LIST); pg8::Unit u;
      for (int ui = 0; ui < 12 && S.next(ui, u); ++ui) { const int e = u.pn >> 2;
          for (int r = tid; r < 256; r += NTHREADS) { const int pos = (u.pm - tb[e]) * 256 + r; toks[ui * 256 + r] = pos < cn[e] ? list[(size_t)e * T + pos] : 0; } }
      __syncthreads(); }
    const pg8::Gemm g{(const bf16_t*)(ws + WS_H2), (const bf16_t*)(ws + WS_WGU) + (size_t)l * 16 * 1024 * 1024, 0, 0, D};
    pg8::gemm_phase<pg8::EpiGated<1>, pg8::MoeOrder, true, true, true>(lds, wv, g, S, pg8::EpiGated<1>{(bf16_t*)(ws + WS_ACT), DE, 3, nullptr});
}
__device__ __forceinline__ void phase_moe_down(LAS unsigned char* lds, int wv, int l) {
    const Args a = oargs();
    LAS int* tb = (LAS int*)(lds + LDS_TB); LAS int* cn = tb + 32; LAS int* toks = (LAS int*)(lds + LDS_TOK);
    unsigned char* ws = a.ws;
    moe_tiles(wv, (const unsigned*)(ws + WS_CTL) + CW_CNT + 64 * l, tb, cn);
    LAS int* ul = (LAS int*)(lds + LDS_TB + 256);
    pg8::moe_unit_list(wv, tb, ul);
    pg8::MoeOrder S{ul, toks};
    const pg8::Gemm g{(const bf16_t*)(ws + WS_ACT), (const bf16_t*)(ws + WS_WDN) + (size_t)l * 16 * 1024 * 512, 0, 0, DE};
    pg8::gemm_phase<pg8::EpiBf16, pg8::MoeOrder, true, true, false>(lds, wv, g, S, pg8::EpiBf16{(bf16_t*)(ws + WS_YB), D, 3});
}
__device__ __forceinline__ void phase_combine(LAS unsigned char* lds, int wv, int l) {
    const Args a = oargs();
    LAS int* tb = (LAS int*)(lds + LDS_TB); LAS int* cn = tb + 32;
    const unsigned* cnt = (const unsigned*)(a.ws + WS_CTL) + CW_CNT + 64 * l;
    moe_tiles(wv, cnt, tb, cn);
    const int tid_ = otid(wv); const int lane = tid_ & 63, gw = blockIdx.x * 8 + (tid_ >> 6), NGW = gridDim.x * 8;
    bf16_t* X = (bf16_t*)(a.ws + WS_X16); float* OUT = a.out; const bf16_t* YB = (const bf16_t*)(a.ws + WS_YB); const int* tokinfo = (const int*)(a.ws + WS_TOKINFO);
    const float* mod = (const float*)(a.ws + WS_MOD);
    for (int row0 = gw; row0 < T; row0 += 2 * NGW) {
        int e0[2], p0[2], e1[2], p1[2]; float w0[2], w1[2]; f32x4 v[2][4]; u32x2 ya[2][4], yc[2][4];
#pragma unroll
        for (int q = 0; q < 2; ++q) { const int row = row0 + q * NGW; const int* ti = tokinfo + (size_t)row * 8;
            e0[q] = ti[0]; p0[q] = ti[1]; e1[q] = ti[3]; p1[q] = ti[4]; w0[q] = __builtin_bit_cast(float, ti[2]); w1[q] = __builtin_bit_cast(float, ti[5]); }
#pragma unroll
        for (int q = 0; q < 2; ++q) { const int row = row0 + q * NGW;
            const bf16_t* y0 = YB + (size_t)(tb[e0[q]] * 256 + p0[q]) * D; const bf16_t* y1 = YB + (size_t)(tb[e1[q]] * 256 + p1[q]) * D;
#pragma unroll
            for (int j = 0; j < 4; ++j) { const u32x2 xw = *(const u32x2*)(X + (size_t)row * D + 4 * lane + 256 * j); v[q][j] = (f32x4){bflo(xw.x), bfhi(xw.x), bflo(xw.y), bfhi(xw.y)}; }
#pragma unroll
            for (int j = 0; j < 4; ++j) { ya[q][j] = *(const u32x2*)(y0 + 4 * lane + 256 * j); yc[q][j] = *(const u32x2*)(y1 + 4 * lane + 256 * j); } }
#pragma unroll
        for (int q = 0; q < 2; ++q) { const int row = row0 + q * NGW; const int b = row / SEQ;
            const float* g2 = mod + ((size_t)l * 4 + b) * 6144 + 5 * 1024;
#pragma unroll
            for (int j = 0; j < 4; ++j) { const int c = 4 * lane + 256 * j; const u32x2 a0 = ya[q][j], a1 = yc[q][j]; const f32x4 gv = *(const f32x4*)(g2 + c);
                f32x4 y; y.x = w0[q] * bflo(a0.x) + w1[q] * bflo(a1.x); y.y = w0[q] * bfhi(a0.x) + w1[q] * bfhi(a1.x); y.z = w0[q] * bflo(a0.y) + w1[q] * bflo(a1.y); y.w = w0[q] * bfhi(a0.y) + w1[q] * bfhi(a1.y);
                v[q][j] = v[q][j] + gv * y; }
            const float r = row_rstd(v[q]);
            if (l == DEPTH - 1) {
                const float* fg = (const float*)a.in[27];
#pragma unroll
                for (int j = 0; j < 4; ++j) { const int c = 4 * lane + 256 * j; *(f32x4*)(OUT + (size_t)row * D + c) = v[q][j] * r * *(const f32x4*)(fg + c); }
            } else {
#pragma unroll
                for (int j = 0; j < 4; ++j) { u32x2 o; o.x = pk2(v[q][j].x, v[q][j].y); o.y = pk2(v[q][j].z, v[q][j].w); *(u32x2*)(X + (size_t)row * D + 4 * lane + 256 * j) = o; }
                const float* mn = mod + ((size_t)(l + 1) * 4 + b) * 6144;
                row_modulate_store(v[q], r, (const float*)a.in[5] + (l + 1) * D, mn + 1024, mn, (bf16_t*)(a.ws + WS_HA) + (size_t)row * D, lane);
                if (l == 1) row_modulate_store(v[q], r, (const float*)a.in[14], nullptr, nullptr, (bf16_t*)(a.ws + WS_XKV) + (size_t)row * D, lane);
            } }
    }
}

__device__ __forceinline__ void phase_mla_norm(int wv, int j) {
    const Args a = oargs();
    const int tid_ = otid(wv); const int lane = tid_ & 63, gw = blockIdx.x * 8 + (tid_ >> 6), NGW = gridDim.x * 8;
    const float* CQRAW = (const float*)(a.ws + WS_CQRAW); const float* CKVRAW = (const float*)(a.ws + WS_CKVRAW);
    bf16_t* CQ = (bf16_t*)(a.ws + WS_CQ); bf16_t* LAT = (bf16_t*)(a.ws + WS_LAT); bf16_t* KROPE = (bf16_t*)(a.ws + WS_KROPE);
    const float* qg = (const float*)a.in[19] + j * QR; const float* kg = (const float*)a.in[16]; const f32x2* rope = (const f32x2*)(a.ws + WS_ROPE);
    for (int row = gw; row < T; row += NGW) {
        { f32x2 v[3]; float s = 0.f;
#pragma unroll
          for (int q = 0; q < 3; ++q) { v[q] = *(const f32x2*)(CQRAW + (size_t)row * QR + 2 * lane + 128 * q); s += v[q].x * v[q].x + v[q].y * v[q].y; }
          const float r = 1.0f / sqrtf(wave_sum(s) * (1.0f / QR) + EPS);
#pragma unroll
          for (int q = 0; q < 3; ++q) { const int c = 2 * lane + 128 * q; const f32x2 gv = *(const f32x2*)(qg + c); *(unsigned*)(CQ + (size_t)row * QR + c) = pk2(v[q].x * r * gv.x, v[q].y * r * gv.y); } }
        if (j == 0) {
            const f32x4 v = *(const f32x4*)(CKVRAW + (size_t)row * 320 + 4 * lane);
            const float s = (v.x * v.x + v.y * v.y) + (v.z * v.z + v.w * v.w);
            const float r = 1.0f / sqrtf(wave_sum(s) * (1.0f / KVR) + EPS);
            const f32x4 gv = *(const f32x4*)(kg + 4 * lane);
            u32x2 o; o.x = pk2(v.x * r * gv.x, v.y * r * gv.y); o.y = pk2(v.z * r * gv.z, v.w * r * gv.w);
            *(u32x2*)(LAT + (size_t)row * KVR + 4 * lane) = o;
            if (lane < 32) { const float x1 = CKVRAW[(size_t)row * 320 + 256 + lane], x2 = CKVRAW[(size_t)row * 320 + 288 + lane]; const f32x2 cs = rope[(size_t)row * 32 + lane];
                KROPE[(size_t)row * 64 + lane] = (bf16_t)f2bf(x1 * cs.x - x2 * cs.y); KROPE[(size_t)row * 64 + 32 + lane] = (bf16_t)f2bf(x1 * cs.y + x2 * cs.x); }
        }
    }
}

namespace att {
typedef float f32x16 __attribute__((ext_vector_type(16)));
typedef short s16x4 __attribute__((ext_vector_type(4)));
constexpr int QB = 256, KVB = 64, KPB = 400  , SHM_V = KVB * 128 * 2, SHM_K = KVB * KPB;
constexpr int K_OFF = 2 * SHM_V, SCR_OFF = K_OFF + 2 * SHM_K;
constexpr float THR = 8.f;
__device__ __forceinline__ int v_st(int k, int c) { const int kk = (k & ~0xC) | ((k & 4) << 1) | ((k & 8) >> 1); return ((kk >> 3) * 4 + (c >> 5)) * 512 + ((kk & 7) * 32 + (c & 31)) * 2; }
__device__ __forceinline__ int v_rd_base(int lane) { return ((lane & 3) << 3) | (((lane >> 2) & 3) << 6) | (((lane >> 4) & 1) << 5) | (((lane >> 5) & 1) << 8); }
constexpr int v_rd_off(int d0, int ks, int half) { return d0 * 512 + ks * 4096 + half * 2048; }
__device__ __forceinline__ int crow(int r, int hi) { return (r & 3) + 8 * (r >> 2) + 4 * hi; }
__device__ __forceinline__ unsigned cvtpk(float lo, float hi) { unsigned r; asm volatile("v_cvt_pk_bf16_f32 %0, %1, %2" : "=v"(r) : "v"(lo), "v"(hi)); return r; }
#define ASBAR() __builtin_amdgcn_sched_barrier(0)
__device__ __forceinline__ void mask_tile(f32x16& p0, f32x16& p1, int dq) {
    const float NEG = -__builtin_inff();
#pragma unroll
    for (int r = 0; r < 16; ++r) { const int c = (r & 3) + 8 * (r >> 2); if (dq - c < 0) p0[r] = NEG; if (dq - c - 32 < 0) p1[r] = NEG; }
}
__device__ __forceinline__ void partialSM(f32x16& p0, f32x16& p1, float& m_reg, float& mn, float& alpha) {
    float pmax = p0[0];
#pragma unroll
    for (int r = 1; r < 16; ++r) pmax = fmaxf(pmax, p0[r]);
#pragma unroll
    for (int r = 0; r < 16; ++r) pmax = fmaxf(pmax, p1[r]);
    { float a_, b_; swap32(pmax, a_, b_); pmax = fmaxf(a_, b_); }
    constexpr float C2 = 1.4426950408889634f * ATTN_SCALE;
    if (__builtin_expect(__all((pmax - m_reg) * ATTN_SCALE <= THR), 1)) { mn = m_reg; alpha = 1.f; }
    else { mn = fmaxf(m_reg, pmax); alpha = __builtin_amdgcn_exp2f((m_reg - mn) * C2); m_reg = mn; }
    const float mnL = -mn * C2;
#pragma unroll
    for (int r = 0; r < 16; ++r) p0[r] = fmaf(p0[r], C2, mnL);
#pragma unroll
    for (int r = 0; r < 16; ++r) p1[r] = fmaf(p1[r], C2, mnL);
#pragma unroll
    for (int r = 0; r < 16; ++r) p0[r] = __builtin_amdgcn_exp2f(p0[r]);
}
__device__ __forceinline__ void finishSM(f32x16& p0, f32x16& p1, float alpha, float& l_reg, bf16x8& pa0, bf16x8& pa1, bf16x8& pa2, bf16x8& pa3) {
#pragma unroll
    for (int r = 0; r < 16; ++r) p1[r] = __builtin_amdgcn_exp2f(p1[r]);
    float ps = 0;
#pragma unroll
    for (int r = 0; r < 16; ++r) ps += p0[r];
#pragma unroll
    for (int r = 0; r < 16; ++r) ps += p1[r];
    { float a_, b_; swap32(ps, a_, b_); ps = a_ + b_; }
    l_reg = l_reg * alpha + ps;
#define PK4(P, B_, OUT) do { unsigned a0 = cvtpk(P[B_+0], P[B_+1]), a1 = cvtpk(P[B_+2], P[B_+3]); unsigned b0 = cvtpk(P[B_+4], P[B_+5]), b1 = cvtpk(P[B_+6], P[B_+7]); \
        auto r0 = __builtin_amdgcn_permlane32_swap(a0, b0, false, false); auto r1 = __builtin_amdgcn_permlane32_swap(a1, b1, false, false); \
        u32x4 w = {r0[0], r1[0], r0[1], r1[1]}; OUT = *reinterpret_cast<bf16x8*>(&w); } while (0)
    PK4(p0, 0, pa0); PK4(p0, 8, pa1); PK4(p1, 0, pa2); PK4(p1, 8, pa3);
#undef PK4
}
template <int KB>
__device__ __forceinline__ void qkt(f32x16& p0, f32x16& p1, const LAS unsigned char* kb, const bf16x8 (&qr)[12]) {
    p0 = f32x16{}; p1 = f32x16{};
#pragma unroll
    for (int d0 = 0; d0 < 12; ++d0) {
        const bf16x8 b0 = *(const LAS bf16x8*)(kb + KB * SHM_K + 32 * d0);
        const bf16x8 b1 = *(const LAS bf16x8*)(kb + KB * SHM_K + 32 * KPB + 32 * d0);
        p0 = __builtin_amdgcn_mfma_f32_32x32x16_bf16(b0, qr[d0], p0, 0, 0, 0);
        p1 = __builtin_amdgcn_mfma_f32_32x32x16_bf16(b1, qr[d0], p1, 0, 0, 0); }
}
template <int VB>
__device__ __forceinline__ void pv_tile(f32x16 (&o)[4], unsigned vb0, bf16x8 pa0, bf16x8 pa1, bf16x8 pa2, bf16x8 pa3) {
#define TRRD(dst, off) asm volatile("ds_read_b64_tr_b16 %0, %1 offset:%2" : "=&v"(dst) : "v"(vb0), "i"(off) : "memory")
#define PV_D0(d0) do { s16x4 l0, l1, l2, l3, h0, h1, h2, h3; constexpr int b_ = VB * SHM_V + v_rd_off(d0, 0, 0); \
        TRRD(l0, b_); TRRD(h0, b_ + 2048); TRRD(l1, b_ + 4096); TRRD(h1, b_ + 6144); TRRD(l2, b_ + 8192); TRRD(h2, b_ + 10240); TRRD(l3, b_ + 12288); TRRD(h3, b_ + 14336); \
        asm volatile("s_waitcnt lgkmcnt(0)" ::: "memory"); ASBAR(); \
        o[d0] = __builtin_amdgcn_mfma_f32_32x32x16_bf16(pa0, (bf16x8){l0[0], l0[1], l0[2], l0[3], h0[0], h0[1], h0[2], h0[3]}, o[d0], 0, 0, 0); \
        o[d0] = __builtin_amdgcn_mfma_f32_32x32x16_bf16(pa1, (bf16x8){l1[0], l1[1], l1[2], l1[3], h1[0], h1[1], h1[2], h1[3]}, o[d0], 0, 0, 0); \
        o[d0] = __builtin_amdgcn_mfma_f32_32x32x16_bf16(pa2, (bf16x8){l2[0], l2[1], l2[2], l2[3], h2[0], h2[1], h2[2], h2[3]}, o[d0], 0, 0, 0); \
        o[d0] = __builtin_amdgcn_mfma_f32_32x32x16_bf16(pa3, (bf16x8){l3[0], l3[1], l3[2], l3[3], h3[0], h3[1], h3[2], h3[3]}, o[d0], 0, 0, 0); } while (0)
    PV_D0(0); PV_D0(1); PV_D0(2); PV_D0(3);
#undef PV_D0
#undef TRRD
}
}

__device__ __forceinline__ void phase_attn(LAS unsigned char* lds, int wv) {
    const Args a = oargs();
    using namespace att;
    const int tid = otid(wv), lane = tid & 63, wid = __builtin_amdgcn_readfirstlane(tid >> 6), r32 = lane & 31, hi = lane >> 5, G = gridDim.x;
    unsigned char* ws = a.ws;
    const bf16_t* Q = (const bf16_t*)(ws + WS_Q); const bf16_t* KV = (const bf16_t*)(ws + WS_KV); const bf16_t* KR = (const bf16_t*)(ws + WS_KROPE);
    bf16_t* AO = (bf16_t*)(ws + WS_AO); const f32x2* rope = (const f32x2*)(ws + WS_ROPE);
    const __amdgpu_buffer_rsrc_t rsKV = __builtin_amdgcn_make_buffer_rsrc((void*)KV, 0, T * 2048 * 2, 0x00020000);
    const __amdgpu_buffer_rsrc_t rsKR = __builtin_amdgcn_make_buffer_rsrc((void*)KR, 0, T * 64 * 2, 0x00020000);
    LAS unsigned char* K_lds = lds + K_OFF;
    LAS float* wsc = (LAS float*)(lds + SCR_OFF) + wid * 64; LAS float* li_l = wsc; LAS float* al_l = wsc + 32;
    const int sr = tid >> 4, sc = (tid & 15) * 8, kr = tid >> 3, kc = tid & 7;
    const int vst0 = v_st(sr, sc), vst1 = v_st(32 + sr, sc), kw0 = sr * KPB + sc * 2, kw1 = (32 + sr) * KPB + sc * 2, kw2 = kr * KPB + 256 + kc * 16;
    const unsigned vb0 = (unsigned)(size_t)lds + (unsigned)v_rd_base(lane);
    const LAS unsigned char* kbp = K_lds + r32 * KPB + hi * 16;
    constexpr int NQB = SEQ / QB, NPAIR = NQB / 2, NITEM = NB * NH * NPAIR;
    for (int it0 = blockIdx.x; it0 < NITEM; it0 += G) {
        int item = it0; if ((G & 7) == 0 && NITEM % G == 0) { const int base = (it0 / G) * G, c = it0 - base; item = base + (c & 7) * (G >> 3) + (c >> 3); }
        const int bh = item / NPAIR, pr = item % NPAIR, b = bh / NH, h = bh % NH;
        const size_t tb0 = (size_t)b * SEQ;
        for (int pass = 0; pass < 2; ++pass) {
            const int qb = pass == 0 ? (NQB - 1 - pr) : pr;
            const int P0 = qb * QB, NT = 4 * (qb + 1), qlo = P0 + wid * 32, qm = qlo + r32 - 4 * hi;
            bf16x8 qr[12];
            { const size_t row = tb0 + P0 + wid * 32 + r32; const bf16_t* qp = Q + row * 1536 + h * DQK + 8 * hi;
#pragma unroll
              for (int d0 = 0; d0 < 12; ++d0) qr[d0] = *(const bf16x8*)(qp + 16 * d0);
#pragma unroll
              for (int dd = 0; dd < 2; ++dd) { ASBAR();
#pragma unroll
                  for (int j4 = 0; j4 < 2; ++j4) { const f32x4 ca = *(const f32x4*)(rope + row * 32 + 16 * dd + 8 * hi + 4 * j4), cb = *(const f32x4*)(rope + row * 32 + 16 * dd + 8 * hi + 4 * j4 + 2);
                      const float cc[4] = {ca.x, ca.z, cb.x, cb.z}, ss[4] = {ca.y, ca.w, cb.y, cb.w};
#pragma unroll
                      for (int jj = 0; jj < 4; ++jj) { const int j = 4 * j4 + jj; const float x1 = bf2f((unsigned short)qr[8 + dd][j]), x2 = bf2f((unsigned short)qr[10 + dd][j]);
                          qr[8 + dd][j] = (short)f2bf(x1 * cc[jj] - x2 * ss[jj]); qr[10 + dd][j] = (short)f2bf(x1 * ss[jj] + x2 * cc[jj]); } } }
              ASBAR(); }
            float m_reg = -1e30f, l_reg = 0.f; f32x16 o[4] = {};
            u32x4 st_v0, st_v1, st_k0, st_k1, st_k2;
            const unsigned voKV = (unsigned)(sr * 2048 + h * 256 + sc) * 2u, voKR = (unsigned)(kr * 64 + kc * 8) * 2u;
#define ALOAD(kb_) do { const unsigned t0_ = (unsigned)tb0 + (unsigned)(kb_); \
                st_v0 = __builtin_amdgcn_raw_buffer_load_b128(rsKV, voKV + 256u, t0_ * 4096u, 0); st_v1 = __builtin_amdgcn_raw_buffer_load_b128(rsKV, voKV + 256u, (t0_ + 32u) * 4096u, 0); \
                st_k0 = __builtin_amdgcn_raw_buffer_load_b128(rsKV, voKV, t0_ * 4096u, 0); st_k1 = __builtin_amdgcn_raw_buffer_load_b128(rsKV, voKV, (t0_ + 32u) * 4096u, 0); \
                st_k2 = __builtin_amdgcn_raw_buffer_load_b128(rsKR, voKR, t0_ * 128u, 0); } while (0)
#define AWRITE(bf) do { *(LAS u32x4*)(lds + (bf) * SHM_V + vst0) = st_v0; *(LAS u32x4*)(lds + (bf) * SHM_V + vst1) = st_v1; \
                *(LAS u32x4*)(K_lds + (bf) * SHM_K + kw0) = st_k0; *(LAS u32x4*)(K_lds + (bf) * SHM_K + kw1) = st_k1; *(LAS u32x4*)(K_lds + (bf) * SHM_K + kw2) = st_k2; } while (0)
#define RESC(a_) do { if (__any((a_) < 1.f)) { if (hi == 0) al_l[r32] = (a_); asm volatile("s_waitcnt lgkmcnt(0)" ::: "memory"); \
                _Pragma("unroll") for (int d_ = 0; d_ < 4; ++d_) _Pragma("unroll") for (int r = 0; r < 16; ++r) o[d_][r] *= al_l[crow(r, hi)]; } } while (0)
#define ASTEP(t, BF) do { f32x16 p0, p1; float mn, al; bf16x8 pa0, pa1, pa2, pa3; const int kb_ = (t) * KVB; \
                if ((t) + 1 < NT) ALOAD(kb_ + KVB); \
                ASBAR(); qkt<BF>(p0, p1, kbp, qr); \
                if (kb_ + KVB - 1 > qlo) mask_tile(p0, p1, qm - kb_); \
                partialSM(p0, p1, m_reg, mn, al); RESC(al); finishSM(p0, p1, al, l_reg, pa0, pa1, pa2, pa3); ASBAR(); \
                pv_tile<BF>(o, vb0, pa0, pa1, pa2, pa3); \
                if ((t) + 1 < NT) { asm volatile("s_waitcnt vmcnt(0)" ::: "memory"); AWRITE((BF) ^ 1); } \
                __syncthreads(); } while (0)
            __syncthreads();
            ALOAD(0); asm volatile("s_waitcnt vmcnt(0)" ::: "memory"); AWRITE(0);
            __syncthreads();
            for (int t = 0; t < NT; t += 2) { ASTEP(t, 0); ASTEP(t + 1, 1); }
            if (hi == 0) li_l[r32] = l_reg;
            asm volatile("s_waitcnt lgkmcnt(0)" ::: "memory");
            int r32e = r32, hie = hi; asm volatile("" : "+v"(r32e), "+v"(hie));
            bf16_t* Ow = AO + (tb0 + P0 + wid * 32) * D + h * 128 + r32e;
#pragma unroll
            for (int r = 0; r < 16; ++r) { const int orow = (r & 3) + 8 * (r >> 2) + 4 * hie; const float rl = __builtin_amdgcn_rcpf(li_l[orow]);
#pragma unroll
                for (int d0 = 0; d0 < 4; ++d0) { const float v = o[d0][r] * rl; const float vn = __shfl_xor(v, 1);
                    if ((r32e & 1) == 0) *(unsigned*)(Ow + (size_t)orow * D + d0 * 32) = cvtpk(v, vn); } }
#undef ALOAD
#undef AWRITE
#undef RESC
#undef ASTEP
        }
    }
    __syncthreads();
}

__device__ __forceinline__ void phase_c1(LAS unsigned char* lds, int wv, int l) {
    const Args a = oargs(); unsigned char* ws = a.ws;
    const pg8::Gemm g{(const bf16_t*)(ws + WS_HA), (const bf16_t*)(ws + WS_WIN) + (size_t)l * 2048 * 1024, T, 2048, D};
    pg8::StaticOrder S; S.init(T, 2048, (int)gridDim.x, (int)blockIdx.x);
    pg8::gemm_phase<pg8::EpiGated<0>, pg8::StaticOrder, true, true, false>(lds, wv, g, S, pg8::EpiGated<0>{(bf16_t*)(ws + WS_U), D, 0xffff, (const float*)a.in[8] + l * 2048});
}
__device__ __forceinline__ void phase_resid(LAS unsigned char* lds, int wv, int l, size_t a_off, size_t w_off) {
    const Args a = oargs(); unsigned char* ws = a.ws;
    const pg8::Gemm g{(const bf16_t*)(ws + a_off), (const bf16_t*)(ws + w_off), T, D, D};
    pg8::StaticOrder S; S.init(T, D, (int)gridDim.x, (int)blockIdx.x);
    pg8::gemm_phase<pg8::EpiResid, pg8::StaticOrder, true, true, false>(lds, wv, g, S, pg8::EpiResid{(bf16_t*)(ws + WS_X16), (const float*)(ws + WS_MOD) + (size_t)l * 4 * 6144 + 2048});
}
__device__ __forceinline__ void phase_a1(LAS unsigned char* lds, int wv, int j) {
    const Args a = oargs(); unsigned char* ws = a.ws;
    { const pg8::Gemm g{(const bf16_t*)(ws + WS_HA), (const bf16_t*)(ws + WS_WDQ) + (size_t)j * 512 * D, T, 512, D};
      pg8::StaticOrder S; S.init(T, 512, (int)gridDim.x, (int)blockIdx.x);
      pg8::gemm_phase<pg8::EpiF32, pg8::StaticOrder, true, true, false>(lds, wv, g, S, pg8::EpiF32{(float*)(ws + WS_CQRAW), QR, QR}); }
    if (j == 0) { const pg8::Gemm g{(const bf16_t*)(ws + WS_XKV), (const bf16_t*)(ws + WS_WDKV), T, 512, D};
      pg8::StaticOrder S; S.init(T, 512, (int)gridDim.x, (int)((blockIdx.x + gridDim.x / 2) % gridDim.x));
      pg8::gemm_phase<pg8::EpiF32, pg8::StaticOrder, true, true, false>(lds, wv, g, S, pg8::EpiF32{(float*)(ws + WS_CKVRAW), 320, 320}); }
}
__device__ __forceinline__ void phase_a2(LAS unsigned char* lds, int wv, int j) {
    const Args a = oargs(); unsigned char* ws = a.ws;
    { const pg8::Gemm g{(const bf16_t*)(ws + WS_CQ), (const bf16_t*)(ws + WS_WUQ) + (size_t)j * 1536 * QR, T, 1536, QR};
      pg8::StaticOrder S; S.init(T, 1536, (int)gridDim.x, (int)blockIdx.x);
      pg8::gemm_phase<pg8::EpiBf16, pg8::StaticOrder, true, true, false>(lds, wv, g, S, pg8::EpiBf16{(bf16_t*)(ws + WS_Q), 1536, 0xffff}); }
    if (j == 0) { const pg8::Gemm g{(const bf16_t*)(ws + WS_LAT), (const bf16_t*)(ws + WS_WUKV), T, 2048, KVR};
      pg8::StaticOrder S; S.init(T, 2048, (int)gridDim.x, (int)((blockIdx.x + gridDim.x / 2) % gridDim.x));
      pg8::gemm_phase<pg8::EpiBf16, pg8::StaticOrder, true, true, false>(lds, wv, g, S, pg8::EpiBf16{(bf16_t*)(ws + WS_KV), 2048, 0xffff}); }
}

constexpr int PH_PER_LAYER = 9, NPHASE = 2 + DEPTH * PH_PER_LAYER;
__global__ void __launch_bounds__(NTHREADS, 2) fwd(Args a) {
    extern __shared__ __attribute__((aligned(16))) unsigned char lds_raw[];
    LAS unsigned char* lds = (LAS unsigned char*)lds_raw;
    const int lo = a.ph_lo, hi = a.ph_hi;
    volatile LAS unsigned* misc = (volatile LAS unsigned*)(lds + LDS_MISC);
    const int wv = __builtin_amdgcn_readfirstlane((int)(threadIdx.x >> 6));
    if (threadIdx.x < 32) misc[threadIdx.x] = 0u;
    __syncthreads();
    if (hi - lo > 1) (void)xcd_barrier_post((unsigned*)(a.ws + WS_CTL) + CW_BAR, misc + 8);
#define IN(k) (lo <= (k) && (k) < hi)
#define SEAM(k) do { if ((k) + 1 < hi) { XcdBarrier bb_; bb_.bar = (unsigned*)(oargs().ws + WS_CTL) + CW_BAR; bb_.x = xb_xcc_id(); bb_.st = misc + 8; xcd_barrier(bb_, otid(wv) == 0); } } while (0)

    if (IN(0)) { phase_prologue(lds, wv); SEAM(0); }
    if (IN(1)) { phase_mod0(wv); SEAM(1); }
#pragma unroll 1
    for (int l = 0; l < DEPTH; ++l) {
        const int pb = 2 + PH_PER_LAYER * l;
        if (l < 2) {
            if (IN(pb + 0)) { phase_c1(lds, wv, l); SEAM(pb + 0); }
            if (IN(pb + 1)) { phase_conv(lds, wv, l); SEAM(pb + 1); }
            if (IN(pb + 2)) { phase_resid(lds, wv, l, WS_V2, WS_WOUT + (size_t)l * D * D * 2); SEAM(pb + 2); }
        } else {
            const int j = l - 2;
            if (IN(pb + 0)) { phase_a1(lds, wv, j); SEAM(pb + 0); }
            if (IN(pb + 1)) { phase_mla_norm(wv, j); SEAM(pb + 1); }
            if (IN(pb + 2)) { phase_a2(lds, wv, j); SEAM(pb + 2); }
            if (IN(pb + 3)) { phase_attn(lds, wv); SEAM(pb + 3); }
            if (IN(pb + 4)) { phase_resid(lds, wv, l, WS_AO, WS_WO + (size_t)j * D * D * 2); SEAM(pb + 4); }
        }
        if (IN(pb + 5)) { phase_route(lds, wv, l); SEAM(pb + 5); }
        if (IN(pb + 6)) { phase_moe_up(lds, wv, l); SEAM(pb + 6); }
        if (IN(pb + 7)) { phase_moe_down(lds, wv, l); SEAM(pb + 7); }
        if (IN(pb + 8)) { phase_combine(lds, wv, l); SEAM(pb + 8); }
    }
#undef IN
#undef SEAM
}

extern "C" void kernel_launch(void* const* d_in, const int* in_sizes, int n_in, void* d_out, int out_size, void* d_ws, size_t ws_size, hipStream_t stream) {
    static int grid = 0;
    if (grid == 0) {
        if (n_in != 28 || out_size != T * D || ws_size < WS_END) { fprintf(stderr, "kernel_launch: unexpected shapes (n_in %d out %d ws %zu)\n", n_in, out_size, ws_size); grid = -1; return; }
        int dev = 0, cus = 0, per_cu = 0;
        if (hipGetDevice(&dev) != hipSuccess || hipDeviceGetAttribute(&cus, hipDeviceAttributeMultiprocessorCount, dev) != hipSuccess) { grid = -1; return; }
        if (hipFuncSetAttribute((const void*)fwd, hipFuncAttributeMaxDynamicSharedMemorySize, LDS_BYTES) != hipSuccess) { fprintf(stderr, "kernel_launch: hipFuncSetAttribute failed\n"); grid = -1; return; }
        if (hipOccupancyMaxActiveBlocksPerMultiprocessor(&per_cu, (const void*)fwd, NTHREADS, LDS_BYTES) != hipSuccess || per_cu < 1) fprintf(stderr, "kernel_launch: occupancy query reports %d\n", per_cu);
        (void)hipGetLastError();
        grid = cus;
    }
    if (grid < 0) return;
    (void)hipMemsetAsync((char*)d_ws + WS_CTL, 0, CTL_BYTES, stream);
    Args a{};
    for (int i = 0; i < 28; ++i) a.in[i] = d_in[i];
    a.out = (float*)d_out; a.ws = (unsigned char*)d_ws;
#if MK_ONE_LAUNCH
    a.ph_lo = 0; a.ph_hi = NPHASE;
    hipLaunchKernelGGL(fwd, dim3(grid), dim3(NTHREADS), LDS_BYTES, stream, a);
#else
    for (int ph = 0; ph < NPHASE; ++ph) {
        if (ph >= 2) { const int l = (ph - 2) / PH_PER_LAYER, k = (ph - 2) % PH_PER_LAYER; if (l < 2 && (k == 3 || k == 4)) continue; }
        a.ph_lo = ph; a.ph_hi = ph + 1;
        hipLaunchKernelGGL(fwd, dim3(grid), dim3(NTHREADS), LDS_BYTES, stream, a);
    }
#endif
}
```
